# Optimizing an MI355X kernel written in HIP

```python
import math
import jax, jax.numpy as jnp
from jax import lax
import numpy as np

D_MODEL = 1024
BATCH = 8
SEQ = 4096
DEPTH = 4

N_A = DEPTH // 2
N_B = DEPTH - N_A
FOX_HEADS = 16
FOX_HEAD_DIM = D_MODEL // FOX_HEADS
DIFF_HEADS = 8
DIFF_HEAD_DIM = D_MODEL // (2 * DIFF_HEADS)
DIFF_V_DIM = 2 * DIFF_HEAD_DIM
N_EXPERTS = 16
N_GROUPS = 4
EXPERTS_PER_GROUP = N_EXPERTS // N_GROUPS
TOP_K = 2
D_EXPERT = 512
Q_BLOCK = 128
DEEPNORM_ALPHA = (2 * DEPTH) ** 0.25
DEEPNORM_BETA = (8 * DEPTH) ** -0.25
LN_EPS = 1e-5
NEG_INF = -1e30

kernel_name = "yoco_fox_diffattn_grouped_moe_deepnorm_adaln"


def layer_norm(x, g, b):
    xf = x.astype(jnp.float32)
    mu = jnp.mean(xf, axis=-1, keepdims=True)
    var = jnp.mean(jnp.square(xf - mu), axis=-1, keepdims=True)
    y = (xf - mu) * lax.rsqrt(var + LN_EPS)
    return (y * g.astype(jnp.float32) + b.astype(jnp.float32)).astype(x.dtype)


def ada_params(c, w, b):
    return jax.nn.silu(c) @ w + b


def modulate(x, shift, scale):
    return x * (1.0 + scale[:, None, :]) + shift[:, None, :]


def post_norm_residual(x, y, gate, g, b):
    return layer_norm(DEEPNORM_ALPHA * x + (1.0 + gate[:, None, :]) * y, g, b)


def fox_attention(q, k, v, logf):
    B, H, S, Dh = q.shape
    nblk = S // Q_BLOCK
    f32 = jnp.float32
    cum = jnp.cumsum(logf.astype(f32), axis=-1)
    kf = k.astype(f32)
    vf = v.astype(f32)
    qb = (q.astype(f32) * (Dh ** -0.5)).reshape(B, H, nblk, Q_BLOCK, Dh).transpose(2, 0, 1, 3, 4)
    cb = cum.reshape(B, H, nblk, Q_BLOCK).transpose(2, 0, 1, 3)
    k_pos = jnp.arange(S)

    def one_block(args):
        i, q_i, c_i = args
        q_pos = i * Q_BLOCK + jnp.arange(Q_BLOCK)
        logits = jnp.einsum('bhqd,bhkd->bhqk', q_i, kf) + c_i[..., :, None] - cum[..., None, :]
        logits = jnp.where(k_pos[None, :] <= q_pos[:, None], logits, NEG_INF)
        p = jax.nn.softmax(logits, axis=-1)
        return jnp.einsum('bhqk,bhkd->bhqd', p, vf)

    out = lax.map(one_block, (jnp.arange(nblk), qb, cb))
    return out.transpose(1, 2, 0, 3, 4).reshape(B, H, S, Dh).astype(q.dtype)


def diff_attention(q1, q2, k1, k2, v, lam):
    B, H, S, d = q1.shape
    nblk = S // Q_BLOCK
    f32 = jnp.float32
    slopes = jnp.exp2(-8.0 * jnp.arange(1, H + 1, dtype=f32) / H)
    scale = d ** -0.5
    k1f, k2f, vf = k1.astype(f32), k2.astype(f32), v.astype(f32)
    q1b = (q1.astype(f32) * scale).reshape(B, H, nblk, Q_BLOCK, d).transpose(2, 0, 1, 3, 4)
    q2b = (q2.astype(f32) * scale).reshape(B, H, nblk, Q_BLOCK, d).transpose(2, 0, 1, 3, 4)
    k_pos = jnp.arange(S)

    def one_block(args):
        i, q1_i, q2_i = args
        q_pos = i * Q_BLOCK + jnp.arange(Q_BLOCK)
        dist = (q_pos[:, None] - k_pos[None, :]).astype(f32)
        bias = jnp.where(dist >= 0, -slopes[:, None, None] * dist, NEG_INF)
        p1 = jax.nn.softmax(jnp.einsum('bhqd,bhkd->bhqk', q1_i, k1f) + bias, axis=-1)
        p2 = jax.nn.softmax(jnp.einsum('bhqd,bhkd->bhqk', q2_i, k2f) + bias, axis=-1)
        return jnp.einsum('bhqk,bhkd->bhqd', p1 - lam * p2, vf)

    out = lax.map(one_block, (jnp.arange(nblk), q1b, q2b))
    return out.transpose(1, 2, 0, 3, 4).reshape(B, H, S, 2 * d)


def grouped_moe(h, router_w, router_b, w_gate, w_up, w_down):
    B, S, D = h.shape
    t = h.reshape(-1, D)
    T = t.shape[0]
    probs = jax.nn.softmax((t @ router_w).astype(jnp.float32), axis=-1)
    sel = probs + router_b.astype(jnp.float32)[None, :]
    grp = sel.reshape(T, N_GROUPS, EXPERTS_PER_GROUP)
    grp_score = jnp.sum(lax.top_k(grp, TOP_K)[0], axis=-1)
    g_idx = jnp.argmax(grp_score, axis=-1)
    in_grp = jnp.take_along_axis(grp, g_idx[:, None, None], axis=1)[:, 0]
    _, local = lax.top_k(in_grp, TOP_K)
    expert_idx = g_idx[:, None] * EXPERTS_PER_GROUP + local
    w = jnp.take_along_axis(probs, expert_idx, axis=-1)
    w = w / jnp.sum(w, axis=-1, keepdims=True)
    gates = jnp.sum(jax.nn.one_hot(expert_idx, N_EXPERTS, dtype=jnp.float32) * w[..., None], axis=1)
    gates = gates.astype(t.dtype)
    out = jnp.zeros_like(t)
    for e in range(N_EXPERTS):
        a = jax.nn.silu(t @ w_gate[e]) * (t @ w_up[e])
        out = out + gates[:, e:e + 1] * (a @ w_down[e])
    return out.reshape(B, S, D)


def setup_inputs(seed: int = 0) -> dict:
    key = jax.random.key(seed)
    keys = jax.random.split(key, 32)
    f32 = jnp.float32
    D = D_MODEL
    kd = DIFF_HEADS * DIFF_HEAD_DIM

    def normal(i, shape, scale):
        return scale * jax.random.normal(keys[i], shape, f32)

    x = normal(0, (BATCH, SEQ, D), 1.0)
    c = normal(1, (BATCH, D), 1.0)
    ada_w = normal(2, (DEPTH, D, 6 * D), 0.5 * D ** -0.5)
    ada_b = normal(3, (DEPTH, 6 * D), 0.02)
    ln_attn_g = 1.0 + normal(4, (DEPTH, D), 0.02)
    ln_attn_b = normal(5, (DEPTH, D), 0.02)
    ln_ffn_g = 1.0 + normal(6, (DEPTH, D), 0.02)
    ln_ffn_b = normal(7, (DEPTH, D), 0.02)
    fox_w_in = jnp.concatenate([
        normal(8, (N_A, D, 2 * D), D ** -0.5),
        normal(9, (N_A, D, D), DEEPNORM_BETA * D ** -0.5),
        normal(10, (N_A, D, FOX_HEADS), D ** -0.5),
    ], axis=-1)
    fox_b_f = 3.0 + normal(11, (N_A, FOX_HEADS), 1.0)
    fox_w_o = normal(12, (N_A, D, D), DEEPNORM_BETA * D ** -0.5)
    kv_ada_w = normal(13, (D, 2 * D), 0.5 * D ** -0.5)
    kv_ada_b = normal(14, (2 * D,), 0.02)
    kv_w = jnp.concatenate([
        normal(15, (D, 2 * kd), D ** -0.5),
        normal(16, (D, DIFF_HEADS * DIFF_V_DIM), DEEPNORM_BETA * D ** -0.5),
    ], axis=-1)
    diff_w_q = normal(17, (N_B, D, 2 * kd), D ** -0.5)
    diff_lambda = normal(18, (N_B, 4, DIFF_HEAD_DIM), 0.1)
    diff_norm_g = 1.0 + normal(19, (N_B, DIFF_V_DIM), 0.02)
    diff_w_o = normal(20, (N_B, DIFF_HEADS * DIFF_V_DIM, D), DEEPNORM_BETA * D ** -0.5)
    router_w = normal(21, (D, N_EXPERTS), D ** -0.5)
    router_b = normal(22, (N_EXPERTS,), 0.01)
    moe_w_gate = normal(23, (DEPTH, N_EXPERTS, D, D_EXPERT), D ** -0.5)
    moe_w_up = normal(24, (DEPTH, N_EXPERTS, D, D_EXPERT), D ** -0.5)
    moe_w_down = normal(25, (DEPTH, N_EXPERTS, D_EXPERT, D), DEEPNORM_BETA * D_EXPERT ** -0.5)
    return {"x": x, "c": c, "ada_w": ada_w, "ada_b": ada_b,
            "ln_attn_g": ln_attn_g, "ln_attn_b": ln_attn_b, "ln_ffn_g": ln_ffn_g, "ln_ffn_b": ln_ffn_b,
            "fox_w_in": fox_w_in, "fox_b_f": fox_b_f, "fox_w_o": fox_w_o,
            "kv_ada_w": kv_ada_w, "kv_ada_b": kv_ada_b, "kv_w": kv_w,
            "diff_w_q": diff_w_q, "diff_lambda": diff_lambda, "diff_norm_g": diff_norm_g, "diff_w_o": diff_w_o,
            "router_w": router_w, "router_b": router_b,
            "moe_w_gate": moe_w_gate, "moe_w_up": moe_w_up, "moe_w_down": moe_w_down}


def reference(x, c, ada_w, ada_b, ln_attn_g, ln_attn_b, ln_ffn_g, ln_ffn_b,
              fox_w_in, fox_b_f, fox_w_o, kv_ada_w, kv_ada_b, kv_w,
              diff_w_q, diff_lambda, diff_norm_g, diff_w_o,
              router_w, router_b, moe_w_gate, moe_w_up, moe_w_down):
    B, S, D = x.shape
    f32 = jnp.float32
    H_A, dh = FOX_HEADS, FOX_HEAD_DIM
    H_B, d = DIFF_HEADS, DIFF_HEAD_DIM
    kd = H_B * d

    def to_heads(t, h):
        return t.reshape(B, S, h, -1).transpose(0, 2, 1, 3)

    def from_heads(t):
        return t.transpose(0, 2, 1, 3).reshape(B, S, -1)

    k1 = k2 = v_sh = None
    for l in range(DEPTH):
        mod = ada_params(c, ada_w[l], ada_b[l])
        sh_a, sc_a, g_a, sh_f, sc_f, g_f = jnp.split(mod, 6, axis=-1)

        if l < N_A:
            i = l
            h = modulate(x, sh_a, sc_a)
            proj = h @ fox_w_in[i]
            q = to_heads(proj[..., :D], H_A)
            k = to_heads(proj[..., D:2 * D], H_A)
            v = to_heads(proj[..., 2 * D:3 * D], H_A)
            logf = jax.nn.log_sigmoid((proj[..., 3 * D:] + fox_b_f[i]).astype(f32))
            o = fox_attention(q, k, v, logf.transpose(0, 2, 1))
            y = from_heads(o) @ fox_w_o[i]
        else:
            if l == N_A:
                kv_sh, kv_sc = jnp.split(ada_params(c, kv_ada_w, kv_ada_b), 2, axis=-1)
                hk = modulate(x, kv_sh, kv_sc)
                kv = hk @ kv_w
                kk = kv[..., :2 * kd].reshape(B, S, H_B, 2, d)
                k1 = kk[..., 0, :].transpose(0, 2, 1, 3)
                k2 = kk[..., 1, :].transpose(0, 2, 1, 3)
                v_sh = to_heads(kv[..., 2 * kd:], H_B)
            j = l - N_A
            lam_init = 0.8 - 0.6 * math.exp(-0.3 * l)
            lp = diff_lambda[j].astype(f32)
            lam = jnp.exp(jnp.sum(lp[0] * lp[1])) - jnp.exp(jnp.sum(lp[2] * lp[3])) + lam_init
            h = modulate(x, sh_a, sc_a)
            qq = (h @ diff_w_q[j]).reshape(B, S, H_B, 2, d)
            q1 = qq[..., 0, :].transpose(0, 2, 1, 3)
            q2 = qq[..., 1, :].transpose(0, 2, 1, 3)
            o = diff_attention(q1, q2, k1, k2, v_sh, lam)
            o = o * lax.rsqrt(jnp.mean(jnp.square(o), axis=-1, keepdims=True) + LN_EPS)
            o = o * diff_norm_g[j].astype(f32) * (1.0 - lam_init)
            y = from_heads(o.astype(x.dtype)) @ diff_w_o[j]

        x = post_norm_residual(x, y, g_a, ln_attn_g[l], ln_attn_b[l])

        h = modulate(x, sh_f, sc_f)
        m = grouped_moe(h, router_w, router_b, moe_w_gate[l], moe_w_up[l], moe_w_down[l])
        x = post_norm_residual(x, m, g_f, ln_ffn_g[l], ln_ffn_b[l])
    return x
```

```cpp
#include <hip/hip_runtime.h>
#include <hip/hip_bf16.h>
#include <cstdio>
#include <cstdint>
#include <cmath>
#define LAS __attribute__((address_space(3)))
namespace pg8 {
#define PG8_LAS __attribute__((address_space(3)))
typedef unsigned short bf16_t;
typedef short bf16x8 __attribute__((ext_vector_type(8)));
typedef float f32x4 __attribute__((ext_vector_type(4)));
typedef unsigned u32x4 __attribute__((ext_vector_type(4)));
constexpr int BM = 256, BK = 64, HALF = 128, HTB = HALF * BK * 2  , STAGE_BYTES = 8 * HTB, NXCD = 8, WGM = 8;

__host__ __device__ __forceinline__ int lds_byte(int r, int c) { const int st = (r >> 4) * 2 + (c >> 5), rr = r & 15, cc = c & 31, ob = rr * 64 + cc * 2; return st * 1024 + (ob ^ (((ob >> 9) & 1) << 5)); }
__host__ __device__ __forceinline__ void stage_rc(int b, int& R, int& C) { const int st = b / 1024, sb = b % 1024, swz = sb ^ (((sb >> 9) & 1) << 5); R = (st >> 1) * 16 + swz / 64; C = (st & 1) * 32 + (swz % 64) / 2; }
__host__ __device__ __forceinline__ int perm32(int rho) { const int n = rho >> 4, i = rho & 15; return 8 * (i >> 2) + 4 * n + (i & 3); }
struct Unit0 { int pm, pn; };
struct StaticOrder {
    int nM, nN, nwg, G, c;
    __host__ __device__ void init(int M, int N, int G_, int c_) { nM = M / BM; nN = N / BM; nwg = nM * nN; G = G_; c = c_; }
    __host__ __device__ bool next(int i, Unit0& u) const {
        const long L = (long)i * G + c; if (L >= nwg) return false;
        int wgid = (int)L; { const int q = nwg / NXCD, r = nwg % NXCD, xcd = wgid % NXCD, off = wgid / NXCD; wgid = (xcd < r ? xcd * (q + 1) : r * (q + 1) + (xcd - r) * q) + off; }
        const int nig = WGM * nN, gid = wgid / nig, fm = gid * WGM, gsz = (nM - fm) < WGM ? (nM - fm) : WGM;
        u.pm = fm + ((wgid % nig) % gsz); u.pn = (wgid % nig) / gsz; return true;
    }
    __device__ __forceinline__ void a_ready(const Unit0&) const {}
    __device__ __forceinline__ void done(const Unit0&) const {}
};

struct Unit { int pm, pn, e, nrows, row0, ord; unsigned boff; };
struct Gemm { const bf16_t* A; const bf16_t* Bt; int K; };

struct DenseSched {
    StaticOrder so; int K;
    __device__ __forceinline__ void init(int M, int N, int K_, int G, int c) { so.init(M, N, G, c); K = K_; }
    __device__ __forceinline__ bool next(int i, Unit& u) const { Unit0 t; if (!so.next(i, t)) return false; u.pm = t.pm; u.pn = t.pn; u.e = 0; u.ord = i; u.nrows = BM; u.row0 = t.pm * BM; u.boff = (unsigned)t.pn * (unsigned)(BM * 2) * (unsigned)K; return true; }
    static constexpr bool GATHER = false;
    __device__ __forceinline__ void aoff(const Unit& u, int tid, unsigned (&off)[2][2]) const {
#pragma unroll
        for (int i = 0; i < 2; ++i) { int R, C; stage_rc(tid * 16 + i * 8192, R, C);
#pragma unroll
            for (int h = 0; h < 2; ++h) off[h][i] = (unsigned)((u.row0 + h * HALF + R) * K + C) * 2u; } }
};
template <bool GATHER_> struct MoeSched {
    static constexpr bool GATHER = GATHER_;
    const PG8_LAS int* tab; int G, c, K; const int* perm; unsigned wstride; const PG8_LAS int* toks;
    __device__ __forceinline__ bool next(int i, Unit& u) const {
        const int L = i * G + c; const int tot = tab[16] * 4; if (L >= tot) return false;
        const int g = L >> 2; int e = 0;
#pragma unroll
        for (int k = 1; k < 16; ++k) e += (tab[k] <= g) ? 1 : 0;
        const int mt = g - tab[e], cnt = tab[32 + e];
        u.pm = mt; u.pn = L & 3; u.e = e; u.ord = i; u.nrows = (cnt - BM * mt) < BM ? (cnt - BM * mt) : BM; u.row0 = tab[64 + e] + BM * mt;
        u.boff = (unsigned)e * wstride + (unsigned)(L & 3) * (unsigned)(BM * 2) * (unsigned)K; return true; }
    __device__ __forceinline__ void fill_tokens(PG8_LAS int* dst, int tid) const {
        Unit u;
        for (int i = 0; i < 8 && next(i, u); ++i) for (int r = tid; r < BM; r += 512) dst[i * BM + r] = r < u.nrows ? perm[u.e * 32768 + u.pm * BM + r] : 0; }
    __device__ __forceinline__ void aoff(const Unit& u, int tid, unsigned (&off)[2][2]) const {
#pragma unroll
        for (int i = 0; i < 2; ++i) { int R, C; stage_rc(tid * 16 + i * 8192, R, C);
#pragma unroll
            for (int h = 0; h < 2; ++h) {
                int row;
                if (GATHER) row = toks[u.ord * BM + h * HALF + R];
                else row = u.row0 + h * HALF + R;
                off[h][i] = (unsigned)(row * K + C) * 2u; } } }
};

typedef float f32x2 __attribute__((ext_vector_type(2))); typedef __bf16 bf16x2_t __attribute__((ext_vector_type(2)));
__device__ __forceinline__ unsigned cvt_pk_bf16(float lo, float hi) { f32x2 v = {lo, hi}; bf16x2_t b = __builtin_convertvector(v, bf16x2_t); return __builtin_bit_cast(unsigned, b); }

struct EpiBf16 {
    static constexpr bool PERM = true, AFTER_DRAIN = false;
    bf16_t* O; int ldc; int split_cols; size_t split_stride; float scv[3]; unsigned* norm; int nslots; int dry;
    __device__ __forceinline__ void operator()(const f32x4 (&acc)[2][2][4][2], const Unit& u, int wr, int wc, int fr, int fq) const {
        const int row0 = u.row0 + wr * 64 + fr; int colt = u.pn * BM; bf16_t* base = O;
        float sc = scv[0]; int tt = 0; if (split_cols) { const int t = colt / split_cols; tt = t; base += (size_t)t * split_stride; colt -= t * split_cols; sc = t == 0 ? scv[0] : (t == 1 ? scv[1] : scv[2]); }
        const int col0 = colt + wc * 64 + 8 * fq;
#pragma unroll
        for (int ai = 0; ai < 2; ++ai)
#pragma unroll
            for (int m = 0; m < 4; ++m) { bf16_t* rowp = base + (size_t)(row0 + ai * HALF + m * 16) * ldc + col0;
#pragma unroll
                for (int bj = 0; bj < 2; ++bj) { const f32x4 v0 = acc[ai][bj][m][0] * sc, v1 = acc[ai][bj][m][1] * sc;
                    u32x4 w; w.x = cvt_pk_bf16(v0[0], v0[1]); w.y = cvt_pk_bf16(v0[2], v0[3]); w.z = cvt_pk_bf16(v1[0], v1[1]); w.w = cvt_pk_bf16(v1[2], v1[3]);
                    if (!dry) *(u32x4*)(rowp + bj * 32) = w; else asm volatile("" :: "v"(w)); } }
        if (norm && !dry && tt < nslots / 16) { const int lane = fq * 16 + fr; float mx = 0.f;
#pragma unroll
            for (int ai = 0; ai < 2; ++ai)
#pragma unroll
                for (int m = 0; m < 4; ++m) { float ss = 0.f;
#pragma unroll
                    for (int bj = 0; bj < 2; ++bj) { const f32x4 v0 = acc[ai][bj][m][0] * sc, v1 = acc[ai][bj][m][1] * sc;
                        ss += (v0[0] * v0[0] + v0[1] * v0[1]) + (v0[2] * v0[2] + v0[3] * v0[3]) + (v1[0] * v1[0] + v1[1] * v1[1]) + (v1[2] * v1[2] + v1[3] * v1[3]); }
                    ss += __uint_as_float((unsigned)__builtin_amdgcn_ds_bpermute((lane ^ 16) << 2, (int)__float_as_uint(ss)));
                    ss += __uint_as_float((unsigned)__builtin_amdgcn_ds_bpermute((lane ^ 32) << 2, (int)__float_as_uint(ss)));
                    mx = fmaxf(mx, ss); }
#pragma unroll
            for (int o = 1; o < 16; o <<= 1) mx = fmaxf(mx, __uint_as_float((unsigned)__builtin_amdgcn_ds_bpermute((lane ^ o) << 2, (int)__float_as_uint(mx))));
            if (lane == 0) __hip_atomic_fetch_max(norm + (u.row0 >> 12) * nslots + u.pn * 4 + wc, __float_as_uint(mx), __ATOMIC_RELAXED, __HIP_MEMORY_SCOPE_AGENT);
        }
    }
};
__device__ __forceinline__ unsigned pk4_fp8(float a, float b, float c, float d) { unsigned w = __builtin_amdgcn_cvt_pk_fp8_f32(a, b, 0u, false); return __builtin_amdgcn_cvt_pk_fp8_f32(c, d, w, true); }
typedef unsigned u32x2e_t __attribute__((ext_vector_type(2)));
__device__ __forceinline__ u32x4 widen16(u32x2e_t w0, u32x2e_t w1) {
    const auto a = __builtin_amdgcn_permlane16_swap(w0[0], w1[0], false, false), b = __builtin_amdgcn_permlane16_swap(w0[1], w1[1], false, false);
    return (u32x4){a[0], b[0], a[1], b[1]}; }
struct EpiFp8 {
    static constexpr bool PERM = true, AFTER_DRAIN = false;
    unsigned char* O; int ldc; float sc; int dry;
    __device__ __forceinline__ void operator()(const f32x4 (&acc)[2][2][4][2], const Unit& u, int wr, int wc, int fr, int fq) const {
        const int row0 = u.row0 + wr * 64 + fr + 16 * (fq & 1), col0 = u.pn * BM + wc * 32 + 8 * (fq & ~1);
#pragma unroll
        for (int ai = 0; ai < 2; ++ai)
#pragma unroll
            for (int mp = 0; mp < 4; mp += 2) { unsigned char* rowp = O + (size_t)(row0 + ai * HALF + mp * 16) * ldc + col0;
#pragma unroll
                for (int bj = 0; bj < 2; ++bj) { const f32x4 a0 = acc[ai][bj][mp][0] * sc, a1 = acc[ai][bj][mp][1] * sc, b0 = acc[ai][bj][mp + 1][0] * sc, b1 = acc[ai][bj][mp + 1][1] * sc;
                    const u32x4 w = widen16((u32x2e_t){pk4_fp8(a0[0], a0[1], a0[2], a0[3]), pk4_fp8(a1[0], a1[1], a1[2], a1[3])}, (u32x2e_t){pk4_fp8(b0[0], b0[1], b0[2], b0[3]), pk4_fp8(b1[0], b1[1], b1[2], b1[3])});
                    if (!dry) *(u32x4*)(rowp + bj * HALF) = w; else asm volatile("" :: "v"(w)); } }
    }
};
__device__ __forceinline__ float silu_mul(float g, float u) { return g * u * __builtin_amdgcn_rcpf(1.0f + __builtin_amdgcn_exp2f(-1.4426950408889634f * g)); }
struct EpiMoe1 {
    static constexpr bool PERM = true, AFTER_DRAIN = false;
    unsigned char* O; float inv_wscale, ascale;
    __device__ __forceinline__ void operator()(const f32x4 (&acc)[2][2][4][2], const Unit& u, int wr, int wc, int fr, int fq) const {
        const int col0 = u.pn * 128 + wc * 32 + 8 * (fq & ~1); const float us = inv_wscale * ascale;
#pragma unroll
        for (int ai = 0; ai < 2; ++ai)
#pragma unroll
            for (int mp = 0; mp < 4; mp += 2) { const int r = ai * HALF + wr * 64 + (mp + (fq & 1)) * 16 + fr; u32x2e_t wv[2];
#pragma unroll
                for (int k = 0; k < 2; ++k) { const f32x4 g0 = acc[ai][0][mp + k][0] * inv_wscale, g1 = acc[ai][0][mp + k][1] * inv_wscale, u0 = acc[ai][1][mp + k][0] * us, u1 = acc[ai][1][mp + k][1] * us;
                    wv[k] = (u32x2e_t){pk4_fp8(silu_mul(g0[0], u0[0]), silu_mul(g0[1], u0[1]), silu_mul(g0[2], u0[2]), silu_mul(g0[3], u0[3])), pk4_fp8(silu_mul(g1[0], u1[0]), silu_mul(g1[1], u1[1]), silu_mul(g1[2], u1[2]), silu_mul(g1[3], u1[3]))}; }
                const u32x4 w = widen16(wv[0], wv[1]);
                if (r < u.nrows) *(u32x4*)(O + (size_t)(u.row0 + r) * 512 + col0) = w; }
    }
};
struct EpiMoe2 {
    static constexpr bool PERM = true, AFTER_DRAIN = false;
    unsigned char* O; float oscale;
    __device__ __forceinline__ void operator()(const f32x4 (&acc)[2][2][4][2], const Unit& u, int wr, int wc, int fr, int fq) const {
        const int col0 = u.pn * BM + wc * 32 + 8 * (fq & ~1); const float s = oscale;
#pragma unroll
        for (int ai = 0; ai < 2; ++ai)
#pragma unroll
            for (int mp = 0; mp < 4; mp += 2) { const int r = ai * HALF + wr * 64 + (mp + (fq & 1)) * 16 + fr; unsigned char* rowp = O + (size_t)(u.row0 + r) * 1024 + col0;
#pragma unroll
                for (int bj = 0; bj < 2; ++bj) { const f32x4 a0 = acc[ai][bj][mp][0] * s, a1 = acc[ai][bj][mp][1] * s, b0 = acc[ai][bj][mp + 1][0] * s, b1 = acc[ai][bj][mp + 1][1] * s;
                    const u32x4 w = widen16((u32x2e_t){pk4_fp8(a0[0], a0[1], a0[2], a0[3]), pk4_fp8(a1[0], a1[1], a1[2], a1[3])}, (u32x2e_t){pk4_fp8(b0[0], b0[1], b0[2], b0[3]), pk4_fp8(b1[0], b1[1], b1[2], b1[3])});
                    if (r < u.nrows) *(u32x4*)(rowp + bj * HALF) = w; } }
    }
};

typedef int v8i32 __attribute__((ext_vector_type(8))); typedef int v4i32 __attribute__((ext_vector_type(4)));
__device__ __forceinline__ v8i32 cat8(bf16x8 a, bf16x8 b) { const v4i32 x = __builtin_bit_cast(v4i32, a), y = __builtin_bit_cast(v4i32, b); return (v8i32){x[0], x[1], x[2], x[3], y[0], y[1], y[2], y[3]}; }
__device__ __forceinline__ void glds_s(const void* sbase, unsigned voff, unsigned lds_dst) { unsigned keep;
    asm volatile("s_mov_b32 %0, m0\n\ts_mov_b32 m0, %3\n\ts_nop 2\n\tglobal_load_lds_dwordx4 %1, %2\n\ts_mov_b32 m0, %0" : "=&s"(keep) : "v"(voff), "s"(sbase), "s"(lds_dst) : "memory"); }
__device__ __forceinline__ const char* uni_ptr(const char* p) { const unsigned long long v = (unsigned long long)p; const unsigned lo = __builtin_amdgcn_readfirstlane((unsigned)v), hi = __builtin_amdgcn_readfirstlane((unsigned)(v >> 32)); return (const char*)(((unsigned long long)hi << 32) | lo); }
template <class Epi, class Sched, bool ALIGN_EPI, bool FP8 = false>
__device__ __forceinline__ void gemm_phase(PG8_LAS unsigned char* lds, const Gemm g, const Sched& S, const Epi& E, const int tid, PG8_LAS unsigned char* park) {
    const int wid = __builtin_amdgcn_readfirstlane(tid >> 6), lane = tid & 63, wr = wid >> 2, wc = wid & 3, fr = lane & 15, fq = lane >> 4;
    const int K = g.K, nt = K / BK;
    unsigned voffB[2];
#pragma unroll
    for (int i = 0; i < 2; ++i) { int R, C; stage_rc(tid * 16 + i * 8192, R, C); const int Rb = Epi::PERM ? ((R & ~31) + perm32(R & 31)) : R; voffB[i] = (unsigned)(Rb * K + C) * 2u; }
    const unsigned kstep = (unsigned)(BK * 2);
    const unsigned hstep = (unsigned)HALF * (unsigned)K * 2u;
    const unsigned ldsw = (unsigned)wid * 1024u;
    const int aoff = lds_byte(wr * 64 + fr, fq * 8), boff = lds_byte(wc * 32 + fr, fq * 8);
    const char* gA = (const char*)g.A;
    const unsigned ldsbase = (unsigned)(size_t)lds;
#define PG8_SA(b, h) (((b) * 2 + (h)) * HTB)
#define PG8_SB(b, h) ((4 + (b) * 2 + (h)) * HTB)
#define PG8_STAGE(bufoff, gbase, voff) do { _Pragma("unroll") for (int _i = 0; _i < 2; ++_i) \
        glds_s(uni_ptr(gbase), (voff)[_i], (unsigned)__builtin_amdgcn_readfirstlane((int)(ldsbase + (unsigned)(bufoff) + ldsw + (unsigned)(_i * 8192)))); } while (0)
#define PG8_LDA(dst, b, h) do { _Pragma("unroll") for (int m = 0; m < 4; ++m) _Pragma("unroll") for (int k = 0; k < 2; ++k) dst[m][k] = *(const PG8_LAS bf16x8*)(lds + PG8_SA(b, h) + aoff + m * 2048 + k * 1024); } while (0)
#define PG8_LDB(dst, b, h) do { _Pragma("unroll") for (int n = 0; n < 2; ++n) _Pragma("unroll") for (int k = 0; k < 2; ++k) dst[n][k] = *(const PG8_LAS bf16x8*)(lds + PG8_SB(b, h) + boff + n * 2048 + k * 1024); } while (0)
#define PG8_MMA(ai, bj, At, Bt) do { __builtin_amdgcn_s_setprio(1); _Pragma("unroll") for (int m = 0; m < 4; ++m) _Pragma("unroll") for (int n = 0; n < 2; ++n) { \
        if constexpr (FP8) acc[ai][bj][m][n] = __builtin_amdgcn_mfma_scale_f32_16x16x128_f8f6f4(cat8(Bt[n][0], Bt[n][1]), cat8(At[m][0], At[m][1]), acc[ai][bj][m][n], 0, 0, 0, 0x7F7F7F7F, 0, 0x7F7F7F7F); \
        else { _Pragma("unroll") for (int k = 0; k < 2; ++k) acc[ai][bj][m][n] = __builtin_amdgcn_mfma_f32_16x16x32_bf16(Bt[n][k], At[m][k], acc[ai][bj][m][n], 0, 0, 0); } } __builtin_amdgcn_s_setprio(0); } while (0)
#define PG8_WAIT_V(n) asm volatile("s_waitcnt vmcnt(" #n ")" ::: "memory")
#define PG8_WAIT_L(n) asm volatile("s_waitcnt lgkmcnt(" #n ")" ::: "memory")
#define PG8_BAR __builtin_amdgcn_s_barrier()
#define PG8_SCHED __builtin_amdgcn_sched_barrier(0)
    Unit cur, nxt; int ui = 0;
    if (!S.next(0, cur)) return;
    f32x4 acc[2][2][4][2];
#pragma unroll
    for (int a = 0; a < 2; ++a)
#pragma unroll
        for (int b = 0; b < 2; ++b)
#pragma unroll
            for (int m = 0; m < 4; ++m)
#pragma unroll
                for (int n = 0; n < 2; ++n) acc[a][b][m][n] = (f32x4){0.f, 0.f, 0.f, 0.f};
    bf16x8 At[4][2], B0[2][2], B1[2][2];
    unsigned offC[2][2];
    S.aoff(cur, tid, offC);
    const char* cB = (const char*)g.Bt + cur.boff;
    PG8_STAGE(PG8_SB(0, 0), cB, voffB); PG8_STAGE(PG8_SB(0, 1), cB + hstep, voffB); PG8_STAGE(PG8_SA(0, 0), gA, offC[0]); PG8_STAGE(PG8_SA(0, 1), gA, offC[1]);
    if (wr == 1) PG8_BAR;
    PG8_WAIT_V(2); PG8_BAR;
    PG8_STAGE(PG8_SB(1, 0), cB + kstep, voffB); PG8_STAGE(PG8_SA(1, 0), gA + kstep, offC[0]); PG8_STAGE(PG8_SB(1, 1), cB + hstep + kstep, voffB);
    PG8_WAIT_V(6); PG8_BAR;
    for (;;) {
        const bool has_next = S.next(ui + 1, nxt);
        const char* nB = has_next ? (const char*)g.Bt + nxt.boff : cB;
#pragma unroll 1
        for (int t = 0; t < nt; t += 2) {
            const bool last = (t == nt - 2);
            const char* a1 = gA + (size_t)(t + 1) * kstep;
            const char* a2 = last ? gA : gA + (size_t)(t + 2) * kstep; const char* b2 = last ? nB : cB + (size_t)(t + 2) * kstep;
            const char* a3 = a2 + kstep; const char* b3 = b2 + kstep;
            PG8_LDB(B0, 0, 0); PG8_LDB(B1, 0, 1); PG8_SCHED; PG8_LDA(At, 0, 0); PG8_STAGE(PG8_SA(1, 1), a1, offC[1]);
            if (last && has_next) {
                { int t2 = tid; asm volatile("" : "+v"(t2)); S.aoff(nxt, t2, offC); } }
            PG8_WAIT_V(8); PG8_WAIT_L(0); PG8_BAR; PG8_MMA(0, 0, At, B0); PG8_MMA(0, 1, At, B1); PG8_BAR; PG8_SCHED;
            PG8_LDA(At, 0, 1); PG8_STAGE(PG8_SB(0, 0), b2, voffB); PG8_STAGE(PG8_SB(0, 1), b2 + hstep, voffB); PG8_STAGE(PG8_SA(0, 0), a2, offC[0]);
            PG8_WAIT_V(8); PG8_WAIT_L(0); PG8_BAR; PG8_MMA(1, 0, At, B0); PG8_MMA(1, 1, At, B1); PG8_BAR; PG8_SCHED;
            PG8_LDB(B0, 1, 0); PG8_LDB(B1, 1, 1); PG8_SCHED; PG8_LDA(At, 1, 0); PG8_STAGE(PG8_SA(0, 1), a2, offC[1]);
            PG8_WAIT_V(8); PG8_WAIT_L(0); PG8_BAR; PG8_MMA(0, 0, At, B0); PG8_MMA(0, 1, At, B1); PG8_BAR; PG8_SCHED;
            PG8_LDA(At, 1, 1); PG8_STAGE(PG8_SB(1, 0), b3, voffB); PG8_STAGE(PG8_SB(1, 1), b3 + hstep, voffB); PG8_STAGE(PG8_SA(1, 0), a3, offC[0]);
            PG8_WAIT_V(8); PG8_WAIT_L(0); PG8_BAR; PG8_MMA(1, 0, At, B0); PG8_MMA(1, 1, At, B1); PG8_BAR; PG8_SCHED;
        }
        if constexpr (ALIGN_EPI) { if (wr == 0) PG8_BAR; }
        E(acc, cur, wr, wc, fr, fq);
        if (!has_next) break;
#pragma unroll
        for (int a = 0; a < 2; ++a)
#pragma unroll
            for (int b = 0; b < 2; ++b)
#pragma unroll
                for (int m = 0; m < 4; ++m)
#pragma unroll
                    for (int n = 0; n < 2; ++n) acc[a][b][m][n] = (f32x4){0.f, 0.f, 0.f, 0.f};
        cur = nxt; cB = nB; ++ui;
        if constexpr (ALIGN_EPI) { if (wr == 1) PG8_BAR; }
    }
    PG8_WAIT_V(0);
    if constexpr (!ALIGN_EPI) { if (wr == 0) PG8_BAR; }
    PG8_BAR;
#undef PG8_SA
#undef PG8_SB
#undef PG8_STAGE
#undef PG8_LDA
#undef PG8_LDB
#undef PG8_MMA
#undef PG8_WAIT_V
#undef PG8_WAIT_L
#undef PG8_BAR
#undef PG8_SCHED
}
}

namespace attn_body {
using bf16=__hip_bfloat16;
using bf16x8=__attribute__((ext_vector_type(8)))short;
using s16x4=__attribute__((ext_vector_type(4)))short;
using f32x16=__attribute__((ext_vector_type(16)))float;
using u32x4=__attribute__((ext_vector_type(4)))unsigned;
#ifndef EMU8
#define EMU8 0
#endif
__device__ __forceinline__ float q8(float x,float s){ if(!EMU8) return x; const unsigned w=__builtin_amdgcn_cvt_pk_fp8_f32(x*s,0.f,0u,false); return __builtin_amdgcn_cvt_f32_fp8((int)w,0)*(1.0f/s); }
constexpr int SEQ=4096,D=64,DM=1024;
constexpr int NW=8,QBLK=32,QB=QBLK*NW,KVBLK=64,NQB=SEQ/QB;
constexpr int ATTN_PITCH=DM, ATTN_UNIT_ROWS=QB;
__device__ __forceinline__ int crow(int r,int hi){return (r&3)+8*(r>>2)+4*hi;}
#define SBAR() __builtin_amdgcn_sched_barrier(0)
__device__ __forceinline__ void cmask(f32x16&p0,f32x16&p1,int jb,int qrel,int hi){
  const float NEG=-INFINITY; int kb=64*jb+4*hi;
  #pragma unroll
  for(int r=0;r<16;++r){int kv=kb+(r&3)+8*(r>>2); if(kv>qrel)p0[r]=NEG; if(kv+32>qrel)p1[r]=NEG;}
}

constexpr int NSLOT=3, SLOTB=8192;
constexpr int LDS_K=0, LDS_V=NSLOT*SLOTB, LDS_WS=2*NSLOT*SLOTB, LDS_OST=LDS_WS+NW*64*4, LDS_BIAS=LDS_OST+NW*4096, LDS_BYTES=LDS_BIAS+SEQ*8;
constexpr float C2=0.125f*1.4426950408889634f;
__device__ __forceinline__ void glds16(const void*sbase,unsigned voff,unsigned lds_dst){unsigned keep;
  asm volatile("s_mov_b32 %0, m0\n\ts_mov_b32 m0, %3\n\ts_nop 2\n\tglobal_load_lds_dwordx4 %1, %2\n\ts_mov_b32 m0, %0":"=&s"(keep):"v"(voff),"s"(sbase),"s"(lds_dst):"memory");}
__device__ __forceinline__ float max3f(float a,float b,float c){float r;asm("v_max3_f32 %0, %1, %2, %3":"=v"(r):"v"(a),"v"(b),"v"(c));return r;}
__device__ __forceinline__ float max2f(float a,float b){float r;asm("v_max_f32_e32 %0, %1, %2":"=v"(r):"v"(a),"v"(b));return r;}
__device__ __forceinline__ float fadd_s(float a,float b){float r;asm("v_add_f32_e32 %0, %1, %2":"=v"(r):"v"(a),"v"(b));return r;}
__device__ __forceinline__ float fsub_s(float a,float b){float r;asm("v_sub_f32_e32 %0, %1, %2":"=v"(r):"v"(a),"v"(b));return r;}
typedef float f32x2_t __attribute__((ext_vector_type(2))); typedef __bf16 bf16x2_t __attribute__((ext_vector_type(2)));
__device__ __forceinline__ unsigned cvtpk_s(float lo,float hi){f32x2_t v={lo,hi};bf16x2_t b=__builtin_convertvector(v,bf16x2_t);return __builtin_bit_cast(unsigned,b);}
#define WAIT_BAR(N) asm volatile("s_waitcnt vmcnt(" #N ") lgkmcnt(0)\n\ts_barrier":::"memory")

__device__ __forceinline__ void qkt(f32x16&p0,f32x16&p1,const char*Kslot,const bf16x8*qr,int r32,int hi){
  const char*kb=Kslot+hi*1024+r32*16;
  #pragma unroll
  for(int d0=0;d0<4;++d0){
    const bf16x8 b0=*reinterpret_cast<const bf16x8*>(kb+d0*2048);
    const bf16x8 b1=*reinterpret_cast<const bf16x8*>(kb+d0*2048+512);
    {p0=__builtin_amdgcn_mfma_f32_32x32x16_bf16(b0,qr[d0],p0,0,0,0);p1=__builtin_amdgcn_mfma_f32_32x32x16_bf16(b1,qr[d0],p1,0,0,0);}}
}
typedef __attribute__((address_space(3))) const char* lds_cptr;
typedef short v4i16_t __attribute__((ext_vector_type(4)));
__device__ __forceinline__ void kload8(bf16x8*kf,lds_cptr kp){
  kf[0]=*(const __attribute__((address_space(3))) bf16x8*)(kp);      kf[1]=*(const __attribute__((address_space(3))) bf16x8*)(kp+512);
  kf[2]=*(const __attribute__((address_space(3))) bf16x8*)(kp+2048); kf[3]=*(const __attribute__((address_space(3))) bf16x8*)(kp+2560);
  kf[4]=*(const __attribute__((address_space(3))) bf16x8*)(kp+4096); kf[5]=*(const __attribute__((address_space(3))) bf16x8*)(kp+4608);
  kf[6]=*(const __attribute__((address_space(3))) bf16x8*)(kp+6144); kf[7]=*(const __attribute__((address_space(3))) bf16x8*)(kp+6656);
}
__device__ __forceinline__ void kload2(bf16x8*kf,lds_cptr kp,int j){ kf[2*j]=*(const __attribute__((address_space(3))) bf16x8*)(kp+j*2048); kf[2*j+1]=*(const __attribute__((address_space(3))) bf16x8*)(kp+j*2048+512); }
__device__ __forceinline__ s16x4 vtr(lds_cptr p){ return __builtin_bit_cast(s16x4,__builtin_amdgcn_ds_read_tr16_b64_v4i16((__attribute__((address_space(3))) v4i16_t*)p)); }
__device__ __forceinline__ float rowmax(const f32x16&p0,const f32x16&p1){
  float a=max3f(p0[0],p0[1],p1[0]),b=max3f(p0[2],p0[3],p1[1]);a=max3f(a,p1[2],p1[3]);
  #pragma unroll
  for(int r=4;r<16;r+=4){a=max3f(a,p0[r],p0[r+1]);b=max3f(b,p0[r+2],p0[r+3]);a=max3f(a,p1[r],p1[r+1]);b=max3f(b,p1[r+2],p1[r+3]);}
  const float m=max2f(a,b);
  auto rr=__builtin_amdgcn_permlane32_swap(__float_as_uint(m),__float_as_uint(m),false,false);
  return max2f(__uint_as_float(rr[0]),__uint_as_float(rr[1]));
}
__device__ __forceinline__ void pv(f32x16*o,int vb,bf16x8 pa0,bf16x8 pa1,bf16x8 pa2,bf16x8 pa3){
  #pragma unroll
  for(int d0=0;d0<2;++d0){s16x4 lo[4],hi[4];
    #pragma unroll
    for(int ks=0;ks<4;++ks){
      asm volatile("ds_read_b64_tr_b16 %0,%1 offset:%c2":"=&v"(lo[ks]):"v"(vb),"i"(d0*4096+ks*1024):"memory");
      asm volatile("ds_read_b64_tr_b16 %0,%1 offset:%c2":"=&v"(hi[ks]):"v"(vb),"i"(d0*4096+ks*1024+512):"memory");}
    asm volatile("s_waitcnt lgkmcnt(0)":::"memory");SBAR();
    #define PK(k) (bf16x8){lo[k][0],lo[k][1],lo[k][2],lo[k][3],hi[k][0],hi[k][1],hi[k][2],hi[k][3]}
    o[d0]=__builtin_amdgcn_mfma_f32_32x32x16_bf16(pa0,PK(0),o[d0],0,0,0);
    o[d0]=__builtin_amdgcn_mfma_f32_32x32x16_bf16(pa1,PK(1),o[d0],0,0,0);
    o[d0]=__builtin_amdgcn_mfma_f32_32x32x16_bf16(pa2,PK(2),o[d0],0,0,0);
    o[d0]=__builtin_amdgcn_mfma_f32_32x32x16_bf16(pa3,PK(3),o[d0],0,0,0);
    #undef PK
  }
}

#ifndef ATTN_STORE16
#define ATTN_STORE16(p,v) (*(u32x4*)(p)=(v))
#endif
typedef float f32x4v __attribute__((ext_vector_type(4)));
typedef unsigned u32x2v __attribute__((ext_vector_type(2)));
#define KAF(ka) __builtin_bit_cast(bf16x8,(u32x4){(ka)[0],(ka)[1],0x3F803F80u,0x00003F80u})
#define KAR(tt) do{ ka0=*(const __attribute__((address_space(3))) u32x2v*)(kap+(tt)*512); ka1=*(const __attribute__((address_space(3))) u32x2v*)(kap+(tt)*512+256); }while(0)
__device__ __forceinline__ float ka_value(u32x2v w){ return (__uint_as_float(w[0]<<16)+__uint_as_float(w[0]&0xffff0000u))+__uint_as_float(w[1]<<16); }
__device__ __forceinline__ u32x2v ka_split(float b){ const unsigned h=cvtpk_s(b,0.f)&0xffffu; const float r1=b-__uint_as_float(h<<16); const unsigned m=cvtpk_s(r1,0.f)&0xffffu; const float r2=r1-__uint_as_float(m<<16); const unsigned l=cvtpk_s(r2,0.f)&0xffffu; return (u32x2v){h|(m<<16),l}; }
template<int THRL> __device__ __forceinline__ void attn_unit(int qb,int t0,const bf16*Qb,const bf16*__restrict__ Kb,const bf16*__restrict__ Vb,bf16*Ob,char*shm,const int tid,const float bh,const float osc){
  const int lane=tid&63,r32=lane&31,hi=lane>>5; const int wid=__builtin_amdgcn_readfirstlane(tid>>6);
  const int q0=qb*QB;
  const bf16*Qw=Qb+(long)(q0+wid*QBLK)*DM;
  const bf16*Kh=Kb+(long)t0*KVBLK*DM,*Vh=Vb+(long)t0*KVBLK*DM;
  const unsigned lds0=(unsigned)(uintptr_t)shm;
  float*wsf=(float*)(shm+LDS_WS)+wid*64;
  const unsigned ksrc=(unsigned)(lane*DM+wid*8)*2u;
  const unsigned vsrc=(unsigned)((16*(wid&3)+(lane>>2))*DM+(wid>>2)*32+(lane&3)*8)*2u;
  const unsigned kdst=lds0+LDS_K+wid*1024, vdst=lds0+LDS_V+wid*1024;
  #define DMA_K(t,slot) glds16(Kh+(long)(t)*KVBLK*DM,ksrc,(unsigned)__builtin_amdgcn_readfirstlane(kdst+(slot)))
  #define DMA_V(t,slot) glds16(Vh+(long)(t)*KVBLK*DM,vsrc,(unsigned)__builtin_amdgcn_readfirstlane(vdst+(slot)))
  const int vb0=(int)(lds0+LDS_V)+((lane>>4)&1)*32+(lane&3)*8+(4*hi+((lane&15)>>2))*64;
  const char*Kbase=shm+LDS_K; bf16x8 kf[8];
  const lds_cptr shm3=(lds_cptr)shm; const lds_cptr kap=shm3+LDS_BIAS+t0*512+r32*8; const lds_cptr kp0=shm3+LDS_K+hi*1024+r32*16; const lds_cptr vp0=shm3+LDS_V+((lane>>4)&1)*32+(lane&3)*8+(4*hi+((lane&15)>>2))*64;
  const int NT=(q0+QB)/KVBLK-t0;
  DMA_K(0,0);DMA_V(0,0);DMA_K(1,SLOTB);
  bf16x8 qr[4];
  #pragma unroll
  for(int d0=0;d0<4;++d0)qr[d0]=*reinterpret_cast<const bf16x8*>(&Qw[(long)r32*DM+d0*16+hi*8]);
  float z_=0.f;asm volatile("":"+v"(z_));float l_reg=z_;f32x16 o[2];
  const float mhat=ka_value(*(const __attribute__((address_space(3))) u32x2v*)((lds_cptr)shm+LDS_BIAS+(q0+wid*QBLK+r32)*8))+bh;
  bf16x8 qa; { const u32x2v nm=ka_split(-mhat); const u32x4 w=hi==0?(u32x4){0x3F803F80u,0x00003F80u,nm[0],nm[1]}:(u32x4){0u,0u,0u,0u}; qa=__builtin_bit_cast(bf16x8,w); }
  u32x2v ka0,ka1;
  #pragma unroll
  for(int r=0;r<16;++r){o[0][r]=z_;o[1][r]=z_;}
  const int qrel=wid*QBLK+r32;
  #define CMASK(P0,P1,t) do{int jb_=(t)-(NT-4); if(jb_>=0)cmask(P0,P1,jb_,qrel,hi);}while(0)
  #define START(P0,P1) do{ _Pragma("unroll") for(int r=0;r<16;++r)P0[r]=__builtin_amdgcn_exp2f(P0[r]); }while(0)
  #define RESC() do{}while(0)
  f32x16 pA0,pA1,pB0,pB1;
  int sl_prev=0,sl_cur=0,sl_next=SLOTB;
  #define ROT() do{sl_prev=sl_cur;sl_cur=sl_next;sl_next=(sl_next==(NSLOT-1)*SLOTB)?0:sl_next+SLOTB;}while(0)
  DMA_K(2,2*SLOTB);
  WAIT_BAR(3);
  KAR(0); pA0=__builtin_amdgcn_mfma_f32_32x32x16_bf16(KAF(ka0),qa,f32x16{},0,0,0); pA1=__builtin_amdgcn_mfma_f32_32x32x16_bf16(KAF(ka1),qa,f32x16{},0,0,0);
  qkt(pA0,pA1,Kbase,qr,r32,hi);asm volatile("s_nop 15\n\ts_nop 7":"+v"(pA0),"+v"(pA1));CMASK(pA0,pA1,0);
  START(pA0,pA1);
  _Pragma("unroll") for(int r=0;r<16;++r)pA1[r]=__builtin_amdgcn_exp2f(pA1[r]);
  WAIT_BAR(0);
  DMA_K(3,0);DMA_V(1,SLOTB);
  ROT();
  kload8(kf,kp0+sl_cur); KAR(1);
  WAIT_BAR(2);
  s16x4 vlo[8],vhi[8]; u32x4 pw0,pw1,pw2,pw3;
  #define PKW(P,B) cvtpk_s(P[B],P[B+1])
  #define PAF(k) __builtin_bit_cast(bf16x8,pw##k)
  #define VFR(i) (bf16x8){vlo[i][0],vlo[i][1],vlo[i][2],vlo[i][3],vhi[i][0],vhi[i][1],vhi[i][2],vhi[i][3]}
  #define PIN(x) asm volatile("":"+v"(x))
  #define MX3(a,b,c) __builtin_fmaxf(__builtin_fmaxf((a),(b)),(c))
  #define GAPA(MF,A0,A1,A2,A3,W0,W1,PW) do{ MF; sacc+=A0; sacc+=A1; sacc+=A2; sacc+=A3; PIN(sacc); W0; W1; PIN(PW); SBAR(); }while(0)
  #define EX(v) __builtin_amdgcn_exp2f(v)
  #define GAPB(MF,X,B) do{ MF; X[B]=EX(X[B]); X[B+1]=EX(X[B+1]); X[B+2]=EX(X[B+2]); X[B+3]=EX(X[B+3]); PIN(X); SBAR(); }while(0)
  #define VRD(i) do{ vlo[i]=vtr(vp_+(((i)>>2)*4096+((i)&3)*1024)); vhi[i]=vtr(vp_+(((i)>>2)*4096+((i)&3)*1024+512)); }while(0)
  #define KRD(G,j) do{ if(G){ kload2(kf,kp0+sl_next,j); SBAR(); } }while(0)
  #define STEP(C0,C1,P0,P1,t,GK,GV,GL) do{ SBAR(); \
    const lds_cptr vp_=vp0+sl_prev; \
    C0=__builtin_amdgcn_mfma_f32_32x32x16_bf16(KAF(ka0),qa,f32x16{},0,0,0); C1=__builtin_amdgcn_mfma_f32_32x32x16_bf16(KAF(ka1),qa,f32x16{},0,0,0); SBAR(); \
    VRD(0); SBAR(); float sacc=(P0[0]+P0[1]); \
    GAPA(C0=__builtin_amdgcn_mfma_f32_32x32x16_bf16(kf[0],qr[0],C0,0,0,0), P0[2],P0[3],P0[4],P0[5],     pw0[0]=PKW(P0,0), pw0[1]=PKW(P0,2), pw0); \
    VRD(4); SBAR(); GAPA(C1=__builtin_amdgcn_mfma_f32_32x32x16_bf16(kf[1],qr[0],C1,0,0,0), P0[6],P0[7],P0[8],P0[9],     pw0[2]=PKW(P0,4), pw0[3]=PKW(P0,6), pw0); \
    VRD(1); SBAR(); GAPA(C0=__builtin_amdgcn_mfma_f32_32x32x16_bf16(kf[2],qr[1],C0,0,0,0),   P0[10],P0[11],P0[12],P0[13], pw1[0]=PKW(P0,8), pw1[1]=PKW(P0,10), pw1); \
    VRD(5); SBAR(); GAPA(C1=__builtin_amdgcn_mfma_f32_32x32x16_bf16(kf[3],qr[1],C1,0,0,0),   P0[14],P0[15],P1[0],P1[1],   pw1[2]=PKW(P0,12),pw1[3]=PKW(P0,14), pw1); \
    VRD(2); SBAR(); GAPA(C0=__builtin_amdgcn_mfma_f32_32x32x16_bf16(kf[4],qr[2],C0,0,0,0),   P1[2],P1[3],P1[4],P1[5],     pw2[0]=PKW(P1,0), pw2[1]=PKW(P1,2), pw2); \
    VRD(6); SBAR(); GAPA(C1=__builtin_amdgcn_mfma_f32_32x32x16_bf16(kf[5],qr[2],C1,0,0,0),   P1[6],P1[7],P1[8],P1[9],     pw2[2]=PKW(P1,4), pw2[3]=PKW(P1,6), pw2); \
    VRD(3); SBAR(); GAPA(C0=__builtin_amdgcn_mfma_f32_32x32x16_bf16(kf[6],qr[3],C0,0,0,0),   P1[10],P1[11],P1[12],P1[13], pw3[0]=PKW(P1,8), pw3[1]=PKW(P1,10), pw3); \
    VRD(7); SBAR(); GAPA(C1=__builtin_amdgcn_mfma_f32_32x32x16_bf16(kf[7],qr[3],C1,0,0,0),   P1[14],P1[15],0.f,0.f,       pw3[2]=PKW(P1,12),pw3[3]=PKW(P1,14), pw3); \
    l_reg+=sacc; \
    if(GK){DMA_K((t)+3,sl_cur);} if(GV){DMA_V((t)+1,sl_next);} \
    CMASK(C0,C1,t); \
    SBAR(); \
    GAPB(o[0]=__builtin_amdgcn_mfma_f32_32x32x16_bf16(PAF(0),VFR(0),o[0],0,0,0), C0,0); \
    GAPB(o[1]=__builtin_amdgcn_mfma_f32_32x32x16_bf16(PAF(0),VFR(4),o[1],0,0,0), C0,4); \
    if(GL){KAR((t)+1);} KRD(GL,0); GAPB(o[0]=__builtin_amdgcn_mfma_f32_32x32x16_bf16(PAF(1),VFR(1),o[0],0,0,0), C0,8); \
    KRD(GL,1); GAPB(o[1]=__builtin_amdgcn_mfma_f32_32x32x16_bf16(PAF(1),VFR(5),o[1],0,0,0), C0,12); \
    KRD(GL,2); GAPB(o[0]=__builtin_amdgcn_mfma_f32_32x32x16_bf16(PAF(2),VFR(2),o[0],0,0,0), C1,0); \
    KRD(GL,3); GAPB(o[1]=__builtin_amdgcn_mfma_f32_32x32x16_bf16(PAF(2),VFR(6),o[1],0,0,0), C1,4); \
    GAPB(o[0]=__builtin_amdgcn_mfma_f32_32x32x16_bf16(PAF(3),VFR(3),o[0],0,0,0), C1,8); \
    GAPB(o[1]=__builtin_amdgcn_mfma_f32_32x32x16_bf16(PAF(3),VFR(7),o[1],0,0,0), C1,12); \
    }while(0)
  int t=1;
  #undef CMASK
  #define CMASK(P0,P1,t) do{}while(0)
  for(;t+5<NT;t+=2){
    STEP(pB0,pB1,pA0,pA1,t,true,true,true);     WAIT_BAR(2); RESC(); ROT();
    STEP(pA0,pA1,pB0,pB1,t+1,true,true,true);   WAIT_BAR(2); RESC(); ROT();
  }
  #undef CMASK
  #define CMASK(P0,P1,t) do{int jb_=(t)-(NT-4); if(jb_>=0)cmask(P0,P1,jb_,qrel,hi);}while(0)
  #define ENDW(tt) do{ if((tt)+3<NT){WAIT_BAR(2);} else if((tt)+2<NT){WAIT_BAR(1);} else {WAIT_BAR(0);} }while(0)
  for(;t+1<NT;t+=2){
    STEP(pB0,pB1,pA0,pA1,t,(t+3<NT),(t+1<NT),(t+1<NT));       ENDW(t);   RESC(); ROT();
    STEP(pA0,pA1,pB0,pB1,t+1,(t+4<NT),(t+2<NT),(t+2<NT));     ENDW(t+1); RESC(); ROT();
  }
  STEP(pB0,pB1,pA0,pA1,NT-1,false,false,false); RESC();
  { float sacc=pB0[0]+pB0[1]; _Pragma("unroll") for(int r=2;r<16;++r)sacc+=pB0[r]; _Pragma("unroll") for(int r=0;r<16;++r)sacc+=pB1[r]; l_reg+=sacc;
    pw0=(u32x4){PKW(pB0,0),PKW(pB0,2),PKW(pB0,4),PKW(pB0,6)};pw1=(u32x4){PKW(pB0,8),PKW(pB0,10),PKW(pB0,12),PKW(pB0,14)};pw2=(u32x4){PKW(pB1,0),PKW(pB1,2),PKW(pB1,4),PKW(pB1,6)};pw3=(u32x4){PKW(pB1,8),PKW(pB1,10),PKW(pB1,12),PKW(pB1,14)};
    SBAR(); pv(o,vb0+sl_cur,PAF(0),PAF(1),PAF(2),PAF(3)); }
  #undef PKW
  #undef PAF
  #undef VFR
  #undef PIN
  #undef MX3
  #undef GAPA
  #undef GAPB
  #undef EX
  #undef VRD
  #undef KRD
  #undef STEP
  #undef ENDW
  {auto rr=__builtin_amdgcn_permlane32_swap(__float_as_uint(l_reg),__float_as_uint(l_reg),false,false);l_reg=__uint_as_float(rr[0])+__uint_as_float(rr[1]);}
  if(hi==0)wsf[32+r32]=l_reg;asm volatile("s_waitcnt lgkmcnt(0)":::"memory");
  float rli[16];
  #pragma unroll
  for(int r=0;r<16;++r)rli[r]=__builtin_amdgcn_rcpf(wsf[32+crow(r,hi)]);
  { unsigned char*stg=(unsigned char*)(shm+LDS_OST)+wid*4096;
    unsigned char*Ow8=(unsigned char*)Ob+(long)(q0+wid*QBLK)*DM;
    #pragma unroll
    for(int r=0;r<16;++r){const int orow=crow(r,hi); const float s_=rli[r]*osc;
      #pragma unroll
      for(int d0=0;d0<2;++d0)stg[orow*64+d0*32+r32]=(unsigned char)(__builtin_amdgcn_cvt_pk_fp8_f32(o[d0][r]*s_,0.f,0u,false)&0xffu);}
    asm volatile("s_waitcnt lgkmcnt(0)":::"memory");
    #pragma unroll
    for(int i=0;i<2;++i){const int row=i*16+(lane>>2),ch=lane&3; const u32x4 v=*(const u32x4*)(stg+row*64+ch*16); ATTN_STORE16(Ow8+(long)row*DM+ch*16,v);} }
  asm volatile("s_waitcnt lgkmcnt(0)\n\ts_barrier":::"memory");
  #undef DMA_K
  #undef DMA_V
  #undef CMASK
  #undef START
  #undef RESC
  #undef ROT
}

constexpr int V128_SLOTB=16384, LDS128_K=0, LDS128_V=NSLOT*SLOTB, LDS128_WS=LDS128_V+NSLOT*V128_SLOTB, LDS128_OST=LDS128_WS+NW*64*4, LDS128_BIAS=LDS128_OST+NW*4096, LDS128_BYTES=LDS128_BIAS+SEQ*8;
__device__ __forceinline__ void pv4(f32x16*o,int vb,bf16x8 pa0,bf16x8 pa1,bf16x8 pa2,bf16x8 pa3){
  #pragma unroll
  for(int d0=0;d0<4;++d0){s16x4 lo[4],hi[4];
    #pragma unroll
    for(int ks=0;ks<4;++ks){
      asm volatile("ds_read_b64_tr_b16 %0,%1 offset:%c2":"=&v"(lo[ks]):"v"(vb),"i"(d0*4096+ks*1024):"memory");
      asm volatile("ds_read_b64_tr_b16 %0,%1 offset:%c2":"=&v"(hi[ks]):"v"(vb),"i"(d0*4096+ks*1024+512):"memory");}
    asm volatile("s_waitcnt lgkmcnt(0)":::"memory");SBAR();
    #define PK(k) (bf16x8){lo[k][0],lo[k][1],lo[k][2],lo[k][3],hi[k][0],hi[k][1],hi[k][2],hi[k][3]}
    o[d0]=__builtin_amdgcn_mfma_f32_32x32x16_bf16(pa0,PK(0),o[d0],0,0,0);
    o[d0]=__builtin_amdgcn_mfma_f32_32x32x16_bf16(pa1,PK(1),o[d0],0,0,0);
    o[d0]=__builtin_amdgcn_mfma_f32_32x32x16_bf16(pa2,PK(2),o[d0],0,0,0);
    o[d0]=__builtin_amdgcn_mfma_f32_32x32x16_bf16(pa3,PK(3),o[d0],0,0,0);
    #undef PK
  }
}
__device__ __forceinline__ void attn_unit128(int qb,int t0,const bf16*Qb,const bf16*__restrict__ Kb,const bf16*__restrict__ Vb,bf16*Ob,char*shm,const int tid,const float bh){
  const int lane=tid&63,r32=lane&31,hi=lane>>5; const int wid=__builtin_amdgcn_readfirstlane(tid>>6);
  const int q0=qb*QB;
  const bf16*Qw=Qb+(long)(q0+wid*QBLK)*DM;
  const bf16*Kh=Kb+(long)t0*KVBLK*DM,*Vh=Vb+(long)t0*KVBLK*DM;
  const unsigned lds0=(unsigned)(uintptr_t)shm;
  float*wsf=(float*)(shm+LDS128_WS)+wid*64;
  const unsigned ksrc=(unsigned)(lane*DM+wid*8)*2u;
  const unsigned vsrc=(unsigned)((16*(wid&3)+(lane>>2))*DM+(wid>>2)*32+(lane&3)*8)*2u;
  const unsigned kdst=lds0+LDS128_K+wid*1024, vdst=lds0+LDS128_V+wid*1024;
  #define DMA_K(t,slot) glds16(Kh+(long)(t)*KVBLK*DM,ksrc,(unsigned)__builtin_amdgcn_readfirstlane(kdst+(slot)))
  #define DMA_V(t,slot) do{ glds16(Vh+(long)(t)*KVBLK*DM,vsrc,(unsigned)__builtin_amdgcn_readfirstlane(vdst+2*(slot))); glds16(Vh+(long)(t)*KVBLK*DM+64,vsrc,(unsigned)__builtin_amdgcn_readfirstlane(vdst+2*(slot)+8192)); }while(0)
  const int vb0=(int)(lds0+LDS128_V)+((lane>>4)&1)*32+(lane&3)*8+(4*hi+((lane&15)>>2))*64;
  const char*Kbase=shm+LDS128_K; bf16x8 kf[8];
  const lds_cptr shm3=(lds_cptr)shm; const lds_cptr kap=shm3+LDS128_BIAS+t0*512+r32*8; const lds_cptr kp0=shm3+LDS128_K+hi*1024+r32*16; const lds_cptr vp0=shm3+LDS128_V+((lane>>4)&1)*32+(lane&3)*8+(4*hi+((lane&15)>>2))*64;
  const int NT=(q0+QB)/KVBLK-t0;
  DMA_K(0,0);DMA_V(0,0);DMA_K(1,SLOTB);
  bf16x8 qr[4];
  #pragma unroll
  for(int d0=0;d0<4;++d0)qr[d0]=*reinterpret_cast<const bf16x8*>(&Qw[(long)r32*DM+d0*16+hi*8]);
  float z_=0.f;asm volatile("":"+v"(z_));float l_reg=z_;f32x16 o[4];
  const float mhat=ka_value(*(const __attribute__((address_space(3))) u32x2v*)((lds_cptr)shm+LDS128_BIAS+(q0+wid*QBLK+r32)*8))+bh;
  bf16x8 qa; { const u32x2v nm=ka_split(-mhat); const u32x4 w=hi==0?(u32x4){0x3F803F80u,0x00003F80u,nm[0],nm[1]}:(u32x4){0u,0u,0u,0u}; qa=__builtin_bit_cast(bf16x8,w); }
  u32x2v ka0,ka1;
  #pragma unroll
  for(int r=0;r<16;++r){o[0][r]=z_;o[1][r]=z_;o[2][r]=z_;o[3][r]=z_;}
  const int qrel=wid*QBLK+r32;
  #define CMASK(P0,P1,t) do{int jb_=(t)-(NT-4); if(jb_>=0)cmask(P0,P1,jb_,qrel,hi);}while(0)
  f32x16 C0,C1;
  int sl_prev=0,sl_cur=0,sl_next=SLOTB;
  #define ROT() do{sl_prev=sl_cur;sl_cur=sl_next;sl_next=(sl_next==(NSLOT-1)*SLOTB)?0:sl_next+SLOTB;}while(0)
  DMA_K(2,2*SLOTB);
  WAIT_BAR(4);
  s16x4 vlo[8],vhi[8]; u32x4 pwA0,pwA1,pwA2,pwA3,pwB0,pwB1,pwB2,pwB3;
  #define PKW(P,B) cvtpk_s(P[B],P[B+1])
  #define PAF(S,k) __builtin_bit_cast(bf16x8,pw##S##k)
  #define VFR(i) (bf16x8){vlo[i][0],vlo[i][1],vlo[i][2],vlo[i][3],vhi[i][0],vhi[i][1],vhi[i][2],vhi[i][3]}
  #define PIN(x) asm volatile("":"+v"(x))
  #define EX(v) __builtin_amdgcn_exp2f(v)
  KAR(0); C0=__builtin_amdgcn_mfma_f32_32x32x16_bf16(KAF(ka0),qa,f32x16{},0,0,0); C1=__builtin_amdgcn_mfma_f32_32x32x16_bf16(KAF(ka1),qa,f32x16{},0,0,0);
  qkt(C0,C1,Kbase,qr,r32,hi);asm volatile("s_nop 15\n\ts_nop 7":"+v"(C0),"+v"(C1));CMASK(C0,C1,0);
  { float sacc=z_;
    _Pragma("unroll") for(int r=0;r<16;++r){C0[r]=EX(C0[r]);C1[r]=EX(C1[r]);}
    _Pragma("unroll") for(int r=0;r<16;++r){sacc+=C0[r];sacc+=C1[r];}
    l_reg+=sacc;
    pwA0=(u32x4){PKW(C0,0),PKW(C0,2),PKW(C0,4),PKW(C0,6)};pwA1=(u32x4){PKW(C0,8),PKW(C0,10),PKW(C0,12),PKW(C0,14)};pwA2=(u32x4){PKW(C1,0),PKW(C1,2),PKW(C1,4),PKW(C1,6)};pwA3=(u32x4){PKW(C1,8),PKW(C1,10),PKW(C1,12),PKW(C1,14)}; }
  WAIT_BAR(0);
  DMA_K(3,0);DMA_V(1,SLOTB);
  ROT();
  kload8(kf,kp0+sl_cur); KAR(1);
  WAIT_BAR(3);
  #define VRD(i) do{ vlo[i]=vtr(vp_+(((i)>>2)*4096+((i)&3)*1024)); vhi[i]=vtr(vp_+(((i)>>2)*4096+((i)&3)*1024+512)); }while(0)
  #define VRD2(i) do{ vlo[i]=vtr(vp_+((2+((i)>>2))*4096+((i)&3)*1024)); vhi[i]=vtr(vp_+((2+((i)>>2))*4096+((i)&3)*1024+512)); }while(0)
  #define KRD(G,j) do{ if(G){ kload2(kf,kp0+sl_next,j); SBAR(); } }while(0)
  #define QKG(V,MF) do{ VRD(V); SBAR(); MF; SBAR(); }while(0)
  #define GB(MF,X,B,W,AFTER) do{ MF; { const float e0_=EX(X[B]), e1_=EX(X[B+1]); sacc+=e0_; sacc+=e1_; W=cvtpk_s(e0_,e1_); } PIN(sacc); PIN(W); AFTER; SBAR(); }while(0)
  #define STEP128(P,N,t,GK,GV,GL) do{ SBAR(); \
    const lds_cptr vp_=vp0+2*sl_prev; \
    C0=__builtin_amdgcn_mfma_f32_32x32x16_bf16(KAF(ka0),qa,f32x16{},0,0,0); C1=__builtin_amdgcn_mfma_f32_32x32x16_bf16(KAF(ka1),qa,f32x16{},0,0,0); SBAR(); \
    QKG(0,C0=__builtin_amdgcn_mfma_f32_32x32x16_bf16(kf[0],qr[0],C0,0,0,0)); \
    QKG(4,C1=__builtin_amdgcn_mfma_f32_32x32x16_bf16(kf[1],qr[0],C1,0,0,0)); \
    QKG(1,C0=__builtin_amdgcn_mfma_f32_32x32x16_bf16(kf[2],qr[1],C0,0,0,0)); \
    QKG(5,C1=__builtin_amdgcn_mfma_f32_32x32x16_bf16(kf[3],qr[1],C1,0,0,0)); \
    QKG(2,C0=__builtin_amdgcn_mfma_f32_32x32x16_bf16(kf[4],qr[2],C0,0,0,0)); \
    QKG(6,C1=__builtin_amdgcn_mfma_f32_32x32x16_bf16(kf[5],qr[2],C1,0,0,0)); \
    QKG(3,C0=__builtin_amdgcn_mfma_f32_32x32x16_bf16(kf[6],qr[3],C0,0,0,0)); \
    QKG(7,C1=__builtin_amdgcn_mfma_f32_32x32x16_bf16(kf[7],qr[3],C1,0,0,0)); \
    if(GK){DMA_K((t)+3,sl_cur);} if(GV){DMA_V((t)+1,sl_next);} \
    CMASK(C0,C1,t); \
    SBAR(); \
    float sacc=z_; \
    GB(o[0]=__builtin_amdgcn_mfma_f32_32x32x16_bf16(PAF(P,0),VFR(0),o[0],0,0,0), C0,0, pw##N##0[0], VRD2(0)); \
    GB(o[1]=__builtin_amdgcn_mfma_f32_32x32x16_bf16(PAF(P,0),VFR(4),o[1],0,0,0), C0,2, pw##N##0[1], VRD2(4)); \
    GB(o[0]=__builtin_amdgcn_mfma_f32_32x32x16_bf16(PAF(P,1),VFR(1),o[0],0,0,0), C0,4, pw##N##0[2], VRD2(1)); \
    GB(o[1]=__builtin_amdgcn_mfma_f32_32x32x16_bf16(PAF(P,1),VFR(5),o[1],0,0,0), C0,6, pw##N##0[3], VRD2(5)); \
    GB(o[0]=__builtin_amdgcn_mfma_f32_32x32x16_bf16(PAF(P,2),VFR(2),o[0],0,0,0), C0,8, pw##N##1[0], VRD2(2)); \
    GB(o[1]=__builtin_amdgcn_mfma_f32_32x32x16_bf16(PAF(P,2),VFR(6),o[1],0,0,0), C0,10,pw##N##1[1], VRD2(6)); \
    GB(o[0]=__builtin_amdgcn_mfma_f32_32x32x16_bf16(PAF(P,3),VFR(3),o[0],0,0,0), C0,12,pw##N##1[2], VRD2(3)); \
    GB(o[1]=__builtin_amdgcn_mfma_f32_32x32x16_bf16(PAF(P,3),VFR(7),o[1],0,0,0), C0,14,pw##N##1[3], VRD2(7)); \
    GB(o[2]=__builtin_amdgcn_mfma_f32_32x32x16_bf16(PAF(P,0),VFR(0),o[2],0,0,0), C1,0, pw##N##2[0], if(GL){KAR((t)+1);}); \
    GB(o[3]=__builtin_amdgcn_mfma_f32_32x32x16_bf16(PAF(P,0),VFR(4),o[3],0,0,0), C1,2, pw##N##2[1], KRD(GL,0)); \
    GB(o[2]=__builtin_amdgcn_mfma_f32_32x32x16_bf16(PAF(P,1),VFR(1),o[2],0,0,0), C1,4, pw##N##2[2], KRD(GL,1)); \
    GB(o[3]=__builtin_amdgcn_mfma_f32_32x32x16_bf16(PAF(P,1),VFR(5),o[3],0,0,0), C1,6, pw##N##2[3], KRD(GL,2)); \
    GB(o[2]=__builtin_amdgcn_mfma_f32_32x32x16_bf16(PAF(P,2),VFR(2),o[2],0,0,0), C1,8, pw##N##3[0], KRD(GL,3)); \
    GB(o[3]=__builtin_amdgcn_mfma_f32_32x32x16_bf16(PAF(P,2),VFR(6),o[3],0,0,0), C1,10,pw##N##3[1], (void)0); \
    GB(o[2]=__builtin_amdgcn_mfma_f32_32x32x16_bf16(PAF(P,3),VFR(3),o[2],0,0,0), C1,12,pw##N##3[2], (void)0); \
    GB(o[3]=__builtin_amdgcn_mfma_f32_32x32x16_bf16(PAF(P,3),VFR(7),o[3],0,0,0), C1,14,pw##N##3[3], (void)0); \
    l_reg+=sacc; \
    }while(0)
  int t=1;
  #undef CMASK
  #define CMASK(P0,P1,t) do{}while(0)
  for(;t+5<NT;t+=2){
    STEP128(A,B,t,true,true,true);     WAIT_BAR(3); ROT();
    STEP128(B,A,t+1,true,true,true);   WAIT_BAR(3); ROT();
  }
  #undef CMASK
  #define CMASK(P0,P1,t) do{int jb_=(t)-(NT-4); if(jb_>=0)cmask(P0,P1,jb_,qrel,hi);}while(0)
  #define ENDW(tt) do{ if((tt)+3<NT){WAIT_BAR(3);} else if((tt)+2<NT){WAIT_BAR(2);} else {WAIT_BAR(0);} }while(0)
  for(;t+1<NT;t+=2){
    STEP128(A,B,t,(t+3<NT),(t+1<NT),(t+1<NT));       ENDW(t);   ROT();
    STEP128(B,A,t+1,(t+4<NT),(t+2<NT),(t+2<NT));     ENDW(t+1); ROT();
  }
  STEP128(A,B,NT-1,false,false,false);
  SBAR(); pv4(o,vb0+2*sl_cur,PAF(B,0),PAF(B,1),PAF(B,2),PAF(B,3));
  #undef PKW
  #undef PAF
  #undef VFR
  #undef PIN
  #undef EX
  #undef VRD
  #undef VRD2
  #undef KRD
  #undef QKG
  #undef GB
  #undef STEP128
  #undef ENDW
  {auto rr=__builtin_amdgcn_permlane32_swap(__float_as_uint(l_reg),__float_as_uint(l_reg),false,false);l_reg=__uint_as_float(rr[0])+__uint_as_float(rr[1]);}
  if(hi==0)wsf[32+r32]=l_reg;asm volatile("s_waitcnt lgkmcnt(0)":::"memory");
  float rli[16];
  #pragma unroll
  for(int r=0;r<16;++r)rli[r]=__builtin_amdgcn_rcpf(wsf[32+crow(r,hi)]);
  bf16*Ow=Ob+(long)(q0+wid*QBLK)*DM;
  #pragma unroll
  for(int hf=0;hf<2;++hf){ bf16*stg=(bf16*)(shm+LDS128_OST)+wid*2048;
    #pragma unroll
    for(int r=0;r<16;++r){const int orow=crow(r,hi);
      #pragma unroll
      for(int d0=0;d0<2;++d0)stg[orow*64+d0*32+r32]=__float2bfloat16(o[2*hf+d0][r]*rli[r]);}
    asm volatile("s_waitcnt lgkmcnt(0)":::"memory");
    #pragma unroll
    for(int i=0;i<4;++i){const int row=i*8+(lane>>3),ch=lane&7; const u32x4 v=*(const u32x4*)(stg+row*64+ch*8); ATTN_STORE16(Ow+(long)row*DM+hf*64+ch*8,v);}
    asm volatile("s_waitcnt lgkmcnt(0)":::"memory"); }
  asm volatile("s_waitcnt lgkmcnt(0)\n\ts_barrier":::"memory");
  #undef DMA_K
  #undef DMA_V
  #undef CMASK
  #undef ROT
}
constexpr int ATTN_LDS_BYTES=LDS_BYTES;
#undef SBAR
#undef WAIT_BAR
}


#ifndef REP_ATTN
#define REP_ATTN 1
#endif
#ifndef REP_P1
#define REP_P1 1
#endif
#ifndef REP_P3
#define REP_P3 1
#endif
#ifndef REP_P5
#define REP_P5 1
#endif
#ifndef REP_P6
#define REP_P6 1
#endif
#ifndef REP_LN1
#define REP_LN1 1
#endif
#ifndef REP_LN2
#define REP_LN2 1
#endif
#ifndef REP_COMB
#define REP_COMB 1
#endif
#ifndef REP_BAR
#define REP_BAR 1
#endif
#ifndef REP_FILL
#define REP_FILL 1
#endif
#ifndef DRY_REP
#define DRY_REP 0
#endif
#ifndef REP_ATTN_FOX
#define REP_ATTN_FOX REP_ATTN
#endif
#ifndef PROBE_NODOT
#define PROBE_NODOT 0
#endif
#ifndef REP_CONV
#define REP_CONV 1
#endif
#ifndef REP_P0B
#define REP_P0B 1
#endif
#ifndef REP_P0
#define REP_P0 1
#endif
#ifndef MK_PER_PHASE
#define MK_PER_PHASE 0
#endif
constexpr int NWAVES = 8;
constexpr int NB = 8, SEQ = 4096, DM = 1024, NT = NB * SEQ;
constexpr int NPH = 2 + 8 * 4;
constexpr float ALPHA = 1.6817928305074292f;
constexpr float LN_EPS = 1e-5f;
constexpr float LOG2E = 1.4426950408889634f;
constexpr float QSCALE = 0.125f * LOG2E;
constexpr float W1SCALE = 32.0f, W2SCALE = 64.0f, ASCALE = 4.0f, WQK = 32.0f, WV = 64.0f, OSC = 4.0f, YSC = 8.0f, DNSC = 16.0f;

typedef unsigned short bf16;
typedef float f32x4 __attribute__((ext_vector_type(4)));
typedef float f32x2 __attribute__((ext_vector_type(2)));
typedef unsigned u32x4 __attribute__((ext_vector_type(4)));
typedef unsigned u32x2 __attribute__((ext_vector_type(2)));

typedef const __attribute__((address_space(4))) unsigned char* kaptr;
#define INP(k) (*(const float* const __attribute__((address_space(4)))*)(ka + 8 * (k)))
constexpr size_t MiB = 1u << 20;
constexpr size_t WS_CTL = 0, CTL_ZERO_BYTES = 1 * MiB;
constexpr size_t WS_MOD = 1 * MiB;
constexpr size_t WS_KVMOD = WS_MOD + 768 * 1024;
constexpr size_t WS_BT = WS_MOD + 896 * 1024;
constexpr size_t WS_LC = 2 * MiB;
constexpr size_t WS_TOK = 4 * MiB;
constexpr size_t WS_PERM = 5 * MiB;
constexpr size_t WS_GWT = 7 * MiB;
constexpr size_t WS_FOXIN = 10 * MiB, WS_FOXO = 22 * MiB, WS_KVW = 26 * MiB, WS_DQ = 30 * MiB, WS_DO = 34 * MiB, WS_MOE1 = 38 * MiB, WS_MOE2 = 70 * MiB;
constexpr size_t WS_ACT = 86 * MiB, ACT_BYTES = 64 * MiB;
constexpr size_t WS_END = WS_ACT + 6 * ACT_BYTES;
constexpr int CW_TMO = 0;
constexpr int CW_BAR = 4096;
constexpr int CW_QUEUE = 190000;
constexpr int CW_NORM = 210000, CW_KVN = CW_NORM + 4096;
constexpr int CW_CNT = 200000;
constexpr int RING_BYTES = 131072, LDSCTL_OFF = 141312  , MISC_OFF = LDSCTL_OFF + 320, MOETAB_OFF = LDSCTL_OFF + 1024, PARK_OFF = LDSCTL_OFF + 2048  , NORML_OFF = LDSCTL_OFF + 10240  , QW_OFF = LDSCTL_OFF + 512, LDS_BYTES = LDSCTL_OFF + 16384;

#define RLX_AGENT __ATOMIC_RELAXED, __HIP_MEMORY_SCOPE_AGENT
__device__ __forceinline__ unsigned pk2(float lo, float hi) { return pg8::cvt_pk_bf16(lo, hi); }
__device__ __forceinline__ f32x4 unpack4(u32x2 w) { f32x4 r; r.x = __uint_as_float(w.x << 16); r.y = __uint_as_float(w.x & 0xffff0000u); r.z = __uint_as_float(w.y << 16); r.w = __uint_as_float(w.y & 0xffff0000u); return r; }
__device__ __forceinline__ f32x4 unpack4_fp8(unsigned w) { const f32x2 lo = __builtin_amdgcn_cvt_pk_f32_fp8((int)w, false), hi = __builtin_amdgcn_cvt_pk_f32_fp8((int)w, true); return (f32x4){lo.x, lo.y, hi.x, hi.y}; }
__device__ __forceinline__ float xshfl(float v, int m, int lane) { return __uint_as_float((unsigned)__builtin_amdgcn_ds_bpermute((lane ^ m) << 2, (int)__float_as_uint(v))); }
__device__ __forceinline__ float wave_sum(float v, int lane) {
#pragma unroll
    for (int o = 1; o < 64; o <<= 1) v += xshfl(v, o, lane);
    return v;
}

#define XB_TMO      128
#define XB_XCNT(j)  (256  + 64 * (j))
#define XB_XSUB(j)  (1280 + 64 * (j))
#define XB_XGEN(j)  (2304 + 64 * (j))
#define XB_TOP      3328
#define XB_TOPGEN   3392
#define XCD_BAR_WORDS 3456
#define XB_SPIN_CAP (1u << 18)

__device__ __forceinline__ unsigned xb_ld(unsigned* p)              { return __hip_atomic_load(p, __ATOMIC_RELAXED, __HIP_MEMORY_SCOPE_AGENT); }
__device__ __forceinline__ unsigned xb_add(unsigned* p, unsigned v) { return __hip_atomic_fetch_add(p, v, __ATOMIC_RELAXED, __HIP_MEMORY_SCOPE_AGENT); }
__device__ __forceinline__ unsigned xb_xcc_id() { return (unsigned)__builtin_amdgcn_s_getreg((3 << 11) | 20) & 0xFu; }
#define XB_SPIN(cond, bar) do { unsigned _sp = 0; while (cond) { __builtin_amdgcn_s_sleep(1); \
    if ((++_sp & 255u) == 0u) { if (xb_ld(&(bar)[XB_TMO])) break; if (_sp > XB_SPIN_CAP) { atomicAdd(&(bar)[XB_TMO], 1u); break; } } } } while (0)

struct XcdBarrier {
    unsigned* bar; unsigned x;
    volatile LAS unsigned* st;
};

__device__ __forceinline__ XcdBarrier xcd_barrier_post(unsigned* bar, volatile LAS unsigned* st) {
    XcdBarrier b; b.bar = bar; b.x = xb_xcc_id(); b.st = st;
    if (threadIdx.x == 0) (void)xb_add(&bar[XB_XCNT(b.x)], 1u);
    return b;
}
__device__ __forceinline__ void xcd_barrier_complete(unsigned* bar, unsigned x, unsigned& nloc, unsigned& nx) {
    const unsigned G = gridDim.x * gridDim.y * gridDim.z;
    unsigned sum, cnt, mine, sp = 0u;
    for (;;) {
        sum = 0u; cnt = 0u; mine = 0u;
#pragma unroll
        for (unsigned j = 0; j < 16; ++j) { const unsigned c = xb_ld(&bar[XB_XCNT(j)]); sum += c; cnt += (c > 0u) ? 1u : 0u; mine = (j == x) ? c : mine; }
        if (sum == G) break;
        __builtin_amdgcn_s_sleep(1);
        if ((++sp & 255u) == 0u) { if (xb_ld(&bar[XB_TMO])) break; if (sp > XB_SPIN_CAP) { atomicAdd(&bar[XB_TMO], 1u); break; } }
    }
    nloc = mine > 0u ? mine : 1u; nx = cnt > 0u ? cnt : 1u;
}

__device__ __forceinline__ void xcd_barrier(const XcdBarrier& b) {
    asm volatile("s_waitcnt vmcnt(0)" ::: "memory");
    __syncthreads();
    if (threadIdx.x == 0) {
        unsigned* bar = b.bar;
        __builtin_amdgcn_s_waitcnt(0);
        unsigned nloc = b.st[0], nx = b.st[1];
        if (nloc == 0u) { xcd_barrier_complete(bar, b.x, nloc, nx); b.st[0] = nloc; b.st[1] = nx; }
        const unsigned old = xb_add(&bar[XB_XSUB(b.x)], 1u);
        const unsigned gen = old / nloc;
        if (old + 1u == (gen + 1u) * nloc) {
            __builtin_amdgcn_fence(__ATOMIC_RELEASE, "agent");
            asm volatile("s_waitcnt vmcnt(0)" ::: "memory");
            const unsigned og = xb_add(&bar[XB_TOP], 1u);
            const unsigned tg = og / nx;
            if (og + 1u == (tg + 1u) * nx) xb_add(&bar[XB_TOPGEN], 1u);
            else XB_SPIN(xb_ld(&bar[XB_TOPGEN]) == tg, bar);
            __builtin_amdgcn_fence(__ATOMIC_ACQUIRE, "agent");
            xb_add(&bar[XB_XGEN(b.x)], 1u);
            asm volatile("s_waitcnt vmcnt(0)" ::: "memory");
        } else {
            XB_SPIN(xb_ld(&bar[XB_XGEN(b.x)]) == gen, bar);
            __builtin_amdgcn_fence(__ATOMIC_ACQUIRE, "agent");
            asm volatile("s_waitcnt vmcnt(0)" ::: "memory");
        }
    }
    __syncthreads();
}

__device__ __forceinline__ void transpose_item(const float* W, int ld, int K, bf16* WT, int drow0, int k0, int n0, LAS float* scr, int lane, float qs) {
#pragma unroll 8
    for (int i = 0; i < 32; ++i) { const int kk = 2 * i + (lane >> 5); scr[kk * 33 + (lane & 31)] = W[(size_t)(k0 + kk) * ld + n0 + (lane & 31)]; (void)qs; }
    asm volatile("s_waitcnt lgkmcnt(0)" ::: "memory");
    const int c = lane & 7;
#pragma unroll
    for (int j = 0; j < 4; ++j) { const int n = (lane >> 3) + 8 * j; const LAS float* s = scr + (8 * c) * 33 + n;
        u32x4 o; o.x = pk2(s[0 * 33], s[1 * 33]); o.y = pk2(s[2 * 33], s[3 * 33]); o.z = pk2(s[4 * 33], s[5 * 33]); o.w = pk2(s[6 * 33], s[7 * 33]);
        *(u32x4*)(WT + (size_t)(drow0 + n) * K + k0 + 8 * c) = o; }
    asm volatile("s_waitcnt lgkmcnt(0)" ::: "memory");
}

__device__ __forceinline__ void transpose_item_fp8(const float* W, int ld, int K, unsigned char* WT, int drow0, int k0, int n0, LAS float* scr, int lane, float scale) {
#pragma unroll 8
    for (int i = 0; i < 32; ++i) { const int kk = 2 * i + (lane >> 5); scr[kk * 33 + (lane & 31)] = __builtin_nontemporal_load(W + (size_t)(k0 + kk) * ld + n0 + (lane & 31)) * scale; }
    asm volatile("s_waitcnt lgkmcnt(0)" ::: "memory");
    const int c = lane & 7;
#pragma unroll
    for (int j = 0; j < 4; ++j) { const int n = (lane >> 3) + 8 * j; const LAS float* s = scr + (8 * c) * 33 + n;
        u32x2 o; o.x = pg8::pk4_fp8(s[0 * 33], s[1 * 33], s[2 * 33], s[3 * 33]); o.y = pg8::pk4_fp8(s[4 * 33], s[5 * 33], s[6 * 33], s[7 * 33]);
        *(u32x2*)(WT + (size_t)(drow0 + n) * K + k0 + 8 * c) = o; }
    asm volatile("s_waitcnt lgkmcnt(0)" ::: "memory");
}

__device__ __forceinline__ void p0_prologue(LAS unsigned char* L, kaptr ka, unsigned char* ws, int tid, int lane, int wave, int bx, int G, int vcu) {
    LAS float* sc = (LAS float*)L;
    LAS float* part = (LAS float*)(L + 32768);
    const float* cin = INP(1);
    for (int i = tid; i < NB * DM; i += NWAVES * 64) { const float v = cin[i]; sc[i] = v / (1.0f + __expf(-v)); }
    __syncthreads();
    for (int task = bx; task < 208; task += G) {
        const float* W; const float* bias; float* out; int ld, n0;
        if (task < 192) { const int l = task / 48, ch = task % 48; W = INP(2) + (size_t)l * DM * 6144; ld = 6144; n0 = ch * 128; bias = INP(3) + l * 6144; out = (float*)(ws + WS_MOD) + (size_t)l * NB * 6144; }
        else { const int ch = task - 192; W = INP(11); ld = 2048; n0 = ch * 128; bias = INP(12); out = (float*)(ws + WS_KVMOD); }
        float acc[8][2];
#pragma unroll
        for (int b = 0; b < 8; ++b) { acc[b][0] = 0.f; acc[b][1] = 0.f; }
        const float* wp = W + (size_t)(wave * 128) * ld + n0 + 2 * lane;
        for (int k4 = 0; k4 < 32; ++k4) {
            f32x2 wv[4];
#pragma unroll
            for (int kk = 0; kk < 4; ++kk) wv[kk] = __builtin_nontemporal_load((const f32x2*)(wp + (size_t)(4 * k4 + kk) * ld));
#pragma unroll
            for (int b = 0; b < 8; ++b) { const f32x4 s = *(const LAS f32x4*)(sc + b * DM + wave * 128 + 4 * k4);
#pragma unroll
                for (int kk = 0; kk < 4; ++kk) { acc[b][0] += s[kk] * wv[kk].x; acc[b][1] += s[kk] * wv[kk].y; } }
        }
#pragma unroll
        for (int b = 0; b < 8; ++b) *(LAS f32x2*)(part + (wave * 8 + b) * 128 + 2 * lane) = (f32x2){acc[b][0], acc[b][1]};
        __syncthreads();
        for (int o = tid; o < 8 * 128; o += NWAVES * 64) { const int b = o >> 7, col = o & 127; float s = bias[n0 + col];
#pragma unroll
            for (int w = 0; w < 8; ++w) s += part[(w * 8 + b) * 128 + col];
            out[(size_t)b * ld + n0 + col] = s; }
        __syncthreads();
    }
    __syncthreads();
    LAS float* scr = (LAS float*)(L + wave * 16384);
    const int gw = vcu * NWAVES + wave, NGW = G * NWAVES;
    constexpr int I_IN = 16 * 96, I_SQ = 16 * 32, I_KV = 16 * 64;
#define HEADPERM(n0) (((n0) & ~255) + 128 * ((((n0) & 255) & 63) >> 5) + 32 * (((n0) & 255) >> 6))
    constexpr int NITEMS = 2 * I_IN + 2 * I_SQ + I_KV + 2 * I_SQ + 2 * I_SQ;
    for (int it = gw; it < NITEMS; it += NGW) {
        int r = it;
        if (r < 2 * I_IN) { const int l = r / I_IN; r %= I_IN; transpose_item_fp8(INP(8) + (size_t)l * DM * 3088, 3088, DM, (unsigned char*)(ws + WS_FOXIN) + (size_t)l * 3072 * DM, HEADPERM(32 * (r % 96)), 64 * (r / 96), 32 * (r % 96), scr, lane, (r % 96) < 64 ? WQK : WV); continue; } r -= 2 * I_IN;
        if (r < 2 * I_SQ) { const int l = r / I_SQ; r %= I_SQ; transpose_item_fp8(INP(10) + (size_t)l * DM * DM, DM, DM, (unsigned char*)(ws + WS_FOXO) + (size_t)l * DM * DM, 32 * (r % 32), 64 * (r / 32), 32 * (r % 32), scr, lane, WV); continue; } r -= 2 * I_SQ;
        if (r < I_KV) { transpose_item_fp8(INP(13), 2048, DM, (unsigned char*)(ws + WS_KVW), HEADPERM(32 * (r % 64)), 64 * (r / 64), 32 * (r % 64), scr, lane, (r % 64) < 32 ? WQK : WV); continue; } r -= I_KV;
        if (r < 2 * I_SQ) { const int l = r / I_SQ; r %= I_SQ; transpose_item_fp8(INP(14) + (size_t)l * DM * DM, DM, DM, (unsigned char*)(ws + WS_DQ) + (size_t)l * DM * DM, HEADPERM(32 * (r % 32)), 64 * (r / 32), 32 * (r % 32), scr, lane, WQK); continue; } r -= 2 * I_SQ;
        { const int l = r / I_SQ; r %= I_SQ; transpose_item_fp8(INP(17) + (size_t)l * DM * DM, DM, DM, (unsigned char*)(ws + WS_DO) + (size_t)l * DM * DM, 32 * (r % 32), 64 * (r / 32), 32 * (r % 32), scr, lane, WV); }
    }
}
__device__ __forceinline__ void moe_weight_copies(LAS unsigned char* L, kaptr ka, unsigned char* ws, int l, int lane, int wave, int G, int vcu) {
    LAS float* scr = (LAS float*)(L + wave * 16384);
    const int gw = vcu * NWAVES + wave, NGW = G * NWAVES;
    for (int it = gw; it < 12288; it += NGW) {
        const int which = it >> 12, e = (it >> 8) & 15, r = it & 255;
        if (which < 2) { const int kb = r >> 4, nb = r & 15, n0 = 32 * nb;
            transpose_item_fp8((which == 0 ? INP(20) : INP(21)) + (size_t)(l * 16 + e) * DM * 512, 512, DM, (unsigned char*)(ws + WS_MOE1) + (size_t)e * DM * DM, (n0 >> 7) * 256 + (n0 & 127) + which * 128, 64 * kb, n0, scr, lane, W1SCALE); }
        else { const int kb = r >> 5, nb = r & 31;
            transpose_item_fp8(INP(22) + (size_t)(l * 16 + e) * 512 * DM, DM, 512, (unsigned char*)(ws + WS_MOE2) + (size_t)e * DM * 512, 32 * nb, 64 * kb, 32 * nb, scr, lane, W2SCALE); }
    }
}

__device__ __forceinline__ void route16(const float (&lg)[16], const LAS float* rb, int& e0, int& e1, float& w0, float& w1) {
    float mx = lg[0];
#pragma unroll
    for (int e = 1; e < 16; ++e) mx = fmaxf(mx, lg[e]);
    float p[16], sum = 0.f;
#pragma unroll
    for (int e = 0; e < 16; ++e) { p[e] = __expf(lg[e] - mx); sum += p[e]; }
    const float inv = 1.0f / sum;
    int be0 = 0, be1 = 1; float bp0 = 0.f, bp1 = 0.f, gbest = -INFINITY;
#pragma unroll
    for (int g = 0; g < 4; ++g) {
        float a[4], q[4];
#pragma unroll
        for (int i = 0; i < 4; ++i) { q[i] = p[4 * g + i] * inv; a[i] = q[i] + rb[4 * g + i]; }
        int i0 = 0; float v0 = a[0], q0 = q[0];
#pragma unroll
        for (int i = 1; i < 4; ++i) if (a[i] > v0) { v0 = a[i]; i0 = i; q0 = q[i]; }
        int i1 = 0; float v1 = -INFINITY, q1 = 0.f;
#pragma unroll
        for (int i = 0; i < 4; ++i) if (i != i0 && a[i] > v1) { v1 = a[i]; i1 = i; q1 = q[i]; }
        const float gs = v0 + v1;
        if (gs > gbest) { gbest = gs; be0 = 4 * g + i0; be1 = 4 * g + i1; bp0 = q0; bp1 = q1; }
    }
    e0 = be0; e1 = be1; const float ws_ = 1.0f / (bp0 + bp1); w0 = bp0 * ws_; w1 = bp1 * ws_;
}

struct RowsCfg {
    const float* xin_f32; const bf16* xin_bf;
    bf16* xout_bf; float* xout_f32;
    const unsigned char* src; float src_inv;
    const float* gate; const float* gamma; const float* beta;
    const float* sc; const float* sh; bf16* hout; int hout_fp8;
    const float* sc2; const float* sh2; bf16* hout2;
    const float* w16; int w16_ld; int dotmode;
    const float* rb;
    unsigned* cnt; int* perm; float* gwt; unsigned* tokslot;
    float* lc; float* bt;
};
template <int MODE, bool XF32>
__device__ __forceinline__ void rows_load(f32x4 (&xf)[4], u32x4 (&xb)[2], u32x2 (&s0)[2], u32x2 (&s1)[2], const RowsCfg& c, int row, int slot0, int slot1, int lane) {
    if (XF32) { const f32x4* xr = (const f32x4*)(c.xin_f32 + (size_t)row * DM) + 2 * lane;
#pragma unroll
        for (int q = 0; q < 4; ++q) xf[q] = xr[128 * (q >> 1) + (q & 1)]; }
    else { const u32x4* xr = (const u32x4*)(c.xin_bf + (size_t)row * DM) + lane;
#pragma unroll
        for (int j = 0; j < 2; ++j) xb[j] = xr[64 * j]; }
    if (MODE == 1) { const u32x2* yr = (const u32x2*)(c.src + (size_t)row * DM) + lane;
#pragma unroll
        for (int j = 0; j < 2; ++j) s0[j] = yr[64 * j]; }
    if (MODE == 2) { const u32x2* r0 = (const u32x2*)(c.src + (size_t)slot0 * DM) + lane; const u32x2* r1 = (const u32x2*)(c.src + (size_t)slot1 * DM) + lane;
#pragma unroll
        for (int j = 0; j < 2; ++j) { s0[j] = r0[64 * j]; s1[j] = r1[64 * j]; } }
}
template <int MODE, bool XF32>
__device__ __forceinline__ void rows_phase(LAS unsigned char* L, const RowsCfg& c, int tid, int lane, int wave, int bx) {
    LAS u32x4* WB = (LAS u32x4*)L;
    LAS u32x4* ST = (LAS u32x4*)(L + 32768 + wave * 8192);
    LAS f32x4* VEC = (LAS f32x4*)(L + 98304);
    LAS float* LF = (LAS float*)(L + 126976);
    LAS int* RE = (LAS int*)(L + 135168);
    LAS float* RW = (LAS float*)(L + 136192);
    LAS int* LP = (LAS int*)(L + 137216);
    LAS int* HIST = (LAS int*)(L + 138240);
    LAS int* GB = HIST + 16; LAS int* OFF = HIST + 32; LAS float* RB = (LAS float*)(HIST + 48);
    LAS float* LG2 = (LAS float*)(L + 126976);
    if (tid < 256) {
        if (MODE != 0) { VEC[0 * 256 + tid] = (((const f32x4*)c.gate)[tid] + 1.0f) * c.src_inv;     VEC[1 * 256 + tid] = ((const f32x4*)c.gamma)[tid]; VEC[2 * 256 + tid] = ((const f32x4*)c.beta)[tid]; }
        if (c.hout) { VEC[3 * 256 + tid] = ((const f32x4*)c.sc)[tid]; VEC[4 * 256 + tid] = ((const f32x4*)c.sh)[tid]; }
        if (c.hout2) { VEC[5 * 256 + tid] = ((const f32x4*)c.sc2)[tid]; VEC[6 * 256 + tid] = ((const f32x4*)c.sh2)[tid]; }
    }
    if (tid < 16) { HIST[tid] = 0; if (c.dotmode) RB[tid] = c.rb[tid]; }
    if (MODE == 2 && tid < 16) GB[tid] = (int)__hip_atomic_load(c.cnt + tid, RLX_AGENT);
    if (c.dotmode) for (int idx = tid; idx < 2048; idx += NWAVES * 64) { const int s = idx >> 6, ln = idx & 63, e = ln & 15, k0 = 32 * s + 8 * (ln >> 4); float w[8];
#pragma unroll
        for (int j = 0; j < 8; ++j) w[j] = c.w16[(size_t)(k0 + j) * c.w16_ld + e];
        WB[idx] = (u32x4){pk2(w[0], w[1]), pk2(w[2], w[3]), pk2(w[4], w[5]), pk2(w[6], w[7])}; }
    __syncthreads();
    if (MODE == 2) { if (tid == 0) { int so = 0;
#pragma unroll
        for (int e = 0; e < 16; ++e) { OFF[e] = so; so += GB[e]; } }
        __syncthreads(); }
    const int rowb = bx * 128 + wave * 16;
#define VQ(vec, q) VEC[(vec) * 256 + 2 * lane + 128 * ((q) >> 1) + ((q) & 1)]
    int myslot = 0; float myw = 0.f;
    if (MODE == 2) { const unsigned t = c.tokslot[rowb * 2 + (lane & 31)]; myslot = OFF[t >> 16] + (int)(t & 0xffffu); myw = c.gwt[rowb * 2 + (lane & 31)]; }
#define ROWS_SLOT(r, k) (MODE == 2 ? __builtin_amdgcn_readlane(myslot, 2 * (r) + (k)) : 0)
    auto compute = [&](f32x4 (&Bxf)[2][4], u32x4 (&Bxb)[2][2], u32x2 (&Bs0)[2][2], u32x2 (&Bs1)[2][2], const int g, const bool mma) __attribute__((always_inline)) {
        f32x4 hv[2][4];
#pragma unroll
        for (int rr = 0; rr < 2; ++rr) {
            const int row = rowb + 2 * g + rr;
            f32x4 v[4];
#pragma unroll
            for (int q = 0; q < 4; ++q) { if (XF32) v[q] = Bxf[rr][q]; else { const u32x4 w = Bxb[rr][q >> 1]; v[q] = (q & 1) ? unpack4((u32x2){w.z, w.w}) : unpack4((u32x2){w.x, w.y}); } }
            if (MODE != 0) {
                float gw0 = 1.f, gw1 = 1.f; if (MODE == 2) { gw0 = __uint_as_float(__builtin_amdgcn_readlane(__float_as_uint(myw), 2 * (2 * g + rr))); gw1 = __uint_as_float(__builtin_amdgcn_readlane(__float_as_uint(myw), 2 * (2 * g + rr) + 1)); }
                float sm = 0.f;
#pragma unroll
                for (int q = 0; q < 4; ++q) { const unsigned w0 = (q & 1) ? Bs0[rr][q >> 1].y : Bs0[rr][q >> 1].x; f32x4 s = unpack4_fp8(w0);
                    if (MODE == 2) { const unsigned w1 = (q & 1) ? Bs1[rr][q >> 1].y : Bs1[rr][q >> 1].x; s = s * gw0 + unpack4_fp8(w1) * gw1; }
                    const f32x4 gt = VQ(0, q); v[q] = v[q] * ALPHA + gt * s; sm += (v[q].x + v[q].y) + (v[q].z + v[q].w); }
                const float mean = wave_sum(sm, lane) * (1.0f / DM); float s2 = 0.f;
#pragma unroll
                for (int q = 0; q < 4; ++q) { v[q] = v[q] - mean; s2 += (v[q].x * v[q].x + v[q].y * v[q].y) + (v[q].z * v[q].z + v[q].w * v[q].w); }
                const float rstd = 1.0f / sqrtf(wave_sum(s2, lane) * (1.0f / DM) + LN_EPS);
#pragma unroll
                for (int q = 0; q < 4; ++q) v[q] = v[q] * rstd * VQ(1, q) + VQ(2, q);
                if (c.xout_f32) { f32x4* xo = (f32x4*)(c.xout_f32 + (size_t)row * DM) + 2 * lane;
#pragma unroll
                    for (int q = 0; q < 4; ++q) xo[128 * (q >> 1) + (q & 1)] = v[q]; }
                else { u32x4* xo = (u32x4*)(c.xout_bf + (size_t)row * DM) + lane;
#pragma unroll
                    for (int j = 0; j < 2; ++j) xo[64 * j] = (u32x4){pk2(v[2 * j].x, v[2 * j].y), pk2(v[2 * j].z, v[2 * j].w), pk2(v[2 * j + 1].x, v[2 * j + 1].y), pk2(v[2 * j + 1].z, v[2 * j + 1].w)}; }
            }
            if (c.hout) { u32x2* ho = (u32x2*)((unsigned char*)c.hout + (size_t)row * DM) + lane;
#pragma unroll
                for (int q = 0; q < 4; ++q) hv[rr][q] = v[q] * (VQ(3, q) + 1.0f) + VQ(4, q);
#pragma unroll
                for (int j = 0; j < 2; ++j) ho[64 * j] = (u32x2){pg8::pk4_fp8(hv[rr][2 * j].x, hv[rr][2 * j].y, hv[rr][2 * j].z, hv[rr][2 * j].w), pg8::pk4_fp8(hv[rr][2 * j + 1].x, hv[rr][2 * j + 1].y, hv[rr][2 * j + 1].z, hv[rr][2 * j + 1].w)}; }
            if (c.hout2) { u32x2* ho = (u32x2*)((unsigned char*)c.hout2 + (size_t)row * DM) + lane;
#pragma unroll
                for (int j = 0; j < 2; ++j) { const f32x4 ha = v[2 * j] * (VQ(5, 2 * j) + 1.0f) + VQ(6, 2 * j), hb = v[2 * j + 1] * (VQ(5, 2 * j + 1) + 1.0f) + VQ(6, 2 * j + 1);
                    ho[64 * j] = (u32x2){pg8::pk4_fp8(ha.x, ha.y, ha.z, ha.w), pg8::pk4_fp8(hb.x, hb.y, hb.z, hb.w)}; } }
        }
        if (c.dotmode) {
#pragma unroll
            for (int rr = 0; rr < 2; ++rr)
#pragma unroll
                for (int j = 0; j < 2; ++j) ST[(2 * (g & 1) + rr) * 128 + lane + 64 * j] = (u32x4){pk2(hv[rr][2 * j].x, hv[rr][2 * j].y), pk2(hv[rr][2 * j].z, hv[rr][2 * j].w), pk2(hv[rr][2 * j + 1].x, hv[rr][2 * j + 1].y), pk2(hv[rr][2 * j + 1].z, hv[rr][2 * j + 1].w)};
            if (mma) {
                f32x4 acc = {0.f, 0.f, 0.f, 0.f};
                const LAS u32x4* ap = ST + (lane & 3) * 128 + (lane >> 4);
#pragma unroll 8
                for (int s = 0; s < 32; ++s) acc = __builtin_amdgcn_mfma_f32_16x16x32_bf16(__builtin_bit_cast(pg8::bf16x8, ap[4 * s]), __builtin_bit_cast(pg8::bf16x8, WB[64 * s + lane]), acc, 0, 0, 0);
                if (lane < 16) {
#pragma unroll
                    for (int rr = 0; rr < 4; ++rr) { const float tot = acc[rr]; const int rl = wave * 16 + 2 * (g - 1) + rr;
                        if (c.dotmode == 2) { const float z = tot + RB[lane]; LF[rl * 16 + lane] = fminf(z, 0.f) - 0.6931471805599453f * __builtin_amdgcn_logf(1.0f + __builtin_amdgcn_exp2f(-LOG2E * fabsf(z))); }
                        else LG2[rl * 16 + lane] = tot; } }
            }
        }
    };
    f32x4 Axf[2][4], Bxf[2][4]; u32x4 Axb[2][2], Bxb[2][2]; u32x2 As0[2][2], Bs0[2][2], As1[2][2], Bs1[2][2];
#define ROWS_LD(P, rr, r) rows_load<MODE, XF32>(P##xf[rr], P##xb[rr], P##s0[rr], P##s1[rr], c, rowb + (r), ROWS_SLOT((r), 0), ROWS_SLOT((r), 1), lane)
    ROWS_LD(A, 0, 0); ROWS_LD(A, 1, 1);
#pragma unroll 1
    for (int g = 0; g < 8; g += 2) {
        ROWS_LD(B, 0, 2 * g + 2); ROWS_LD(B, 1, 2 * g + 3);
        compute(Axf, Axb, As0, As1, g, false);
        if (g + 2 < 8) { ROWS_LD(A, 0, 2 * g + 4); ROWS_LD(A, 1, 2 * g + 5); }
        compute(Bxf, Bxb, Bs0, Bs1, g + 1, true);
    }
#undef ROWS_LD
#undef ROWS_SLOT
#undef VQ
    if (c.dotmode == 1) {
        asm volatile("s_waitcnt lgkmcnt(0)" ::: "memory");
        if (lane < 16) { float lg[16];
#pragma unroll
            for (int e = 0; e < 16; ++e) lg[e] = LG2[(wave * 16 + lane) * 16 + e];
            int e0, e1; float w0, w1; route16(lg, RB, e0, e1, w0, w1);
            const int rl = wave * 16 + lane;
            RE[rl * 2] = e0; RE[rl * 2 + 1] = e1; RW[rl * 2] = w0; RW[rl * 2 + 1] = w1;
            LP[rl * 2] = __hip_atomic_fetch_add(HIST + e0, 1, __ATOMIC_RELAXED, __HIP_MEMORY_SCOPE_WORKGROUP);
            LP[rl * 2 + 1] = __hip_atomic_fetch_add(HIST + e1, 1, __ATOMIC_RELAXED, __HIP_MEMORY_SCOPE_WORKGROUP); }
    }
    __syncthreads();
    if (c.dotmode == 2) {
        const int b = bx >> 5, blk = bx & 31;
        if (tid < 16) { float run = 0.f;
            for (int i = 0; i < 128; ++i) { run += LF[i * 16 + tid]; LF[i * 16 + tid] = run; }
            c.bt[(b * 16 + tid) * 32 + blk] = run; }
        __syncthreads();
        { const int e = tid >> 5, i0 = 4 * (tid & 31);
          const f32x4 o = {LF[(i0 + 0) * 16 + e], LF[(i0 + 1) * 16 + e], LF[(i0 + 2) * 16 + e], LF[(i0 + 3) * 16 + e]};
          *(f32x4*)(c.lc + (size_t)(b * 16 + e) * SEQ + blk * 128 + i0) = o; }
    }
    if (c.dotmode == 1) {
        if (c.cnt == nullptr) { __syncthreads(); return; }
        if (tid < 16) GB[tid] = (int)__hip_atomic_fetch_add(c.cnt + tid, (unsigned)HIST[tid], RLX_AGENT);
        __syncthreads();
        if (tid < 128) { const int row = bx * 128 + tid;
#pragma unroll
            for (int k = 0; k < 2; ++k) { const int e = RE[tid * 2 + k], pos = GB[e] + LP[tid * 2 + k];
                c.perm[e * 32768 + pos] = row; c.gwt[row * 2 + k] = RW[tid * 2 + k]; c.tokslot[row * 2 + k] = ((unsigned)e << 16) | (unsigned)pos; } }
    }
    __syncthreads();
}

__device__ __forceinline__ void combine_phase(const bf16* O1, const bf16* O2, bf16* O, const float* lamp  , const float* gnorm  , float lam_init, int lane, int wave, int bx) {
    float pa = lamp[lane] * lamp[64 + lane], pb = lamp[128 + lane] * lamp[192 + lane];
    pa = wave_sum(pa, lane); pb = wave_sum(pb, lane);
    const float lam = __expf(pa) - __expf(pb) + lam_init, post = (1.0f - lam_init) * OSC;
    float g[16];
#pragma unroll
    for (int k = 0; k < 16; ++k) g[k] = gnorm[(lane & 7) * 16 + k] * post;
    const int rowb = bx * 128 + wave * 16;
    for (int i = 0; i < 16; ++i) {
        const size_t off = (size_t)(rowb + i) * DM + 16 * lane;
        const u32x4 a0 = *(const u32x4*)(O1 + off), a1 = *(const u32x4*)(O1 + off + 8), b0 = *(const u32x4*)(O2 + off), b1 = *(const u32x4*)(O2 + off + 8);
        float d[16];
        { const f32x4 x0 = unpack4((u32x2){a0.x, a0.y}), x1 = unpack4((u32x2){a0.z, a0.w}), x2 = unpack4((u32x2){a1.x, a1.y}), x3 = unpack4((u32x2){a1.z, a1.w});
          const f32x4 y0 = unpack4((u32x2){b0.x, b0.y}), y1 = unpack4((u32x2){b0.z, b0.w}), y2 = unpack4((u32x2){b1.x, b1.y}), y3 = unpack4((u32x2){b1.z, b1.w});
          const f32x4 r0 = x0 - y0 * lam, r1 = x1 - y1 * lam, r2 = x2 - y2 * lam, r3 = x3 - y3 * lam;
#pragma unroll
          for (int k = 0; k < 4; ++k) { d[k] = r0[k]; d[4 + k] = r1[k]; d[8 + k] = r2[k]; d[12 + k] = r3[k]; } }
        float ss = 0.f;
#pragma unroll
        for (int k = 0; k < 16; ++k) ss += d[k] * d[k];
        ss += xshfl(ss, 1, lane); ss += xshfl(ss, 2, lane); ss += xshfl(ss, 4, lane);
        const float r = 1.0f / sqrtf(ss * (1.0f / 128.0f) + LN_EPS);
        u32x4 w0;
        w0.x = pg8::pk4_fp8(d[0] * r * g[0], d[1] * r * g[1], d[2] * r * g[2], d[3] * r * g[3]); w0.y = pg8::pk4_fp8(d[4] * r * g[4], d[5] * r * g[5], d[6] * r * g[6], d[7] * r * g[7]);
        w0.z = pg8::pk4_fp8(d[8] * r * g[8], d[9] * r * g[9], d[10] * r * g[10], d[11] * r * g[11]); w0.w = pg8::pk4_fp8(d[12] * r * g[12], d[13] * r * g[13], d[14] * r * g[14], d[15] * r * g[15]);
        *(u32x4*)((unsigned char*)O + off) = w0;
    }
}

__device__ __forceinline__ void fill_bias(LAS unsigned char* L, bool fox, const float* lc, const float* bt, float slope, int nkeys, int tid, int lane, int kaoff) {
    LAS u32x4* bias = (LAS u32x4*)(L + kaoff);
    const int s = 8 * tid;
    float pre = 0.f;
    if (fox) { const int blk = tid >> 4; const int l5 = lane & 31; float inc = bt[l5];
        const float own = inc;
#pragma unroll
        for (int o = 1; o < 32; o <<= 1) { const float t = __uint_as_float((unsigned)__builtin_amdgcn_ds_bpermute((lane - o) << 2, (int)__float_as_uint(inc))); inc += (l5 >= o) ? t : 0.f; }
        pre = __uint_as_float((unsigned)__builtin_amdgcn_ds_bpermute(blk << 2, (int)__float_as_uint(inc - own))); }
    if (s < nkeys) {
        f32x4 o0, o1;
        if (fox) { const f32x4 a = *(const f32x4*)(lc + s), b = *(const f32x4*)(lc + s + 4);
            o0 = (a + pre) * (-LOG2E); o1 = (b + pre) * (-LOG2E); }
        else { const float k = slope * LOG2E;
            o0 = (f32x4){k * (float)s, k * (float)(s + 1), k * (float)(s + 2), k * (float)(s + 3)}; o1 = (f32x4){k * (float)(s + 4), k * (float)(s + 5), k * (float)(s + 6), k * (float)(s + 7)}; }
        const attn_body::u32x2v k0 = attn_body::ka_split(o0.x), k1 = attn_body::ka_split(o0.y), k2 = attn_body::ka_split(o0.z), k3 = attn_body::ka_split(o0.w);
        const attn_body::u32x2v k4 = attn_body::ka_split(o1.x), k5 = attn_body::ka_split(o1.y), k6 = attn_body::ka_split(o1.z), k7 = attn_body::ka_split(o1.w);
        bias[4 * tid] = (u32x4){k0[0], k0[1], k1[0], k1[1]}; bias[4 * tid + 1] = (u32x4){k2[0], k2[1], k3[0], k3[1]}; bias[4 * tid + 2] = (u32x4){k4[0], k4[1], k5[0], k5[1]}; bias[4 * tid + 3] = (u32x4){k6[0], k6[1], k7[0], k7[1]};
    }
}

struct Args { const float* in[23]; float* out; unsigned char* ws; int ph_lo, ph_hi, li, pad; };
__global__ void __launch_bounds__(NWAVES * 64, 2) mk_fwd(Args args) {
    extern __shared__ __attribute__((aligned(16))) unsigned char lds[];
    LAS unsigned char* L = (LAS unsigned char*)lds;
    const int tid0 = threadIdx.x; const int wave0 = __builtin_amdgcn_readfirstlane(tid0 >> 6);
    const int bx0 = blockIdx.x;
    for (int u = tid0; u < (LDS_BYTES - LDSCTL_OFF) / 4; u += NWAVES * 64) ((LAS unsigned*)(L + LDSCTL_OFF))[u] = 0u;
    __syncthreads();
    volatile LAS unsigned* MISC = (volatile LAS unsigned*)(L + MISC_OFF);
    XcdBarrier bar = xcd_barrier_post((unsigned*)(args.ws + WS_CTL) + CW_BAR + args.li * XCD_BAR_WORDS, MISC + 8);
    const int lo = args.ph_lo, hi = args.ph_hi;
    int ph = 0;
    constexpr size_t AE = ACT_BYTES / 2;
#define PH_ON (ph >= lo && ph < hi)
#define FRESH_TID() int lane; asm volatile("v_mbcnt_lo_u32_b32 %0, -1, 0\n\tv_mbcnt_hi_u32_b32 %0, -1, %0" : "=v"(lane)); const int wave = wave0; const int tid = wave * 64 + lane; (void)tid; \
    int bx = bx0; asm volatile("" : "+s"(bx)); const int G = 256; const int vcu = (bx % 8) * (G / 8) + bx / 8; (void)vcu; const int bb = bx >> 5; (void)bb; \
    kaptr ka = (kaptr)__builtin_amdgcn_kernarg_segment_ptr(); asm volatile("" : "+s"(ka)); \
    unsigned char* ws = *(unsigned char* const __attribute__((address_space(4)))*)(ka + 8 * 24); float* out = *(float* const __attribute__((address_space(4)))*)(ka + 8 * 23); (void)out; \
    unsigned* ctl = (unsigned*)(ws + WS_CTL); (void)ctl; bf16* ACT = (bf16*)(ws + WS_ACT); \
    bf16 *B0 = ACT, *B1 = ACT + AE, *B2 = ACT + 2 * AE, *B3 = ACT + 3 * AE, *B4 = ACT + 4 * AE, *B5 = ACT + 5 * AE; (void)B0; (void)B1; (void)B2; (void)B3; (void)B4; (void)B5; \
    float* MOD = (float*)(ws + WS_MOD); float* KVMOD = (float*)(ws + WS_KVMOD); float* BT = (float*)(ws + WS_BT); float* LC = (float*)(ws + WS_LC); (void)MOD; (void)KVMOD; (void)BT; (void)LC; \
    unsigned* TOK = (unsigned*)(ws + WS_TOK); int* PERM = (int*)(ws + WS_PERM); float* GWT = (float*)(ws + WS_GWT); (void)TOK; (void)PERM; (void)GWT
#define PH_END do { if (PH_ON && ph + 1 < hi) { XcdBarrier b_ = bar; asm volatile("" : "+s"(b_.bar), "+s"(b_.x)); for (int rb_ = 0; rb_ < REP_BAR; ++rb_) xcd_barrier(b_); } ++ph; } while (0)


    if (PH_ON) { FRESH_TID(); for (int rep_ = 0; rep_ < REP_P0; ++rep_) p0_prologue(L, ka, ws, tid, lane, wave, bx, G, vcu); }
    PH_END;
    if (PH_ON) { FRESH_TID();
        RowsCfg c{}; c.xin_f32 = INP(0); c.sh = MOD + (size_t)bb * 6144; c.sc = MOD + (size_t)bb * 6144 + DM; c.hout = B5; c.hout_fp8 = 1;
        c.w16 = INP(8) + 3072; c.w16_ld = 3088; c.dotmode = 2; c.rb = INP(9); c.lc = LC; c.bt = BT;
        for (int rep_ = 0; rep_ < REP_P0B; ++rep_) rows_phase<0, true>(L, c, tid, lane, wave, bx);
    }
    PH_END;

    for (int l = 0; l < 4; ++l) {
        const bool fox = l < 2;
        if (PH_ON) { FRESH_TID();
            for (int rep_ = 0; rep_ < REP_P1; ++rep_)
            for (int pass = (l == 2 ? 0 : 1); pass < 2; ++pass) {
                pg8::Gemm g; pg8::EpiBf16 E; int N;
                if (fox) { g = pg8::Gemm{B5, (const bf16*)((const unsigned char*)(ws + WS_FOXIN) + (size_t)l * 3072 * DM), DM / 2}; N = 3072; E = pg8::EpiBf16{B2, DM, DM, AE, {QSCALE / WQK, 1.0f / WQK, 1.0f / WV}, ctl + CW_NORM + 1024 * l, 32, DRY_REP && rep_ > 0}; }
                else if (pass == 0) { g = pg8::Gemm{B2, (const bf16*)(ws + WS_KVW), DM / 2}; N = 2048; E = pg8::EpiBf16{B3, DM, DM, AE, {1.0f / WQK, 1.0f / WV, 0.f}, ctl + CW_KVN, 16, DRY_REP && rep_ > 0}; }
                else { g = pg8::Gemm{B5, (const bf16*)((const unsigned char*)(ws + WS_DQ) + (size_t)(l - 2) * DM * DM), DM / 2}; N = 1024; E = pg8::EpiBf16{B0, DM, DM, AE, {QSCALE / WQK, 0.f, 0.f}, ctl + CW_NORM + 1024 * l, 16, DRY_REP && rep_ > 0}; }
                pg8::DenseSched S; S.init(NT, N, DM / 2, G, bx);
                pg8::gemm_phase<pg8::EpiBf16, pg8::DenseSched, true, true>(L, g, S, E, tid, L + PARK_OFF);
            }
        }
        PH_END;
        if (PH_ON) { FRESH_TID();
            LAS int* QW = (LAS int*)(L + QW_OFF);
            unsigned* qctr = ctl + CW_QUEUE + 64 * l;
            const int total = 2048;
            const int kaoff = fox ? attn_body::LDS_BIAS : attn_body::LDS128_BIAS;
            { LAS float* NL = (LAS float*)(L + NORML_OFF);
              for (int i = tid; i < 512; i += NWAVES * 64) { const int b = i >> 6, s = i & 63; unsigned v = 0u;
                  if (fox) { if ((s & 31) < 16) v = __hip_atomic_load(ctl + CW_NORM + 1024 * l + b * 32 + (s < 32 ? s : 16 + (s - 32)), RLX_AGENT); }
                  else { if (s < 16) v = __hip_atomic_load(ctl + CW_NORM + 1024 * l + b * 16 + s, RLX_AGENT); else if (s >= 32 && s < 48) v = __hip_atomic_load(ctl + CW_KVN + b * 16 + (s - 32), RLX_AGENT); }
                  NL[i] = __uint_as_float(v); } }
            for (int rep_ = 0; rep_ < (fox ? REP_ATTN_FOX : REP_ATTN); ++rep_) {
            unsigned* qc = qctr + 16 * rep_;
            int pvh = -1, pnk = 0;
            if (tid == 0) QW[0] = (int)__hip_atomic_fetch_add(qc, 1u, RLX_AGENT);
            __syncthreads();
            for (;;) {
                const int u = __builtin_amdgcn_readfirstlane(QW[0]);
                __syncthreads();
                if (u >= total) break;
                int nxt = 0; if (tid == 0) nxt = (int)__hip_atomic_fetch_add(qc, 1u, RLX_AGENT);
                const int vh = u & 127, qb = 15 - (u >> 7);
                const bf16 *Qb, *Kb, *Vb; bf16* Ob; const float *lc = nullptr, *bt = nullptr; float slope = 0.f; int nqi;
                if (fox) { const int b = vh >> 4, h = vh & 15; const size_t o = (size_t)b * SEQ * DM + h * 64;
                    Qb = B2 + o; Kb = B3 + o; Vb = B4 + o; Ob = (bf16*)((unsigned char*)B0 + o);   lc = LC + (size_t)vh * SEQ; bt = BT + vh * 32;
                    nqi = b * 64 + h; }
                else { const int b = vh >> 4, h = (vh >> 1) & 7, j = vh & 1; const size_t o = (size_t)b * SEQ * DM + h * 128;
                    Qb = B0 + o + j * 64; Kb = B3 + o + j * 64; Vb = B4 + o; Ob = (j ? B2 : B1) + o; slope = exp2f(-(float)(h + 1));
                    nqi = b * 64 + 2 * h + j; }
                const LAS float* NL = (const LAS float*)(L + NORML_OFF);
                const float q2 = NL[nqi], k2 = NL[nqi + 32];
                const float bh = 1.01f * sqrtf(q2 * k2), bound = 2.0f * bh + 32.0f;
                int tu = tid; int t0;
                asm volatile("" : "+v"(tu));
                if (!(vh == pvh && (qb + 1) * 256 <= pnk)) {
                    fill_bias(L, fox, lc, bt, slope, (qb + 1) * 256, tu, tu & 63, kaoff);
                    asm volatile("s_waitcnt lgkmcnt(0)\n\ts_barrier" ::: "memory");
                    pvh = vh; pnk = (qb + 1) * 256; }
                { const LAS attn_body::u32x2v* bias = (const LAS attn_body::u32x2v*)(L + kaoff); const int jl = tu & 63;
                  const bool c = (jl < 4 * qb) && (attn_body::ka_value(bias[64 * jl + 63]) - attn_body::ka_value(bias[256 * qb]) + bound < 0.0f);
                  t0 = (int)__builtin_popcountll(__ballot(c)) & ~1; }
                if (fox) attn_body::attn_unit<8>(qb, t0, (const attn_body::bf16*)Qb, (const attn_body::bf16*)Kb, (const attn_body::bf16*)Vb, (attn_body::bf16*)Ob, (char*)lds, tu, bh, OSC);
                else attn_body::attn_unit128(qb, t0, (const attn_body::bf16*)Qb, (const attn_body::bf16*)Kb, (const attn_body::bf16*)Vb, (attn_body::bf16*)Ob, (char*)lds, tu, bh);
                if (tid == 0) QW[0] = nxt;
                __syncthreads();
            }
            }
        }
        PH_END;
        if (!fox) {
            if (PH_ON) { FRESH_TID(); for (int rep_ = 0; rep_ < REP_COMB; ++rep_) combine_phase(B1, B2, B0, INP(15) + (size_t)(l - 2) * 256, INP(16) + (size_t)(l - 2) * 128, (l == 2) ? 0.47071302f : 0.55605820f  , lane, wave, bx); }
            PH_END;
        } else ++ph;
        if (PH_ON) { FRESH_TID();
            pg8::Gemm g{B0, (const bf16*)((const unsigned char*)(ws + (fox ? WS_FOXO : WS_DO)) + (size_t)(fox ? l : l - 2) * DM * DM), DM / 2};
            pg8::DenseSched S; S.init(NT, DM, DM / 2, G, bx);
            for (int rep_ = 0; rep_ < REP_P3; ++rep_) { pg8::EpiFp8 E{(unsigned char*)B1, DM, YSC / (WV * OSC), DRY_REP && rep_ > 0};
            pg8::gemm_phase<pg8::EpiFp8, pg8::DenseSched, true, true>(L, g, S, E, tid, L + PARK_OFF); }
        }
        PH_END;
        if (PH_ON) { FRESH_TID();
            const float* modl = MOD + ((size_t)l * NB + bb) * 6144; bf16* XB = (bf16*)out + (size_t)NT * DM;     RowsCfg c{}; c.xin_f32 = INP(0); c.xin_bf = XB; c.xout_bf = (l == 3) ? B5 : XB; c.src = (const unsigned char*)B1; c.src_inv = 1.0f / YSC; c.gate = modl + 2 * DM; c.gamma = INP(4) + l * DM; c.beta = INP(5) + l * DM;
            c.sh = modl + 3 * DM; c.sc = modl + 4 * DM; c.hout = B0; c.hout_fp8 = 1; c.w16 = INP(18); c.w16_ld = 16; c.dotmode = 1; c.rb = INP(19);
            c.cnt = ctl + CW_CNT + 64 * l; c.perm = PERM; c.gwt = GWT; c.tokslot = TOK;
            for (int rep_ = 0; rep_ < REP_LN1; ++rep_) { RowsCfg c2 = c; if (rep_ + 1 < REP_LN1) { c2.xout_bf = (l == 3) ? B5 : B5; c2.cnt = nullptr; if (PROBE_NODOT) c2.dotmode = 0; }
            if (l == 0) rows_phase<1, true>(L, c2, tid, lane, wave, bx); else rows_phase<1, false>(L, c2, tid, lane, wave, bx); }
            for (int rep_ = 0; rep_ < REP_CONV; ++rep_) moe_weight_copies(L, ka, ws, l, lane, wave, G, vcu);
        }
        PH_END;
        if (PH_ON) { FRESH_TID();
            LAS int* TAB = (LAS int*)(L + MOETAB_OFF);
            if (tid < 16) TAB[32 + tid] = (int)__hip_atomic_load(ctl + CW_CNT + 64 * l + tid, RLX_AGENT);
            __syncthreads();
            if (tid == 0) { int tp = 0, so = 0;
#pragma unroll
                for (int e = 0; e < 16; ++e) { const int cn = TAB[32 + e]; TAB[e] = tp; TAB[64 + e] = so; tp += (cn + 255) >> 8; so += cn; } TAB[16] = tp; }
            __syncthreads();
            pg8::Gemm g{B0, (const bf16*)(ws + WS_MOE1), DM / 2};
            pg8::MoeSched<true> S{TAB, G, vcu, DM / 2, PERM, (unsigned)(DM * DM), (const LAS int*)(L + PARK_OFF)};
            S.fill_tokens((LAS int*)(L + PARK_OFF), tid); __syncthreads();
            pg8::EpiMoe1 E{(unsigned char*)B2, 1.0f / W1SCALE, ASCALE};
            for (int rep_ = 0; rep_ < REP_P5; ++rep_)
            pg8::gemm_phase<pg8::EpiMoe1, pg8::MoeSched<true>, true, true>(L, g, S, E, tid, L + PARK_OFF);
        }
        PH_END;
        if (PH_ON) { FRESH_TID();
            LAS int* TAB = (LAS int*)(L + MOETAB_OFF);
            if (tid < 16) TAB[32 + tid] = (int)__hip_atomic_load(ctl + CW_CNT + 64 * l + tid, RLX_AGENT);
            __syncthreads();
            if (tid == 0) { int tp = 0, so = 0;
#pragma unroll
                for (int e = 0; e < 16; ++e) { const int cn = TAB[32 + e]; TAB[e] = tp; TAB[64 + e] = so; tp += (cn + 255) >> 8; so += cn; } TAB[16] = tp; }
            __syncthreads();
            pg8::Gemm g{B2, (const bf16*)(ws + WS_MOE2), 256};
            pg8::MoeSched<false> S{TAB, G, vcu, 256, PERM, (unsigned)(DM * 512), nullptr};
            pg8::EpiMoe2 E{(unsigned char*)B0, DNSC / (W2SCALE * ASCALE)};
            for (int rep_ = 0; rep_ < REP_P6; ++rep_)
            pg8::gemm_phase<pg8::EpiMoe2, pg8::MoeSched<false>, true, true>(L, g, S, E, tid, L + PARK_OFF);
        }
        PH_END;
        if (PH_ON) { FRESH_TID();
            const float* modl = MOD + ((size_t)l * NB + bb) * 6144; bf16* XB = (bf16*)out + (size_t)NT * DM; RowsCfg c{}; c.xin_bf = (l == 3) ? B5 : XB; if (l == 3) c.xout_f32 = out; else c.xout_bf = XB; c.src = (const unsigned char*)B0; c.src_inv = 1.0f / DNSC; c.gate = modl + 5 * DM; c.gamma = INP(6) + l * DM; c.beta = INP(7) + l * DM;
            c.cnt = ctl + CW_CNT + 64 * l; c.tokslot = TOK; c.gwt = GWT;
            if (l < 3) { const float* modn = MOD + ((size_t)(l + 1) * NB + bb) * 6144; c.sh = modn; c.sc = modn + DM; c.hout = B5; c.hout_fp8 = 1; }
            if (l == 0) { c.w16 = INP(8) + (size_t)DM * 3088 + 3072; c.w16_ld = 3088; c.dotmode = 2; c.rb = INP(9) + 16; c.lc = LC; c.bt = BT; }
            if (l == 1) { c.sh2 = KVMOD + (size_t)bb * 2048; c.sc2 = KVMOD + (size_t)bb * 2048 + DM; c.hout2 = B2; }
            for (int rep_ = 0; rep_ < REP_LN2; ++rep_) { RowsCfg c2 = c; if (rep_ + 1 < REP_LN2) { c2.xout_f32 = nullptr; c2.xout_bf = (l == 1) ? B3 : B2; }
            rows_phase<2, false>(L, c2, tid, lane, wave, bx); }
        }
        PH_END;
    }
#undef PH_ON
#undef PH_END
}

extern "C" void kernel_launch(void* const* d_in, const int* in_sizes, int n_in, void* d_out, int out_size, void* d_ws, size_t ws_size, hipStream_t stream) {
    static int grid = 0;
    if (grid == 0) {
        if (n_in != 23 || in_sizes[0] != NT * DM || out_size != NT * DM || ws_size < WS_END) { fprintf(stderr, "kernel_launch: unexpected problem (n_in %d, in0 %d, out %d, ws %zu < %zu)\n", n_in, n_in > 0 ? in_sizes[0] : -1, out_size, ws_size, (size_t)WS_END); grid = -1; return; }
        if (hipFuncSetAttribute((const void*)mk_fwd, hipFuncAttributeMaxDynamicSharedMemorySize, LDS_BYTES) != hipSuccess) { fprintf(stderr, "kernel_launch: hipFuncSetAttribute failed\n"); grid = -1; return; }
        int per_cu = 0;
        if (hipOccupancyMaxActiveBlocksPerMultiprocessor(&per_cu, (const void*)mk_fwd, NWAVES * 64, LDS_BYTES) != hipSuccess || per_cu < 1) fprintf(stderr, "kernel_launch: occupancy query reports %d\n", per_cu);
        (void)hipGetLastError();
        grid = 256;
    }
    if (grid < 0) return;
    if (hipMemsetAsync((char*)d_ws + WS_CTL, 0, CTL_ZERO_BYTES, stream) != hipSuccess) { fprintf(stderr, "kernel_launch: memset failed\n"); return; }
    Args a{};
    for (int i = 0; i < 23; ++i) a.in[i] = (const float*)d_in[i];
    a.out = (float*)d_out; a.ws = (unsigned char*)d_ws;
#if MK_PER_PHASE
    for (int p = 0; p < NPH; ++p) { a.ph_lo = p; a.ph_hi = p + 1; a.li = p; hipLaunchKernelGGL(mk_fwd, dim3(grid), dim3(NWAVES * 64), LDS_BYTES, stream, a); }
#else
    a.ph_lo = 0; a.ph_hi = NPH; a.li = 0;
    hipLaunchKernelGGL(mk_fwd, dim3(grid), dim3(NWAVES * 64), LDS_BYTES, stream, a);
#endif
    const hipError_t le = hipPeekAtLastError();
    if (le != hipSuccess) fprintf(stderr, "kernel_launch: launch failed: %s\n", hipGetErrorName(le));
}
```

```cpp
#include <hip/hip_runtime.h>
#include <hip/hip_bf16.h>
#include <cstdio>
#include <cstdint>
#include <cmath>
#define LAS __attribute__((address_space(3)))
namespace pg8 {
#define PG8_LAS __attribute__((address_space(3)))
typedef unsigned short bf16_t;
typedef short bf16x8 __attribute__((ext_vector_type(8)));
typedef float f32x4 __attribute__((ext_vector_type(4)));
typedef unsigned u32x4 __attribute__((ext_vector_type(4)));
constexpr int BM = 256, BK = 64, HALF = 128, HTB = HALF * BK * 2  , STAGE_BYTES = 8 * HTB, NXCD = 8, WGM = 8;

__host__ __device__ __forceinline__ int lds_byte(int r, int c) { const int st = (r >> 4) * 2 + (c >> 5), rr = r & 15, cc = c & 31, ob = rr * 64 + cc * 2; return st * 1024 + (ob ^ (((ob >> 9) & 1) << 5)); }
__host__ __device__ __forceinline__ void stage_rc(int b, int& R, int& C) { const int st = b / 1024, sb = b % 1024, swz = sb ^ (((sb >> 9) & 1) << 5); R = (st >> 1) * 16 + swz / 64; C = (st & 1) * 32 + (swz % 64) / 2; }
__host__ __device__ __forceinline__ int perm32(int rho) { const int n = rho >> 4, i = rho & 15; return 8 * (i >> 2) + 4 * n + (i & 3); }
struct Unit0 { int pm, pn; };
struct StaticOrder {
    int nM, nN, nwg, G, c;
    __host__ __device__ void init(int M, int N, int G_, int c_) { nM = M / BM; nN = N / BM; nwg = nM * nN; G = G_; c = c_; }
    __host__ __device__ bool next(int i, Unit0& u) const {
        const long L = (long)i * G + c; if (L >= nwg) return false;
        int wgid = (int)L; { const int q = nwg / NXCD, r = nwg % NXCD, xcd = wgid % NXCD, off = wgid / NXCD; wgid = (xcd < r ? xcd * (q + 1) : r * (q + 1) + (xcd - r) * q) + off; }
        const int nig = WGM * nN, gid = wgid / nig, fm = gid * WGM, gsz = (nM - fm) < WGM ? (nM - fm) : WGM;
        u.pm = fm + ((wgid % nig) % gsz); u.pn = (wgid % nig) / gsz; return true;
    }
    __device__ __forceinline__ void a_ready(const Unit0&) const {}
    __device__ __forceinline__ void done(const Unit0&) const {}
};

struct Unit { int pm, pn, e, nrows, row0, ord; unsigned boff; };
struct Gemm { const bf16_t* A; const bf16_t* Bt; int K; };

struct DenseSched {
    StaticOrder so; int K;
    __device__ __forceinline__ void init(int M, int N, int K_, int G, int c) { so.init(M, N, G, c); K = K_; }
    __device__ __forceinline__ bool next(int i, Unit& u) const { Unit0 t; if (!so.next(i, t)) return false; u.pm = t.pm; u.pn = t.pn; u.e = 0; u.ord = i; u.nrows = BM; u.row0 = t.pm * BM; u.boff = (unsigned)t.pn * (unsigned)(BM * 2) * (unsigned)K; return true; }
    static constexpr bool GATHER = false;
    __device__ __forceinline__ void aoff(const Unit& u, int tid, unsigned (&off)[2][2]) const {
#pragma unroll
        for (int i = 0; i < 2; ++i) { int R, C; stage_rc(tid * 16 + i * 8192, R, C);
#pragma unroll
            for (int h = 0; h < 2; ++h) off[h][i] = (unsigned)((u.row0 + h * HALF + R) * K + C) * 2u; } }
};
template <bool GATHER_> struct MoeSched {
    static constexpr bool GATHER = GATHER_;
    const PG8_LAS int* tab; int G, c, K; const int* perm; unsigned wstride; const PG8_LAS int* toks;
    __device__ __forceinline__ bool next(int i, Unit& u) const {
        const int L = i * G + c; const int tot = tab[16] * 4; if (L >= tot) return false;
        const int g = L >> 2; int e = 0;
#pragma unroll
        for (int k = 1; k < 16; ++k) e += (tab[k] <= g) ? 1 : 0;
        const int mt = g - tab[e], cnt = tab[32 + e];
        u.pm = mt; u.pn = L & 3; u.e = e; u.ord = i; u.nrows = (cnt - BM * mt) < BM ? (cnt - BM * mt) : BM; u.row0 = tab[64 + e] + BM * mt;
        u.boff = (unsigned)e * wstride + (unsigned)(L & 3) * (unsigned)(BM * 2) * (unsigned)K; return true; }
    __device__ __forceinline__ void fill_tokens(PG8_LAS int* dst, int tid) const {
        Unit u;
        for (int i = 0; i < 8 && next(i, u); ++i) for (int r = tid; r < BM; r += 512) dst[i * BM + r] = r < u.nrows ? perm[u.e * 32768 + u.pm * BM + r] : 0; }
    __device__ __forceinline__ void aoff(const Unit& u, int tid, unsigned (&off)[2][2]) const {
#pragma unroll
        for (int i = 0; i < 2; ++i) { int R, C; stage_rc(tid * 16 + i * 8192, R, C);
#pragma unroll
            for (int h = 0; h < 2; ++h) {
                int row;
                if (GATHER) row = toks[u.ord * BM + h * HALF + R];
                else row = u.row0 + h * HALF + R;
                off[h][i] = (unsigned)(row * K + C) * 2u; } } }
};

typedef float f32x2 __attribute__((ext_vector_type(2))); typedef __bf16 bf16x2_t __attribute__((ext_vector_type(2)));
__device__ __forceinline__ unsigned cvt_pk_bf16(float lo, float hi) { f32x2 v = {lo, hi}; bf16x2_t b = __builtin_convertvector(v, bf16x2_t); return __builtin_bit_cast(unsigned, b); }

struct EpiBf16 {
    static constexpr bool PERM = true, AFTER_DRAIN = false;
    bf16_t* O; int ldc; int split_cols; size_t split_stride; float scv[3]; unsigned* norm; int nslots; int dry;
    __device__ __forceinline__ void operator()(const f32x4 (&acc)[2][2][4][2], const Unit& u, int wr, int wc, int fr, int fq) const {
        const int row0 = u.row0 + wr * 64 + fr; int colt = u.pn * BM; bf16_t* base = O;
        float sc = scv[0]; int tt = 0; if (split_cols) { const int t = colt / split_cols; tt = t; base += (size_t)t * split_stride; colt -= t * split_cols; sc = t == 0 ? scv[0] : (t == 1 ? scv[1] : scv[2]); }
        const int col0 = colt + wc * 64 + 8 * fq;
#pragma unroll
        for (int ai = 0; ai < 2; ++ai)
#pragma unroll
            for (int m = 0; m < 4; ++m) { bf16_t* rowp = base + (size_t)(row0 + ai * HALF + m * 16) * ldc + col0;
#pragma unroll
                for (int bj = 0; bj < 2; ++bj) { const f32x4 v0 = acc[ai][bj][m][0] * sc, v1 = acc[ai][bj][m][1] * sc;
                    u32x4 w; w.x = cvt_pk_bf16(v0[0], v0[1]); w.y = cvt_pk_bf16(v0[2], v0[3]); w.z = cvt_pk_bf16(v1[0], v1[1]); w.w = cvt_pk_bf16(v1[2], v1[3]);
                    if (!dry) *(u32x4*)(rowp + bj * 32) = w; else asm volatile("" :: "v"(w)); } }
        if (norm && !dry && tt < nslots / 16) { const int lane = fq * 16 + fr; float mx = 0.f;
#pragma unroll
            for (int ai = 0; ai < 2; ++ai)
#pragma unroll
                for (int m = 0; m < 4; ++m) { float ss = 0.f;
#pragma unroll
                    for (int bj = 0; bj < 2; ++bj) { const f32x4 v0 = acc[ai][bj][m][0] * sc, v1 = acc[ai][bj][m][1] * sc;
                        ss += (v0[0] * v0[0] + v0[1] * v0[1]) + (v0[2] * v0[2] + v0[3] * v0[3]) + (v1[0] * v1[0] + v1[1] * v1[1]) + (v1[2] * v1[2] + v1[3] * v1[3]); }
                    ss += __uint_as_float((unsigned)__builtin_amdgcn_ds_bpermute((lane ^ 16) << 2, (int)__float_as_uint(ss)));
                    ss += __uint_as_float((unsigned)__builtin_amdgcn_ds_bpermute((lane ^ 32) << 2, (int)__float_as_uint(ss)));
                    mx = fmaxf(mx, ss); }
#pragma unroll
            for (int o = 1; o < 16; o <<= 1) mx = fmaxf(mx, __uint_as_float((unsigned)__builtin_amdgcn_ds_bpermute((lane ^ o) << 2, (int)__float_as_uint(mx))));
            if (lane == 0) __hip_atomic_fetch_max(norm + (u.row0 >> 12) * nslots + u.pn * 4 + wc, __float_as_uint(mx), __ATOMIC_RELAXED, __HIP_MEMORY_SCOPE_AGENT);
        }
    }
};
__device__ __forceinline__ unsigned pk4_fp8(float a, float b, float c, float d) { unsigned w = __builtin_amdgcn_cvt_pk_fp8_f32(a, b, 0u, false); return __builtin_amdgcn_cvt_pk_fp8_f32(c, d, w, true); }
typedef unsigned u32x2e_t __attribute__((ext_vector_type(2)));
__device__ __forceinline__ u32x4 widen16(u32x2e_t w0, u32x2e_t w1) {
    const auto a = __builtin_amdgcn_permlane16_swap(w0[0], w1[0], false, false), b = __builtin_amdgcn_permlane16_swap(w0[1], w1[1], false, false);
    return (u32x4){a[0], b[0], a[1], b[1]}; }
struct EpiFp8 {
    static constexpr bool PERM = true, AFTER_DRAIN = false;
    unsigned char* O; int ldc; float sc; int dry;
    __device__ __forceinline__ void operator()(const f32x4 (&acc)[2][2][4][2], const Unit& u, int wr, int wc, int fr, int fq) const {
        const int row0 = u.row0 + wr * 64 + fr + 16 * (fq & 1), col0 = u.pn * BM + wc * 32 + 8 * (fq & ~1);
#pragma unroll
        for (int ai = 0; ai < 2; ++ai)
#pragma unroll
            for (int mp = 0; mp < 4; mp += 2) { unsigned char* rowp = O + (size_t)(row0 + ai * HALF + mp * 16) * ldc + col0;
#pragma unroll
                for (int bj = 0; bj < 2; ++bj) { const f32x4 a0 = acc[ai][bj][mp][0] * sc, a1 = acc[ai][bj][mp][1] * sc, b0 = acc[ai][bj][mp + 1][0] * sc, b1 = acc[ai][bj][mp + 1][1] * sc;
                    const u32x4 w = widen16((u32x2e_t){pk4_fp8(a0[0], a0[1], a0[2], a0[3]), pk4_fp8(a1[0], a1[1], a1[2], a1[3])}, (u32x2e_t){pk4_fp8(b0[0], b0[1], b0[2], b0[3]), pk4_fp8(b1[0], b1[1], b1[2], b1[3])});
                    if (!dry) *(u32x4*)(rowp + bj * HALF) = w; else asm volatile("" :: "v"(w)); } }
    }
};
__device__ __forceinline__ float silu_mul(float g, float u) { return g * u * __builtin_amdgcn_rcpf(1.0f + __builtin_amdgcn_exp2f(-1.4426950408889634f * g)); }
struct EpiMoe1 {
    static constexpr bool PERM = true, AFTER_DRAIN = false;
    unsigned char* O; float inv_wscale, ascale;
    __device__ __forceinline__ void operator()(const f32x4 (&acc)[2][2][4][2], const Unit& u, int wr, int wc, int fr, int fq) const {
        const int col0 = u.pn * 128 + wc * 32 + 8 * (fq & ~1); const float us = inv_wscale * ascale;
#pragma unroll
        for (int ai = 0; ai < 2; ++ai)
#pragma unroll
            for (int mp = 0; mp < 4; mp += 2) { const int r = ai * HALF + wr * 64 + (mp + (fq & 1)) * 16 + fr; u32x2e_t wv[2];
#pragma unroll
                for (int k = 0; k < 2; ++k) { const f32x4 g0 = acc[ai][0][mp + k][0] * inv_wscale, g1 = acc[ai][0][mp + k][1] * inv_wscale, u0 = acc[ai][1][mp + k][0] * us, u1 = acc[ai][1][mp + k][1] * us;
                    wv[k] = (u32x2e_t){pk4_fp8(silu_mul(g0[0], u0[0]), silu_mul(g0[1], u0[1]), silu_mul(g0[2], u0[2]), silu_mul(g0[3], u0[3])), pk4_fp8(silu_mul(g1[0], u1[0]), silu_mul(g1[1], u1[1]), silu_mul(g1[2], u1[2]), silu_mul(g1[3], u1[3]))}; }
                const u32x4 w = widen16(wv[0], wv[1]);
                if (r < u.nrows) *(u32x4*)(O + (size_t)(u.row0 + r) * 512 + col0) = w; }
    }
};
struct EpiMoe2 {
    static constexpr bool PERM = true, AFTER_DRAIN = false;
    unsigned char* O; float oscale;
    __device__ __forceinline__ void operator()(const f32x4 (&acc)[2][2][4][2], const Unit& u, int wr, int wc, int fr, int fq) const {
        const int col0 = u.pn * BM + wc * 32 + 8 * (fq & ~1); const float s = oscale;
#pragma unroll
        for (int ai = 0; ai < 2; ++ai)
#pragma unroll
            for (int mp = 0; mp < 4; mp += 2) { const int r = ai * HALF + wr * 64 + (mp + (fq & 1)) * 16 + fr; unsigned char* rowp = O + (size_t)(u.row0 + r) * 1024 + col0;
#pragma unroll
                for (int bj = 0; bj < 2; ++bj) { const f32x4 a0 = acc[ai][bj][mp][0] * s, a1 = acc[ai][bj][mp][1] * s, b0 = acc[ai][bj][mp + 1][0] * s, b1 = acc[ai][bj][mp + 1][1] * s;
                    const u32x4 w = widen16((u32x2e_t){pk4_fp8(a0[0], a0[1], a0[2], a0[3]), pk4_fp8(a1[0], a1[1], a1[2], a1[3])}, (u32x2e_t){pk4_fp8(b0[0], b0[1], b0[2], b0[3]), pk4_fp8(b1[0], b1[1], b1[2], b1[3])});
                    if (r < u.nrows) *(u32x4*)(rowp + bj * HALF) = w; } }
    }
};

typedef int v8i32 __attribute__((ext_vector_type(8))); typedef int v4i32 __attribute__((ext_vector_type(4)));
__device__ __forceinline__ v8i32 cat8(bf16x8 a, bf16x8 b) { const v4i32 x = __builtin_bit_cast(v4i32, a), y = __builtin_bit_cast(v4i32, b); return (v8i32){x[0], x[1], x[2], x[3], y[0], y[1], y[2], y[3]}; }
__device__ __forceinline__ void glds_s(const void* sbase, unsigned voff, unsigned lds_dst) { unsigned keep;
    asm volatile("s_mov_b32 %0, m0\n\ts_mov_b32 m0, %3\n\ts_nop 2\n\tglobal_load_lds_dwordx4 %1, %2\n\ts_mov_b32 m0, %0" : "=&s"(keep) : "v"(voff), "s"(sbase), "s"(lds_dst) : "memory"); }
__device__ __forceinline__ const char* uni_ptr(const char* p) { const unsigned long long v = (unsigned long long)p; const unsigned lo = __builtin_amdgcn_readfirstlane((unsigned)v), hi = __builtin_amdgcn_readfirstlane((unsigned)(v >> 32)); return (const char*)(((unsigned long long)hi << 32) | lo); }
template <class Epi, class Sched, bool ALIGN_EPI, bool FP8 = false, int ABL = 0>
__device__ __forceinline__ void gemm_phase(PG8_LAS unsigned char* lds, const Gemm g, const Sched& S, const Epi& E, const int tid, PG8_LAS unsigned char* park) {
    const int wid = __builtin_amdgcn_readfirstlane(tid >> 6), lane = tid & 63, wr = wid >> 2, wc = wid & 3, fr = lane & 15, fq = lane >> 4;
    const int K = g.K, nt = K / BK;
    unsigned voffB[2];
#pragma unroll
    for (int i = 0; i < 2; ++i) { int R, C; stage_rc(tid * 16 + i * 8192, R, C); const int Rb = Epi::PERM ? ((R & ~31) + perm32(R & 31)) : R; voffB[i] = (unsigned)(Rb * K + C) * 2u; }
    const unsigned kstep = (unsigned)(BK * 2);
    const unsigned hstep = (unsigned)HALF * (unsigned)K * 2u;
    const unsigned ldsw = (unsigned)wid * 1024u;
    const int aoff = lds_byte(wr * 64 + fr, fq * 8), boff = lds_byte(wc * 32 + fr, fq * 8);
    const char* gA = (const char*)g.A;
    const unsigned ldsbase = (unsigned)(size_t)lds;
#define PG8_SA(b, h) (((b) * 2 + (h)) * HTB)
#define PG8_SB(b, h) ((4 + (b) * 2 + (h)) * HTB)
#define PG8_STAGE(bufoff, gbase, voff) do { if constexpr (!(((ABL & 4) && (bufoff) < 4 * HTB) || ((ABL & 8) && (bufoff) >= 4 * HTB))) _Pragma("unroll") for (int _i = 0; _i < 2; ++_i) \
        glds_s(uni_ptr(gbase), (voff)[_i], (unsigned)__builtin_amdgcn_readfirstlane((int)(ldsbase + (unsigned)(bufoff) + ldsw + (unsigned)(_i * 8192)))); } while (0)
#define PG8_LDA(dst, b, h) do { if constexpr (!(ABL & 16)) _Pragma("unroll") for (int m = 0; m < 4; ++m) _Pragma("unroll") for (int k = 0; k < 2; ++k) dst[m][k] = *(const PG8_LAS bf16x8*)(lds + PG8_SA(b, h) + aoff + m * 2048 + k * 1024); } while (0)
#define PG8_LDB(dst, b, h) do { if constexpr (!(ABL & 16)) _Pragma("unroll") for (int n = 0; n < 2; ++n) _Pragma("unroll") for (int k = 0; k < 2; ++k) dst[n][k] = *(const PG8_LAS bf16x8*)(lds + PG8_SB(b, h) + boff + n * 2048 + k * 1024); } while (0)
#define PG8_MMA(ai, bj, At, Bt) do { __builtin_amdgcn_s_setprio(1); if constexpr (!(ABL & 1)) _Pragma("unroll") for (int m = 0; m < 4; ++m) _Pragma("unroll") for (int n = 0; n < 2; ++n) { \
        if constexpr (FP8) acc[ai][bj][m][n] = __builtin_amdgcn_mfma_scale_f32_16x16x128_f8f6f4(cat8(Bt[n][0], Bt[n][1]), cat8(At[m][0], At[m][1]), acc[ai][bj][m][n], 0, 0, 0, 0x7F7F7F7F, 0, 0x7F7F7F7F); \
        else { _Pragma("unroll") for (int k = 0; k < 2; ++k) acc[ai][bj][m][n] = __builtin_amdgcn_mfma_f32_16x16x32_bf16(Bt[n][k], At[m][k], acc[ai][bj][m][n], 0, 0, 0); } } __builtin_amdgcn_s_setprio(0); } while (0)
#define PG8_WAIT_V(n) asm volatile("s_waitcnt vmcnt(" #n ")" ::: "memory")
#define PG8_WAIT_L(n) asm volatile("s_waitcnt lgkmcnt(" #n ")" ::: "memory")
#define PG8_BAR __builtin_amdgcn_s_barrier()
#define PG8_SCHED __builtin_amdgcn_sched_barrier(0)
    Unit cur, nxt; int ui = 0;
    if (!S.next(0, cur)) return;
    f32x4 acc[2][2][4][2];
#pragma unroll
    for (int a = 0; a < 2; ++a)
#pragma unroll
        for (int b = 0; b < 2; ++b)
#pragma unroll
            for (int m = 0; m < 4; ++m)
#pragma unroll
                for (int n = 0; n < 2; ++n) acc[a][b][m][n] = (f32x4){0.f, 0.f, 0.f, 0.f};
    bf16x8 At[4][2], B0[2][2], B1[2][2];
    if constexpr (ABL & 16) { _Pragma("unroll") for (int m = 0; m < 4; ++m) _Pragma("unroll") for (int k = 0; k < 2; ++k) { At[m][k] = (bf16x8){0,0,0,0,0,0,0,0}; asm volatile("" : "+v"(At[m][k])); }
        _Pragma("unroll") for (int n = 0; n < 2; ++n) _Pragma("unroll") for (int k = 0; k < 2; ++k) { B0[n][k] = (bf16x8){0,0,0,0,0,0,0,0}; B1[n][k] = B0[n][k]; asm volatile("" : "+v"(B0[n][k]), "+v"(B1[n][k])); } }
    unsigned offC[2][2];
    S.aoff(cur, tid, offC);
    const char* cB = (const char*)g.Bt + cur.boff;
    PG8_STAGE(PG8_SB(0, 0), cB, voffB); PG8_STAGE(PG8_SB(0, 1), cB + hstep, voffB); PG8_STAGE(PG8_SA(0, 0), gA, offC[0]); PG8_STAGE(PG8_SA(0, 1), gA, offC[1]);
    if (wr == 1) PG8_BAR;
    PG8_WAIT_V(2); PG8_BAR;
    PG8_STAGE(PG8_SB(1, 0), cB + kstep, voffB); PG8_STAGE(PG8_SA(1, 0), gA + kstep, offC[0]); PG8_STAGE(PG8_SB(1, 1), cB + hstep + kstep, voffB);
    PG8_WAIT_V(6); PG8_BAR;
    for (;;) {
        const bool has_next = S.next(ui + 1, nxt);
        const char* nB = has_next ? (const char*)g.Bt + nxt.boff : cB;
#pragma unroll 1
        for (int t = 0; t < nt; t += 2) {
            const bool last = (t == nt - 2);
            const char* a1 = gA + (size_t)(t + 1) * kstep;
            const char* a2 = last ? gA : gA + (size_t)(t + 2) * kstep; const char* b2 = last ? nB : cB + (size_t)(t + 2) * kstep;
            const char* a3 = a2 + kstep; const char* b3 = b2 + kstep;
            PG8_LDB(B0, 0, 0); PG8_LDB(B1, 0, 1); PG8_SCHED; PG8_LDA(At, 0, 0); PG8_STAGE(PG8_SA(1, 1), a1, offC[1]);
            if (last && has_next) {
                { int t2 = tid; asm volatile("" : "+v"(t2)); S.aoff(nxt, t2, offC); } }
            PG8_WAIT_V(8); PG8_WAIT_L(0); PG8_BAR; PG8_MMA(0, 0, At, B0); PG8_MMA(0, 1, At, B1); PG8_BAR; PG8_SCHED;
            PG8_LDA(At, 0, 1); PG8_STAGE(PG8_SB(0, 0), b2, voffB); PG8_STAGE(PG8_SB(0, 1), b2 + hstep, voffB); PG8_STAGE(PG8_SA(0, 0), a2, offC[0]);
            PG8_WAIT_V(8); PG8_WAIT_L(0); PG8_BAR; PG8_MMA(1, 0, At, B0); PG8_MMA(1, 1, At, B1); PG8_BAR; PG8_SCHED;
            PG8_LDB(B0, 1, 0); PG8_LDB(B1, 1, 1); PG8_SCHED; PG8_LDA(At, 1, 0); PG8_STAGE(PG8_SA(0, 1), a2, offC[1]);
            PG8_WAIT_V(8); PG8_WAIT_L(0); PG8_BAR; PG8_MMA(0, 0, At, B0); PG8_MMA(0, 1, At, B1); PG8_BAR; PG8_SCHED;
            PG8_LDA(At, 1, 1); PG8_STAGE(PG8_SB(1, 0), b3, voffB); PG8_STAGE(PG8_SB(1, 1), b3 + hstep, voffB); PG8_STAGE(PG8_SA(1, 0), a3, offC[0]);
            PG8_WAIT_V(8); PG8_WAIT_L(0); PG8_BAR; PG8_MMA(1, 0, At, B0); PG8_MMA(1, 1, At, B1); PG8_BAR; PG8_SCHED;
        }
        if constexpr (ALIGN_EPI) { if (wr == 0) PG8_BAR; }
        if constexpr (!(ABL & 2)) E(acc, cur, wr, wc, fr, fq); else { _Pragma("unroll") for (int a = 0; a < 2; ++a) _Pragma("unroll") for (int b = 0; b < 2; ++b) _Pragma("unroll") for (int m = 0; m < 4; ++m) _Pragma("unroll") for (int n = 0; n < 2; ++n) asm volatile("" :: "v"(acc[a][b][m][n])); }
        if (!has_next) break;
#pragma unroll
        for (int a = 0; a < 2; ++a)
#pragma unroll
            for (int b = 0; b < 2; ++b)
#pragma unroll
                for (int m = 0; m < 4; ++m)
#pragma unroll
                    for (int n = 0; n < 2; ++n) acc[a][b][m][n] = (f32x4){0.f, 0.f, 0.f, 0.f};
        cur = nxt; cB = nB; ++ui;
        if constexpr (ALIGN_EPI) { if (wr == 1) PG8_BAR; }
    }
    PG8_WAIT_V(0);
    if constexpr (!ALIGN_EPI) { if (wr == 0) PG8_BAR; }
    PG8_BAR;
#undef PG8_SA
#undef PG8_SB
#undef PG8_STAGE
#undef PG8_LDA
#undef PG8_LDB
#undef PG8_MMA
#undef PG8_WAIT_V
#undef PG8_WAIT_L
#undef PG8_BAR
#undef PG8_SCHED
}
}

namespace attn_body {
using bf16=__hip_bfloat16;
using bf16x8=__attribute__((ext_vector_type(8)))short;
using s16x4=__attribute__((ext_vector_type(4)))short;
using f32x16=__attribute__((ext_vector_type(16)))float;
using u32x4=__attribute__((ext_vector_type(4)))unsigned;
#ifndef EMU8
#define EMU8 0
#endif
__device__ __forceinline__ float q8(float x,float s){ if(!EMU8) return x; const unsigned w=__builtin_amdgcn_cvt_pk_fp8_f32(x*s,0.f,0u,false); return __builtin_amdgcn_cvt_f32_fp8((int)w,0)*(1.0f/s); }
constexpr int SEQ=4096,D=64,DM=1024;
constexpr int NW=8,QBLK=32,QB=QBLK*NW,KVBLK=64,NQB=SEQ/QB;
constexpr int ATTN_PITCH=DM, ATTN_UNIT_ROWS=QB;
__device__ __forceinline__ int crow(int r,int hi){return (r&3)+8*(r>>2)+4*hi;}
#define SBAR() __builtin_amdgcn_sched_barrier(0)
__device__ __forceinline__ void cmask(f32x16&p0,f32x16&p1,int jb,int qrel,int hi){
  const float NEG=-INFINITY; int kb=64*jb+4*hi;
  #pragma unroll
  for(int r=0;r<16;++r){int kv=kb+(r&3)+8*(r>>2); if(kv>qrel)p0[r]=NEG; if(kv+32>qrel)p1[r]=NEG;}
}

constexpr int NSLOT=3, SLOTB=8192;
constexpr int LDS_K=0, LDS_V=NSLOT*SLOTB, LDS_WS=2*NSLOT*SLOTB, LDS_OST=LDS_WS+NW*64*4, LDS_BIAS=LDS_OST+NW*4096, LDS_BYTES=LDS_BIAS+SEQ*8;
constexpr float C2=0.125f*1.4426950408889634f;
__device__ __forceinline__ void glds16(const void*sbase,unsigned voff,unsigned lds_dst){unsigned keep;
  asm volatile("s_mov_b32 %0, m0\n\ts_mov_b32 m0, %3\n\ts_nop 2\n\tglobal_load_lds_dwordx4 %1, %2\n\ts_mov_b32 m0, %0":"=&s"(keep):"v"(voff),"s"(sbase),"s"(lds_dst):"memory");}
__device__ __forceinline__ float max3f(float a,float b,float c){float r;asm("v_max3_f32 %0, %1, %2, %3":"=v"(r):"v"(a),"v"(b),"v"(c));return r;}
__device__ __forceinline__ float max2f(float a,float b){float r;asm("v_max_f32_e32 %0, %1, %2":"=v"(r):"v"(a),"v"(b));return r;}
__device__ __forceinline__ float fadd_s(float a,float b){float r;asm("v_add_f32_e32 %0, %1, %2":"=v"(r):"v"(a),"v"(b));return r;}
__device__ __forceinline__ float fsub_s(float a,float b){float r;asm("v_sub_f32_e32 %0, %1, %2":"=v"(r):"v"(a),"v"(b));return r;}
typedef float f32x2_t __attribute__((ext_vector_type(2))); typedef __bf16 bf16x2_t __attribute__((ext_vector_type(2)));
__device__ __forceinline__ unsigned cvtpk_s(float lo,float hi){f32x2_t v={lo,hi};bf16x2_t b=__builtin_convertvector(v,bf16x2_t);return __builtin_bit_cast(unsigned,b);}
#define WAIT_BAR(N) asm volatile("s_waitcnt vmcnt(" #N ") lgkmcnt(0)\n\ts_barrier":::"memory")

__device__ __forceinline__ void qkt(f32x16&p0,f32x16&p1,const char*Kslot,const bf16x8*qr,int r32,int hi){
  const char*kb=Kslot+hi*1024+r32*16;
  #pragma unroll
  for(int d0=0;d0<4;++d0){
    const bf16x8 b0=*reinterpret_cast<const bf16x8*>(kb+d0*2048);
    const bf16x8 b1=*reinterpret_cast<const bf16x8*>(kb+d0*2048+512);
    {p0=__builtin_amdgcn_mfma_f32_32x32x16_bf16(b0,qr[d0],p0,0,0,0);p1=__builtin_amdgcn_mfma_f32_32x32x16_bf16(b1,qr[d0],p1,0,0,0);}}
}
typedef __attribute__((address_space(3))) const char* lds_cptr;
typedef short v4i16_t __attribute__((ext_vector_type(4)));
__device__ __forceinline__ void kload8(bf16x8*kf,lds_cptr kp){
  kf[0]=*(const __attribute__((address_space(3))) bf16x8*)(kp);      kf[1]=*(const __attribute__((address_space(3))) bf16x8*)(kp+512);
  kf[2]=*(const __attribute__((address_space(3))) bf16x8*)(kp+2048); kf[3]=*(const __attribute__((address_space(3))) bf16x8*)(kp+2560);
  kf[4]=*(const __attribute__((address_space(3))) bf16x8*)(kp+4096); kf[5]=*(const __attribute__((address_space(3))) bf16x8*)(kp+4608);
  kf[6]=*(const __attribute__((address_space(3))) bf16x8*)(kp+6144); kf[7]=*(const __attribute__((address_space(3))) bf16x8*)(kp+6656);
}
__device__ __forceinline__ void kload2(bf16x8*kf,lds_cptr kp,int j){ kf[2*j]=*(const __attribute__((address_space(3))) bf16x8*)(kp+j*2048); kf[2*j+1]=*(const __attribute__((address_space(3))) bf16x8*)(kp+j*2048+512); }
__device__ __forceinline__ s16x4 vtr(lds_cptr p){ return __builtin_bit_cast(s16x4,__builtin_amdgcn_ds_read_tr16_b64_v4i16((__attribute__((address_space(3))) v4i16_t*)p)); }
__device__ __forceinline__ float rowmax(const f32x16&p0,const f32x16&p1){
  float a=max3f(p0[0],p0[1],p1[0]),b=max3f(p0[2],p0[3],p1[1]);a=max3f(a,p1[2],p1[3]);
  #pragma unroll
  for(int r=4;r<16;r+=4){a=max3f(a,p0[r],p0[r+1]);b=max3f(b,p0[r+2],p0[r+3]);a=max3f(a,p1[r],p1[r+1]);b=max3f(b,p1[r+2],p1[r+3]);}
  const float m=max2f(a,b);
  auto rr=__builtin_amdgcn_permlane32_swap(__float_as_uint(m),__float_as_uint(m),false,false);
  return max2f(__uint_as_float(rr[0]),__uint_as_float(rr[1]));
}
__device__ __forceinline__ void pv(f32x16*o,int vb,bf16x8 pa0,bf16x8 pa1,bf16x8 pa2,bf16x8 pa3){
  #pragma unroll
  for(int d0=0;d0<2;++d0){s16x4 lo[4],hi[4];
    #pragma unroll
    for(int ks=0;ks<4;++ks){
      asm volatile("ds_read_b64_tr_b16 %0,%1 offset:%c2":"=&v"(lo[ks]):"v"(vb),"i"(d0*4096+ks*1024):"memory");
      asm volatile("ds_read_b64_tr_b16 %0,%1 offset:%c2":"=&v"(hi[ks]):"v"(vb),"i"(d0*4096+ks*1024+512):"memory");}
    asm volatile("s_waitcnt lgkmcnt(0)":::"memory");SBAR();
    #define PK(k) (bf16x8){lo[k][0],lo[k][1],lo[k][2],lo[k][3],hi[k][0],hi[k][1],hi[k][2],hi[k][3]}
    o[d0]=__builtin_amdgcn_mfma_f32_32x32x16_bf16(pa0,PK(0),o[d0],0,0,0);
    o[d0]=__builtin_amdgcn_mfma_f32_32x32x16_bf16(pa1,PK(1),o[d0],0,0,0);
    o[d0]=__builtin_amdgcn_mfma_f32_32x32x16_bf16(pa2,PK(2),o[d0],0,0,0);
    o[d0]=__builtin_amdgcn_mfma_f32_32x32x16_bf16(pa3,PK(3),o[d0],0,0,0);
    #undef PK
  }
}

#ifndef ATTN_STORE16
#define ATTN_STORE16(p,v) (*(u32x4*)(p)=(v))
#endif
typedef float f32x4v __attribute__((ext_vector_type(4)));
typedef unsigned u32x2v __attribute__((ext_vector_type(2)));
#define KAF(ka) __builtin_bit_cast(bf16x8,(u32x4){(ka)[0],(ka)[1],0x3F803F80u,0x00003F80u})
#define KAR(tt) do{ ka0=*(const __attribute__((address_space(3))) u32x2v*)(kap+(tt)*512); ka1=*(const __attribute__((address_space(3))) u32x2v*)(kap+(tt)*512+256); }while(0)
__device__ __forceinline__ float ka_value(u32x2v w){ return (__uint_as_float(w[0]<<16)+__uint_as_float(w[0]&0xffff0000u))+__uint_as_float(w[1]<<16); }
__device__ __forceinline__ u32x2v ka_split(float b){ const unsigned h=cvtpk_s(b,0.f)&0xffffu; const float r1=b-__uint_as_float(h<<16); const unsigned m=cvtpk_s(r1,0.f)&0xffffu; const float r2=r1-__uint_as_float(m<<16); const unsigned l=cvtpk_s(r2,0.f)&0xffffu; return (u32x2v){h|(m<<16),l}; }
template<int THRL> __device__ __forceinline__ void attn_unit(int qb,int t0,const bf16*Qb,const bf16*__restrict__ Kb,const bf16*__restrict__ Vb,bf16*Ob,char*shm,const int tid,const float bh,const float osc){
  const int lane=tid&63,r32=lane&31,hi=lane>>5; const int wid=__builtin_amdgcn_readfirstlane(tid>>6);
  const int q0=qb*QB;
  const bf16*Qw=Qb+(long)(q0+wid*QBLK)*DM;
  const bf16*Kh=Kb+(long)t0*KVBLK*DM,*Vh=Vb+(long)t0*KVBLK*DM;
  const unsigned lds0=(unsigned)(uintptr_t)shm;
  float*wsf=(float*)(shm+LDS_WS)+wid*64;
  const unsigned ksrc=(unsigned)(lane*DM+wid*8)*2u;
  const unsigned vsrc=(unsigned)((16*(wid&3)+(lane>>2))*DM+(wid>>2)*32+(lane&3)*8)*2u;
  const unsigned kdst=lds0+LDS_K+wid*1024, vdst=lds0+LDS_V+wid*1024;
  #define DMA_K(t,slot) glds16(Kh+(long)(t)*KVBLK*DM,ksrc,(unsigned)__builtin_amdgcn_readfirstlane(kdst+(slot)))
  #define DMA_V(t,slot) glds16(Vh+(long)(t)*KVBLK*DM,vsrc,(unsigned)__builtin_amdgcn_readfirstlane(vdst+(slot)))
  const int vb0=(int)(lds0+LDS_V)+((lane>>4)&1)*32+(lane&3)*8+(4*hi+((lane&15)>>2))*64;
  const char*Kbase=shm+LDS_K; bf16x8 kf[8];
  const lds_cptr shm3=(lds_cptr)shm; const lds_cptr kap=shm3+LDS_BIAS+t0*512+r32*8; const lds_cptr kp0=shm3+LDS_K+hi*1024+r32*16; const lds_cptr vp0=shm3+LDS_V+((lane>>4)&1)*32+(lane&3)*8+(4*hi+((lane&15)>>2))*64;
  const int NT=(q0+QB)/KVBLK-t0;
  DMA_K(0,0);DMA_V(0,0);DMA_K(1,SLOTB);
  bf16x8 qr[4];
  #pragma unroll
  for(int d0=0;d0<4;++d0)qr[d0]=*reinterpret_cast<const bf16x8*>(&Qw[(long)r32*DM+d0*16+hi*8]);
  float z_=0.f;asm volatile("":"+v"(z_));float l_reg=z_;f32x16 o[2];
  const float mhat=ka_value(*(const __attribute__((address_space(3))) u32x2v*)((lds_cptr)shm+LDS_BIAS+(q0+wid*QBLK+r32)*8))+bh;
  bf16x8 qa; { const u32x2v nm=ka_split(-mhat); const u32x4 w=hi==0?(u32x4){0x3F803F80u,0x00003F80u,nm[0],nm[1]}:(u32x4){0u,0u,0u,0u}; qa=__builtin_bit_cast(bf16x8,w); }
  u32x2v ka0,ka1;
  #pragma unroll
  for(int r=0;r<16;++r){o[0][r]=z_;o[1][r]=z_;}
  const int qrel=wid*QBLK+r32;
  #define CMASK(P0,P1,t) do{int jb_=(t)-(NT-4); if(jb_>=0)cmask(P0,P1,jb_,qrel,hi);}while(0)
  #define START(P0,P1) do{ _Pragma("unroll") for(int r=0;r<16;++r)P0[r]=__builtin_amdgcn_exp2f(P0[r]); }while(0)
  #define RESC() do{}while(0)
  f32x16 pA0,pA1,pB0,pB1;
  int sl_prev=0,sl_cur=0,sl_next=SLOTB;
  #define ROT() do{sl_prev=sl_cur;sl_cur=sl_next;sl_next=(sl_next==(NSLOT-1)*SLOTB)?0:sl_next+SLOTB;}while(0)
  DMA_K(2,2*SLOTB);
  WAIT_BAR(3);
  KAR(0); pA0=__builtin_amdgcn_mfma_f32_32x32x16_bf16(KAF(ka0),qa,f32x16{},0,0,0); pA1=__builtin_amdgcn_mfma_f32_32x32x16_bf16(KAF(ka1),qa,f32x16{},0,0,0);
  qkt(pA0,pA1,Kbase,qr,r32,hi);asm volatile("s_nop 15\n\ts_nop 7":"+v"(pA0),"+v"(pA1));CMASK(pA0,pA1,0);
  START(pA0,pA1);
  _Pragma("unroll") for(int r=0;r<16;++r)pA1[r]=__builtin_amdgcn_exp2f(pA1[r]);
  WAIT_BAR(0);
  DMA_K(3,0);DMA_V(1,SLOTB);
  ROT();
  kload8(kf,kp0+sl_cur); KAR(1);
  WAIT_BAR(2);
  s16x4 vlo[8],vhi[8]; u32x4 pw0,pw1,pw2,pw3;
  #define PKW(P,B) cvtpk_s(P[B],P[B+1])
  #define PAF(k) __builtin_bit_cast(bf16x8,pw##k)
  #define VFR(i) (bf16x8){vlo[i][0],vlo[i][1],vlo[i][2],vlo[i][3],vhi[i][0],vhi[i][1],vhi[i][2],vhi[i][3]}
  #define PIN(x) asm volatile("":"+v"(x))
  #define MX3(a,b,c) __builtin_fmaxf(__builtin_fmaxf((a),(b)),(c))
  #define GAPA(MF,A0,A1,A2,A3,W0,W1,PW) do{ MF; sacc+=A0; sacc+=A1; sacc+=A2; sacc+=A3; PIN(sacc); W0; W1; PIN(PW); SBAR(); }while(0)
  #define EX(v) __builtin_amdgcn_exp2f(v)
  #define GAPB(MF,X,B) do{ MF; X[B]=EX(X[B]); X[B+1]=EX(X[B+1]); X[B+2]=EX(X[B+2]); X[B+3]=EX(X[B+3]); PIN(X); SBAR(); }while(0)
  #define VRD(i) do{ vlo[i]=vtr(vp_+(((i)>>2)*4096+((i)&3)*1024)); vhi[i]=vtr(vp_+(((i)>>2)*4096+((i)&3)*1024+512)); }while(0)
  #define KRD(G,j) do{ if(G){ kload2(kf,kp0+sl_next,j); SBAR(); } }while(0)
  #define STEP(C0,C1,P0,P1,t,GK,GV,GL) do{ SBAR(); \
    const lds_cptr vp_=vp0+sl_prev; \
    C0=__builtin_amdgcn_mfma_f32_32x32x16_bf16(KAF(ka0),qa,f32x16{},0,0,0); C1=__builtin_amdgcn_mfma_f32_32x32x16_bf16(KAF(ka1),qa,f32x16{},0,0,0); SBAR(); \
    VRD(0); SBAR(); float sacc=(P0[0]+P0[1]); \
    GAPA(C0=__builtin_amdgcn_mfma_f32_32x32x16_bf16(kf[0],qr[0],C0,0,0,0), P0[2],P0[3],P0[4],P0[5],     pw0[0]=PKW(P0,0), pw0[1]=PKW(P0,2), pw0); \
    VRD(4); SBAR(); GAPA(C1=__builtin_amdgcn_mfma_f32_32x32x16_bf16(kf[1],qr[0],C1,0,0,0), P0[6],P0[7],P0[8],P0[9],     pw0[2]=PKW(P0,4), pw0[3]=PKW(P0,6), pw0); \
    VRD(1); SBAR(); GAPA(C0=__builtin_amdgcn_mfma_f32_32x32x16_bf16(kf[2],qr[1],C0,0,0,0),   P0[10],P0[11],P0[12],P0[13], pw1[0]=PKW(P0,8), pw1[1]=PKW(P0,10), pw1); \
    VRD(5); SBAR(); GAPA(C1=__builtin_amdgcn_mfma_f32_32x32x16_bf16(kf[3],qr[1],C1,0,0,0),   P0[14],P0[15],P1[0],P1[1],   pw1[2]=PKW(P0,12),pw1[3]=PKW(P0,14), pw1); \
    VRD(2); SBAR(); GAPA(C0=__builtin_amdgcn_mfma_f32_32x32x16_bf16(kf[4],qr[2],C0,0,0,0),   P1[2],P1[3],P1[4],P1[5],     pw2[0]=PKW(P1,0), pw2[1]=PKW(P1,2), pw2); \
    VRD(6); SBAR(); GAPA(C1=__builtin_amdgcn_mfma_f32_32x32x16_bf16(kf[5],qr[2],C1,0,0,0),   P1[6],P1[7],P1[8],P1[9],     pw2[2]=PKW(P1,4), pw2[3]=PKW(P1,6), pw2); \
    VRD(3); SBAR(); GAPA(C0=__builtin_amdgcn_mfma_f32_32x32x16_bf16(kf[6],qr[3],C0,0,0,0),   P1[10],P1[11],P1[12],P1[13], pw3[0]=PKW(P1,8), pw3[1]=PKW(P1,10), pw3); \
    VRD(7); SBAR(); GAPA(C1=__builtin_amdgcn_mfma_f32_32x32x16_bf16(kf[7],qr[3],C1,0,0,0),   P1[14],P1[15],0.f,0.f,       pw3[2]=PKW(P1,12),pw3[3]=PKW(P1,14), pw3); \
    l_reg+=sacc; \
    if(GK){DMA_K((t)+3,sl_cur);} if(GV){DMA_V((t)+1,sl_next);} \
    CMASK(C0,C1,t); \
    SBAR(); \
    GAPB(o[0]=__builtin_amdgcn_mfma_f32_32x32x16_bf16(PAF(0),VFR(0),o[0],0,0,0), C0,0); \
    GAPB(o[1]=__builtin_amdgcn_mfma_f32_32x32x16_bf16(PAF(0),VFR(4),o[1],0,0,0), C0,4); \
    if(GL){KAR((t)+1);} KRD(GL,0); GAPB(o[0]=__builtin_amdgcn_mfma_f32_32x32x16_bf16(PAF(1),VFR(1),o[0],0,0,0), C0,8); \
    KRD(GL,1); GAPB(o[1]=__builtin_amdgcn_mfma_f32_32x32x16_bf16(PAF(1),VFR(5),o[1],0,0,0), C0,12); \
    KRD(GL,2); GAPB(o[0]=__builtin_amdgcn_mfma_f32_32x32x16_bf16(PAF(2),VFR(2),o[0],0,0,0), C1,0); \
    KRD(GL,3); GAPB(o[1]=__builtin_amdgcn_mfma_f32_32x32x16_bf16(PAF(2),VFR(6),o[1],0,0,0), C1,4); \
    GAPB(o[0]=__builtin_amdgcn_mfma_f32_32x32x16_bf16(PAF(3),VFR(3),o[0],0,0,0), C1,8); \
    GAPB(o[1]=__builtin_amdgcn_mfma_f32_32x32x16_bf16(PAF(3),VFR(7),o[1],0,0,0), C1,12); \
    }while(0)
  int t=1;
  #undef CMASK
  #define CMASK(P0,P1,t) do{}while(0)
  for(;t+5<NT;t+=2){
    STEP(pB0,pB1,pA0,pA1,t,true,true,true);     WAIT_BAR(2); RESC(); ROT();
    STEP(pA0,pA1,pB0,pB1,t+1,true,true,true);   WAIT_BAR(2); RESC(); ROT();
  }
  #undef CMASK
  #define CMASK(P0,P1,t) do{int jb_=(t)-(NT-4); if(jb_>=0)cmask(P0,P1,jb_,qrel,hi);}while(0)
  #define ENDW(tt) do{ if((tt)+3<NT){WAIT_BAR(2);} else if((tt)+2<NT){WAIT_BAR(1);} else {WAIT_BAR(0);} }while(0)
  for(;t+1<NT;t+=2){
    STEP(pB0,pB1,pA0,pA1,t,(t+3<NT),(t+1<NT),(t+1<NT));       ENDW(t);   RESC(); ROT();
    STEP(pA0,pA1,pB0,pB1,t+1,(t+4<NT),(t+2<NT),(t+2<NT));     ENDW(t+1); RESC(); ROT();
  }
  STEP(pB0,pB1,pA0,pA1,NT-1,false,false,false); RESC();
  { float sacc=pB0[0]+pB0[1]; _Pragma("unroll") for(int r=2;r<16;++r)sacc+=pB0[r]; _Pragma("unroll") for(int r=0;r<16;++r)sacc+=pB1[r]; l_reg+=sacc;
    pw0=(u32x4){PKW(pB0,0),PKW(pB0,2),PKW(pB0,4),PKW(pB0,6)};pw1=(u32x4){PKW(pB0,8),PKW(pB0,10),PKW(pB0,12),PKW(pB0,14)};pw2=(u32x4){PKW(pB1,0),PKW(pB1,2),PKW(pB1,4),PKW(pB1,6)};pw3=(u32x4){PKW(pB1,8),PKW(pB1,10),PKW(pB1,12),PKW(pB1,14)};
    SBAR(); pv(o,vb0+sl_cur,PAF(0),PAF(1),PAF(2),PAF(3)); }
  #undef PKW
  #undef PAF
  #undef VFR
  #undef PIN
  #undef MX3
  #undef GAPA
  #undef GAPB
  #undef EX
  #undef VRD
  #undef KRD
  #undef STEP
  #undef ENDW
  {auto rr=__builtin_amdgcn_permlane32_swap(__float_as_uint(l_reg),__float_as_uint(l_reg),false,false);l_reg=__uint_as_float(rr[0])+__uint_as_float(rr[1]);}
  if(hi==0)wsf[32+r32]=l_reg;asm volatile("s_waitcnt lgkmcnt(0)":::"memory");
  float rli[16];
  #pragma unroll
  for(int r=0;r<16;++r)rli[r]=__builtin_amdgcn_rcpf(wsf[32+crow(r,hi)]);
  { unsigned char*stg=(unsigned char*)(shm+LDS_OST)+wid*4096;
    unsigned char*Ow8=(unsigned char*)Ob+(long)(q0+wid*QBLK)*DM;
    #pragma unroll
    for(int r=0;r<16;++r){const int orow=crow(r,hi); const float s_=rli[r]*osc;
      #pragma unroll
      for(int d0=0;d0<2;++d0)stg[orow*64+d0*32+r32]=(unsigned char)(__builtin_amdgcn_cvt_pk_fp8_f32(o[d0][r]*s_,0.f,0u,false)&0xffu);}
    asm volatile("s_waitcnt lgkmcnt(0)":::"memory");
    #pragma unroll
    for(int i=0;i<2;++i){const int row=i*16+(lane>>2),ch=lane&3; const u32x4 v=*(const u32x4*)(stg+row*64+ch*16); ATTN_STORE16(Ow8+(long)row*DM+ch*16,v);} }
  asm volatile("s_waitcnt lgkmcnt(0)\n\ts_barrier":::"memory");
  #undef DMA_K
  #undef DMA_V
  #undef CMASK
  #undef START
  #undef RESC
  #undef ROT
}

constexpr int V128_SLOTB=16384, LDS128_K=0, LDS128_V=NSLOT*SLOTB, LDS128_WS=LDS128_V+NSLOT*V128_SLOTB, LDS128_OST=LDS128_WS+NW*64*4, LDS128_BIAS=LDS128_OST+NW*4096, LDS128_BYTES=LDS128_BIAS+SEQ*8;
__device__ __forceinline__ void pv4(f32x16*o,int vb,bf16x8 pa0,bf16x8 pa1,bf16x8 pa2,bf16x8 pa3){
  #pragma unroll
  for(int d0=0;d0<4;++d0){s16x4 lo[4],hi[4];
    #pragma unroll
    for(int ks=0;ks<4;++ks){
      asm volatile("ds_read_b64_tr_b16 %0,%1 offset:%c2":"=&v"(lo[ks]):"v"(vb),"i"(d0*4096+ks*1024):"memory");
      asm volatile("ds_read_b64_tr_b16 %0,%1 offset:%c2":"=&v"(hi[ks]):"v"(vb),"i"(d0*4096+ks*1024+512):"memory");}
    asm volatile("s_waitcnt lgkmcnt(0)":::"memory");SBAR();
    #define PK(k) (bf16x8){lo[k][0],lo[k][1],lo[k][2],lo[k][3],hi[k][0],hi[k][1],hi[k][2],hi[k][3]}
    o[d0]=__builtin_amdgcn_mfma_f32_32x32x16_bf16(pa0,PK(0),o[d0],0,0,0);
    o[d0]=__builtin_amdgcn_mfma_f32_32x32x16_bf16(pa1,PK(1),o[d0],0,0,0);
    o[d0]=__builtin_amdgcn_mfma_f32_32x32x16_bf16(pa2,PK(2),o[d0],0,0,0);
    o[d0]=__builtin_amdgcn_mfma_f32_32x32x16_bf16(pa3,PK(3),o[d0],0,0,0);
    #undef PK
  }
}
__device__ __forceinline__ void attn_unit128(int qb,int t0,const bf16*Qb,const bf16*__restrict__ Kb,const bf16*__restrict__ Vb,bf16*Ob,char*shm,const int tid,const float bh,const int comb,unsigned char*Oc,const float*lamp,const float*gnorm,const float post,const float eps){
  const int lane=tid&63,r32=lane&31,hi=lane>>5; const int wid=__builtin_amdgcn_readfirstlane(tid>>6);
  const int q0=qb*QB;
  const bf16*Qw=Qb+(long)(q0+wid*QBLK)*DM;
  const bf16*Kh=Kb+(long)t0*KVBLK*DM,*Vh=Vb+(long)t0*KVBLK*DM;
  const unsigned lds0=(unsigned)(uintptr_t)shm;
  float*wsf=(float*)(shm+LDS128_WS)+wid*64;
  const unsigned ksrc=(unsigned)(lane*DM+wid*8)*2u;
  const unsigned vsrc=(unsigned)((16*(wid&3)+(lane>>2))*DM+(wid>>2)*32+(lane&3)*8)*2u;
  const unsigned kdst=lds0+LDS128_K+wid*1024, vdst=lds0+LDS128_V+wid*1024;
  #define DMA_K(t,slot) glds16(Kh+(long)(t)*KVBLK*DM,ksrc,(unsigned)__builtin_amdgcn_readfirstlane(kdst+(slot)))
  #define DMA_V(t,slot) do{ glds16(Vh+(long)(t)*KVBLK*DM,vsrc,(unsigned)__builtin_amdgcn_readfirstlane(vdst+2*(slot))); glds16(Vh+(long)(t)*KVBLK*DM+64,vsrc,(unsigned)__builtin_amdgcn_readfirstlane(vdst+2*(slot)+8192)); }while(0)
  const int vb0=(int)(lds0+LDS128_V)+((lane>>4)&1)*32+(lane&3)*8+(4*hi+((lane&15)>>2))*64;
  const char*Kbase=shm+LDS128_K; bf16x8 kf[8];
  const lds_cptr shm3=(lds_cptr)shm; const lds_cptr kap=shm3+LDS128_BIAS+t0*512+r32*8; const lds_cptr kp0=shm3+LDS128_K+hi*1024+r32*16; const lds_cptr vp0=shm3+LDS128_V+((lane>>4)&1)*32+(lane&3)*8+(4*hi+((lane&15)>>2))*64;
  const int NT=(q0+QB)/KVBLK-t0;
  DMA_K(0,0);DMA_V(0,0);DMA_K(1,SLOTB);
  bf16x8 qr[4];
  #pragma unroll
  for(int d0=0;d0<4;++d0)qr[d0]=*reinterpret_cast<const bf16x8*>(&Qw[(long)r32*DM+d0*16+hi*8]);
  float z_=0.f;asm volatile("":"+v"(z_));float l_reg=z_;f32x16 o[4];
  const float mhat=ka_value(*(const __attribute__((address_space(3))) u32x2v*)((lds_cptr)shm+LDS128_BIAS+(q0+wid*QBLK+r32)*8))+bh;
  bf16x8 qa; { const u32x2v nm=ka_split(-mhat); const u32x4 w=hi==0?(u32x4){0x3F803F80u,0x00003F80u,nm[0],nm[1]}:(u32x4){0u,0u,0u,0u}; qa=__builtin_bit_cast(bf16x8,w); }
  u32x2v ka0,ka1;
  #pragma unroll
  for(int r=0;r<16;++r){o[0][r]=z_;o[1][r]=z_;o[2][r]=z_;o[3][r]=z_;}
  const int qrel=wid*QBLK+r32;
  #define CMASK(P0,P1,t) do{int jb_=(t)-(NT-4); if(jb_>=0)cmask(P0,P1,jb_,qrel,hi);}while(0)
  f32x16 C0,C1;
  int sl_prev=0,sl_cur=0,sl_next=SLOTB;
  #define ROT() do{sl_prev=sl_cur;sl_cur=sl_next;sl_next=(sl_next==(NSLOT-1)*SLOTB)?0:sl_next+SLOTB;}while(0)
  DMA_K(2,2*SLOTB);
  WAIT_BAR(4);
  s16x4 vlo[8],vhi[8]; u32x4 pwA0,pwA1,pwA2,pwA3,pwB0,pwB1,pwB2,pwB3;
  #define PKW(P,B) cvtpk_s(P[B],P[B+1])
  #define PAF(S,k) __builtin_bit_cast(bf16x8,pw##S##k)
  #define VFR(i) (bf16x8){vlo[i][0],vlo[i][1],vlo[i][2],vlo[i][3],vhi[i][0],vhi[i][1],vhi[i][2],vhi[i][3]}
  #define PIN(x) asm volatile("":"+v"(x))
  #define EX(v) __builtin_amdgcn_exp2f(v)
  KAR(0); C0=__builtin_amdgcn_mfma_f32_32x32x16_bf16(KAF(ka0),qa,f32x16{},0,0,0); C1=__builtin_amdgcn_mfma_f32_32x32x16_bf16(KAF(ka1),qa,f32x16{},0,0,0);
  qkt(C0,C1,Kbase,qr,r32,hi);asm volatile("s_nop 15\n\ts_nop 7":"+v"(C0),"+v"(C1));CMASK(C0,C1,0);
  { float sacc=z_;
    _Pragma("unroll") for(int r=0;r<16;++r){C0[r]=EX(C0[r]);C1[r]=EX(C1[r]);}
    _Pragma("unroll") for(int r=0;r<16;++r){sacc+=C0[r];sacc+=C1[r];}
    l_reg+=sacc;
    pwA0=(u32x4){PKW(C0,0),PKW(C0,2),PKW(C0,4),PKW(C0,6)};pwA1=(u32x4){PKW(C0,8),PKW(C0,10),PKW(C0,12),PKW(C0,14)};pwA2=(u32x4){PKW(C1,0),PKW(C1,2),PKW(C1,4),PKW(C1,6)};pwA3=(u32x4){PKW(C1,8),PKW(C1,10),PKW(C1,12),PKW(C1,14)}; }
  WAIT_BAR(0);
  DMA_K(3,0);DMA_V(1,SLOTB);
  ROT();
  kload8(kf,kp0+sl_cur); KAR(1);
  WAIT_BAR(3);
  #define VRD(i) do{ vlo[i]=vtr(vp_+(((i)>>2)*4096+((i)&3)*1024)); vhi[i]=vtr(vp_+(((i)>>2)*4096+((i)&3)*1024+512)); }while(0)
  #define VRD2(i) do{ vlo[i]=vtr(vp_+((2+((i)>>2))*4096+((i)&3)*1024)); vhi[i]=vtr(vp_+((2+((i)>>2))*4096+((i)&3)*1024+512)); }while(0)
  #define KRD(G,j) do{ if(G){ kload2(kf,kp0+sl_next,j); SBAR(); } }while(0)
  #define QKG(V,MF) do{ VRD(V); SBAR(); MF; SBAR(); }while(0)
  #define GB(MF,X,B,W,AFTER) do{ MF; { const float e0_=EX(X[B]), e1_=EX(X[B+1]); sacc+=e0_; sacc+=e1_; W=cvtpk_s(e0_,e1_); } PIN(sacc); PIN(W); AFTER; SBAR(); }while(0)
  #define STEP128(P,N,t,GK,GV,GL) do{ SBAR(); \
    const lds_cptr vp_=vp0+2*sl_prev; \
    C0=__builtin_amdgcn_mfma_f32_32x32x16_bf16(KAF(ka0),qa,f32x16{},0,0,0); C1=__builtin_amdgcn_mfma_f32_32x32x16_bf16(KAF(ka1),qa,f32x16{},0,0,0); SBAR(); \
    QKG(0,C0=__builtin_amdgcn_mfma_f32_32x32x16_bf16(kf[0],qr[0],C0,0,0,0)); \
    QKG(4,C1=__builtin_amdgcn_mfma_f32_32x32x16_bf16(kf[1],qr[0],C1,0,0,0)); \
    QKG(1,C0=__builtin_amdgcn_mfma_f32_32x32x16_bf16(kf[2],qr[1],C0,0,0,0)); \
    QKG(5,C1=__builtin_amdgcn_mfma_f32_32x32x16_bf16(kf[3],qr[1],C1,0,0,0)); \
    QKG(2,C0=__builtin_amdgcn_mfma_f32_32x32x16_bf16(kf[4],qr[2],C0,0,0,0)); \
    QKG(6,C1=__builtin_amdgcn_mfma_f32_32x32x16_bf16(kf[5],qr[2],C1,0,0,0)); \
    QKG(3,C0=__builtin_amdgcn_mfma_f32_32x32x16_bf16(kf[6],qr[3],C0,0,0,0)); \
    QKG(7,C1=__builtin_amdgcn_mfma_f32_32x32x16_bf16(kf[7],qr[3],C1,0,0,0)); \
    if(GK){DMA_K((t)+3,sl_cur);} if(GV){DMA_V((t)+1,sl_next);} \
    CMASK(C0,C1,t); \
    SBAR(); \
    float sacc=z_; \
    GB(o[0]=__builtin_amdgcn_mfma_f32_32x32x16_bf16(PAF(P,0),VFR(0),o[0],0,0,0), C0,0, pw##N##0[0], VRD2(0)); \
    GB(o[1]=__builtin_amdgcn_mfma_f32_32x32x16_bf16(PAF(P,0),VFR(4),o[1],0,0,0), C0,2, pw##N##0[1], VRD2(4)); \
    GB(o[0]=__builtin_amdgcn_mfma_f32_32x32x16_bf16(PAF(P,1),VFR(1),o[0],0,0,0), C0,4, pw##N##0[2], VRD2(1)); \
    GB(o[1]=__builtin_amdgcn_mfma_f32_32x32x16_bf16(PAF(P,1),VFR(5),o[1],0,0,0), C0,6, pw##N##0[3], VRD2(5)); \
    GB(o[0]=__builtin_amdgcn_mfma_f32_32x32x16_bf16(PAF(P,2),VFR(2),o[0],0,0,0), C0,8, pw##N##1[0], VRD2(2)); \
    GB(o[1]=__builtin_amdgcn_mfma_f32_32x32x16_bf16(PAF(P,2),VFR(6),o[1],0,0,0), C0,10,pw##N##1[1], VRD2(6)); \
    GB(o[0]=__builtin_amdgcn_mfma_f32_32x32x16_bf16(PAF(P,3),VFR(3),o[0],0,0,0), C0,12,pw##N##1[2], VRD2(3)); \
    GB(o[1]=__builtin_amdgcn_mfma_f32_32x32x16_bf16(PAF(P,3),VFR(7),o[1],0,0,0), C0,14,pw##N##1[3], VRD2(7)); \
    GB(o[2]=__builtin_amdgcn_mfma_f32_32x32x16_bf16(PAF(P,0),VFR(0),o[2],0,0,0), C1,0, pw##N##2[0], if(GL){KAR((t)+1);}); \
    GB(o[3]=__builtin_amdgcn_mfma_f32_32x32x16_bf16(PAF(P,0),VFR(4),o[3],0,0,0), C1,2, pw##N##2[1], KRD(GL,0)); \
    GB(o[2]=__builtin_amdgcn_mfma_f32_32x32x16_bf16(PAF(P,1),VFR(1),o[2],0,0,0), C1,4, pw##N##2[2], KRD(GL,1)); \
    GB(o[3]=__builtin_amdgcn_mfma_f32_32x32x16_bf16(PAF(P,1),VFR(5),o[3],0,0,0), C1,6, pw##N##2[3], KRD(GL,2)); \
    GB(o[2]=__builtin_amdgcn_mfma_f32_32x32x16_bf16(PAF(P,2),VFR(2),o[2],0,0,0), C1,8, pw##N##3[0], KRD(GL,3)); \
    GB(o[3]=__builtin_amdgcn_mfma_f32_32x32x16_bf16(PAF(P,2),VFR(6),o[3],0,0,0), C1,10,pw##N##3[1], (void)0); \
    GB(o[2]=__builtin_amdgcn_mfma_f32_32x32x16_bf16(PAF(P,3),VFR(3),o[2],0,0,0), C1,12,pw##N##3[2], (void)0); \
    GB(o[3]=__builtin_amdgcn_mfma_f32_32x32x16_bf16(PAF(P,3),VFR(7),o[3],0,0,0), C1,14,pw##N##3[3], (void)0); \
    l_reg+=sacc; \
    }while(0)
  int t=1;
  #undef CMASK
  #define CMASK(P0,P1,t) do{}while(0)
  for(;t+5<NT;t+=2){
    STEP128(A,B,t,true,true,true);     WAIT_BAR(3); ROT();
    STEP128(B,A,t+1,true,true,true);   WAIT_BAR(3); ROT();
  }
  #undef CMASK
  #define CMASK(P0,P1,t) do{int jb_=(t)-(NT-4); if(jb_>=0)cmask(P0,P1,jb_,qrel,hi);}while(0)
  #define ENDW(tt) do{ if((tt)+3<NT){WAIT_BAR(3);} else if((tt)+2<NT){WAIT_BAR(2);} else {WAIT_BAR(0);} }while(0)
  for(;t+1<NT;t+=2){
    STEP128(A,B,t,(t+3<NT),(t+1<NT),(t+1<NT));       ENDW(t);   ROT();
    STEP128(B,A,t+1,(t+4<NT),(t+2<NT),(t+2<NT));     ENDW(t+1); ROT();
  }
  STEP128(A,B,NT-1,false,false,false);
  bf16*Ow=Ob+(long)(q0+wid*QBLK)*DM;
  u32x4 v1r[2][4]; f32x4v gr[2][2];
  if(comb){
    #pragma unroll
    for(int hf=0;hf<2;++hf){
      #pragma unroll
      for(int i=0;i<4;++i)v1r[hf][i]=*(const u32x4*)(Ow+(long)(i*8+(lane>>3))*DM+hf*64+(lane&7)*8);
      gr[hf][0]=*(const f32x4v*)(gnorm+hf*64+(lane&7)*8); gr[hf][1]=*(const f32x4v*)(gnorm+hf*64+(lane&7)*8+4); } }
  SBAR(); pv4(o,vb0+2*sl_cur,PAF(B,0),PAF(B,1),PAF(B,2),PAF(B,3));
  #undef PKW
  #undef PAF
  #undef VFR
  #undef PIN
  #undef EX
  #undef VRD
  #undef VRD2
  #undef KRD
  #undef QKG
  #undef GB
  #undef STEP128
  #undef ENDW
  {auto rr=__builtin_amdgcn_permlane32_swap(__float_as_uint(l_reg),__float_as_uint(l_reg),false,false);l_reg=__uint_as_float(rr[0])+__uint_as_float(rr[1]);}
  if(hi==0)wsf[32+r32]=l_reg;asm volatile("s_waitcnt lgkmcnt(0)":::"memory");
  float rli[16];
  #pragma unroll
  for(int r=0;r<16;++r)rli[r]=__builtin_amdgcn_rcpf(wsf[32+crow(r,hi)]);
  if(!comb){
  #pragma unroll
  for(int hf=0;hf<2;++hf){ bf16*stg=(bf16*)(shm+LDS128_OST)+wid*2048;
    #pragma unroll
    for(int r=0;r<16;++r){const int orow=crow(r,hi);
      #pragma unroll
      for(int d0=0;d0<2;++d0)stg[orow*64+d0*32+r32]=__float2bfloat16(o[2*hf+d0][r]*rli[r]);}
    asm volatile("s_waitcnt lgkmcnt(0)":::"memory");
    #pragma unroll
    for(int i=0;i<4;++i){const int row=i*8+(lane>>3),ch=lane&7; const u32x4 v=*(const u32x4*)(stg+row*64+ch*8); ATTN_STORE16(Ow+(long)row*DM+hf*64+ch*8,v);}
    asm volatile("s_waitcnt lgkmcnt(0)":::"memory"); }
  } else {
    unsigned char*Ocw=Oc+(long)(q0+wid*QBLK)*DM;
    float dd[2][4][8]; float ss[4]={0.f,0.f,0.f,0.f}; const float lam=*lamp;
    #pragma unroll
    for(int hf=0;hf<2;++hf){ bf16*stg=(bf16*)(shm+LDS128_OST)+wid*2048;
      #pragma unroll
      for(int r=0;r<16;++r){const int orow=crow(r,hi);
        #pragma unroll
        for(int d0=0;d0<2;++d0)stg[orow*64+d0*32+r32]=__float2bfloat16(o[2*hf+d0][r]*rli[r]);}
      asm volatile("s_waitcnt lgkmcnt(0)":::"memory");
      #pragma unroll
      for(int i=0;i<4;++i){const int row=i*8+(lane>>3),ch=lane&7; const u32x4 v2=*(const u32x4*)(stg+row*64+ch*8); const u32x4 v1=v1r[hf][i];
        #pragma unroll
        for(int k=0;k<4;++k){ const float a0=__uint_as_float(v1[k]<<16),a1=__uint_as_float(v1[k]&0xffff0000u),b0=__uint_as_float(v2[k]<<16),b1=__uint_as_float(v2[k]&0xffff0000u);
          const float d0_=a0-b0*lam,d1_=a1-b1*lam; dd[hf][i][2*k]=d0_; dd[hf][i][2*k+1]=d1_; ss[i]+=d0_*d0_; ss[i]+=d1_*d1_; } }
      asm volatile("s_waitcnt lgkmcnt(0)":::"memory"); }
    float gg[2][8];
    #pragma unroll
    for(int hf=0;hf<2;++hf){ const f32x4v g0=gr[hf][0], g1=gr[hf][1];
      #pragma unroll
      for(int k=0;k<4;++k){gg[hf][k]=g0[k]*post;gg[hf][4+k]=g1[k]*post;} }
    #pragma unroll
    for(int i=0;i<4;++i){ float s_=ss[i];
      s_+=__uint_as_float((unsigned)__builtin_amdgcn_ds_bpermute((lane^1)<<2,(int)__float_as_uint(s_)));
      s_+=__uint_as_float((unsigned)__builtin_amdgcn_ds_bpermute((lane^2)<<2,(int)__float_as_uint(s_)));
      s_+=__uint_as_float((unsigned)__builtin_amdgcn_ds_bpermute((lane^4)<<2,(int)__float_as_uint(s_)));
      const float rn=1.0f/sqrtf(s_*(1.0f/128.0f)+eps);
      const int row=i*8+(lane>>3),ch=lane&7;
      #pragma unroll
      for(int hf=0;hf<2;++hf){ float e[8];
        #pragma unroll
        for(int k=0;k<8;++k)e[k]=dd[hf][i][k]*rn*gg[hf][k];
        unsigned w0=__builtin_amdgcn_cvt_pk_fp8_f32(e[0],e[1],0u,false); w0=__builtin_amdgcn_cvt_pk_fp8_f32(e[2],e[3],w0,true);
        unsigned w1=__builtin_amdgcn_cvt_pk_fp8_f32(e[4],e[5],0u,false); w1=__builtin_amdgcn_cvt_pk_fp8_f32(e[6],e[7],w1,true);
        *(u32x2v*)(Ocw+(long)row*DM+hf*64+ch*8)=(u32x2v){w0,w1}; } }
  }
  asm volatile("s_waitcnt lgkmcnt(0)\n\ts_barrier":::"memory");
  #undef DMA_K
  #undef DMA_V
  #undef CMASK
  #undef ROT
}
constexpr int ATTN_LDS_BYTES=LDS_BYTES;
#undef SBAR
#undef WAIT_BAR
}


#ifndef ABLP
#define ABLP 0
#endif
#ifndef REP_ATTN
#define REP_ATTN 1
#endif
#ifndef REP_P1
#define REP_P1 1
#endif
#ifndef REP_P3
#define REP_P3 1
#endif
#ifndef REP_P5
#define REP_P5 1
#endif
#ifndef REP_P6
#define REP_P6 1
#endif
#ifndef REP_LN1
#define REP_LN1 1
#endif
#ifndef REP_LN2
#define REP_LN2 1
#endif
#ifndef REP_COMB
#define REP_COMB 1
#endif
#ifndef REP_BAR
#define REP_BAR 1
#endif
#ifndef REP_FILL
#define REP_FILL 1
#endif
#ifndef DRY_REP
#define DRY_REP 0
#endif
#ifndef REP_ATTN_FOX
#define REP_ATTN_FOX REP_ATTN
#endif
#ifndef PROBE_NODOT
#define PROBE_NODOT 0
#endif
#ifndef REP_CONV
#define REP_CONV 1
#endif
#ifndef REP_P0B
#define REP_P0B 1
#endif
#ifndef REP_P0
#define REP_P0 1
#endif
#ifndef MK_PER_PHASE
#define MK_PER_PHASE 0
#endif
constexpr int NWAVES = 8;
constexpr int NB = 8, SEQ = 4096, DM = 1024, NT = NB * SEQ;
constexpr int NPH = 2 + 8 * 4;
constexpr float ALPHA = 1.6817928305074292f;
constexpr float LN_EPS = 1e-5f;
constexpr float LOG2E = 1.4426950408889634f;
constexpr float QSCALE = 0.125f * LOG2E;
constexpr float W1SCALE = 32.0f, W2SCALE = 64.0f, ASCALE = 4.0f, WQK = 32.0f, WV = 64.0f, OSC = 4.0f, YSC = 8.0f, DNSC = 16.0f;

typedef unsigned short bf16;
typedef float f32x4 __attribute__((ext_vector_type(4)));
typedef float f32x2 __attribute__((ext_vector_type(2)));
typedef unsigned u32x4 __attribute__((ext_vector_type(4)));
typedef unsigned u32x2 __attribute__((ext_vector_type(2)));

typedef const __attribute__((address_space(4))) unsigned char* kaptr;
#define INP(k) (*(const float* const __attribute__((address_space(4)))*)(ka + 8 * (k)))
constexpr size_t MiB = 1u << 20;
constexpr size_t WS_CTL = 0, CTL_ZERO_BYTES = 1 * MiB;
constexpr size_t WS_MOD = 1 * MiB;
constexpr size_t WS_KVMOD = WS_MOD + 768 * 1024;
constexpr size_t WS_BT = WS_MOD + 896 * 1024;
constexpr size_t WS_LC = 2 * MiB;
constexpr size_t WS_TOK = 4 * MiB;
constexpr size_t WS_PERM = 5 * MiB;
constexpr size_t WS_GWT = 7 * MiB;
constexpr size_t WS_FOXIN = 10 * MiB, WS_FOXO = 22 * MiB, WS_KVW = 26 * MiB, WS_DQ = 30 * MiB, WS_DO = 34 * MiB, WS_MOE1 = 38 * MiB, WS_MOE2 = 70 * MiB;
constexpr size_t WS_ACT = 86 * MiB, ACT_BYTES = 64 * MiB;
constexpr size_t WS_END = WS_ACT + 6 * ACT_BYTES;
constexpr int CW_TMO = 0;
constexpr int CW_BAR = 4096;
constexpr int CW_QUEUE = 190000;
constexpr int CW_NORM = 210000, CW_KVN = CW_NORM + 4096;
constexpr int CW_CNT = 200000;
constexpr int RING_BYTES = 131072, LDSCTL_OFF = 141312  , MISC_OFF = LDSCTL_OFF + 320, MOETAB_OFF = LDSCTL_OFF + 1024, PARK_OFF = LDSCTL_OFF + 2048  , NORML_OFF = LDSCTL_OFF + 10240  , QW_OFF = LDSCTL_OFF + 512, LDS_BYTES = LDSCTL_OFF + 16384;

#define RLX_AGENT __ATOMIC_RELAXED, __HIP_MEMORY_SCOPE_AGENT
__device__ __forceinline__ unsigned pk2(float lo, float hi) { return pg8::cvt_pk_bf16(lo, hi); }
__device__ __forceinline__ f32x4 unpack4(u32x2 w) { f32x4 r; r.x = __uint_as_float(w.x << 16); r.y = __uint_as_float(w.x & 0xffff0000u); r.z = __uint_as_float(w.y << 16); r.w = __uint_as_float(w.y & 0xffff0000u); return r; }
__device__ __forceinline__ f32x4 unpack4_fp8(unsigned w) { const f32x2 lo = __builtin_amdgcn_cvt_pk_f32_fp8((int)w, false), hi = __builtin_amdgcn_cvt_pk_f32_fp8((int)w, true); return (f32x4){lo.x, lo.y, hi.x, hi.y}; }
__device__ __forceinline__ float xshfl(float v, int m, int lane) { return __uint_as_float((unsigned)__builtin_amdgcn_ds_bpermute((lane ^ m) << 2, (int)__float_as_uint(v))); }
__device__ __forceinline__ float wave_sum(float v, int lane) {
#pragma unroll
    for (int o = 1; o < 64; o <<= 1) v += xshfl(v, o, lane);
    return v;
}

#define XB_TMO      128
#define XB_XCNT(j)  (256  + 64 * (j))
#define XB_XSUB(j)  (1280 + 64 * (j))
#define XB_XGEN(j)  (2304 + 64 * (j))
#define XB_TOP      3328
#define XB_TOPGEN   3392
#define XCD_BAR_WORDS 3456
#define XB_SPIN_CAP (1u << 18)

__device__ __forceinline__ unsigned xb_ld(unsigned* p)              { return __hip_atomic_load(p, __ATOMIC_RELAXED, __HIP_MEMORY_SCOPE_AGENT); }
__device__ __forceinline__ unsigned xb_add(unsigned* p, unsigned v) { return __hip_atomic_fetch_add(p, v, __ATOMIC_RELAXED, __HIP_MEMORY_SCOPE_AGENT); }
__device__ __forceinline__ unsigned xb_xcc_id() { return (unsigned)__builtin_amdgcn_s_getreg((3 << 11) | 20) & 0xFu; }
#define XB_SPIN(cond, bar) do { unsigned _sp = 0; while (cond) { __builtin_amdgcn_s_sleep(1); \
    if ((++_sp & 255u) == 0u) { if (xb_ld(&(bar)[XB_TMO])) break; if (_sp > XB_SPIN_CAP) { atomicAdd(&(bar)[XB_TMO], 1u); break; } } } } while (0)

struct XcdBarrier {
    unsigned* bar; unsigned x;
    volatile LAS unsigned* st;
};

__device__ __forceinline__ XcdBarrier xcd_barrier_post(unsigned* bar, volatile LAS unsigned* st) {
    XcdBarrier b; b.bar = bar; b.x = xb_xcc_id(); b.st = st;
    if (threadIdx.x == 0) (void)xb_add(&bar[XB_XCNT(b.x)], 1u);
    return b;
}
__device__ __forceinline__ void xcd_barrier_complete(unsigned* bar, unsigned x, unsigned& nloc, unsigned& nx) {
    const unsigned G = gridDim.x * gridDim.y * gridDim.z;
    unsigned sum, cnt, mine, sp = 0u;
    for (;;) {
        sum = 0u; cnt = 0u; mine = 0u;
#pragma unroll
        for (unsigned j = 0; j < 16; ++j) { const unsigned c = xb_ld(&bar[XB_XCNT(j)]); sum += c; cnt += (c > 0u) ? 1u : 0u; mine = (j == x) ? c : mine; }
        if (sum == G) break;
        __builtin_amdgcn_s_sleep(1);
        if ((++sp & 255u) == 0u) { if (xb_ld(&bar[XB_TMO])) break; if (sp > XB_SPIN_CAP) { atomicAdd(&bar[XB_TMO], 1u); break; } }
    }
    nloc = mine > 0u ? mine : 1u; nx = cnt > 0u ? cnt : 1u;
}

__device__ __forceinline__ void xcd_barrier(const XcdBarrier& b) {
    asm volatile("s_waitcnt vmcnt(0)" ::: "memory");
    __syncthreads();
    if (threadIdx.x == 0) {
        unsigned* bar = b.bar;
        __builtin_amdgcn_s_waitcnt(0);
        unsigned nloc = b.st[0], nx = b.st[1];
        if (nloc == 0u) { xcd_barrier_complete(bar, b.x, nloc, nx); b.st[0] = nloc; b.st[1] = nx; }
        const unsigned old = xb_add(&bar[XB_XSUB(b.x)], 1u);
        const unsigned gen = old / nloc;
        if (old + 1u == (gen + 1u) * nloc) {
            __builtin_amdgcn_fence(__ATOMIC_RELEASE, "agent");
            asm volatile("s_waitcnt vmcnt(0)" ::: "memory");
            const unsigned og = xb_add(&bar[XB_TOP], 1u);
            const unsigned tg = og / nx;
            if (og + 1u == (tg + 1u) * nx) xb_add(&bar[XB_TOPGEN], 1u);
            else XB_SPIN(xb_ld(&bar[XB_TOPGEN]) == tg, bar);
            __builtin_amdgcn_fence(__ATOMIC_ACQUIRE, "agent");
            xb_add(&bar[XB_XGEN(b.x)], 1u);
            asm volatile("s_waitcnt vmcnt(0)" ::: "memory");
        } else {
            XB_SPIN(xb_ld(&bar[XB_XGEN(b.x)]) == gen, bar);
            __builtin_amdgcn_fence(__ATOMIC_ACQUIRE, "agent");
            asm volatile("s_waitcnt vmcnt(0)" ::: "memory");
        }
    }
    __syncthreads();
}

__device__ __forceinline__ void transpose_item(const float* W, int ld, int K, bf16* WT, int drow0, int k0, int n0, LAS float* scr, int lane, float qs) {
#pragma unroll 8
    for (int i = 0; i < 32; ++i) { const int kk = 2 * i + (lane >> 5); scr[kk * 33 + (lane & 31)] = W[(size_t)(k0 + kk) * ld + n0 + (lane & 31)]; (void)qs; }
    asm volatile("s_waitcnt lgkmcnt(0)" ::: "memory");
    const int c = lane & 7;
#pragma unroll
    for (int j = 0; j < 4; ++j) { const int n = (lane >> 3) + 8 * j; const LAS float* s = scr + (8 * c) * 33 + n;
        u32x4 o; o.x = pk2(s[0 * 33], s[1 * 33]); o.y = pk2(s[2 * 33], s[3 * 33]); o.z = pk2(s[4 * 33], s[5 * 33]); o.w = pk2(s[6 * 33], s[7 * 33]);
        *(u32x4*)(WT + (size_t)(drow0 + n) * K + k0 + 8 * c) = o; }
    asm volatile("s_waitcnt lgkmcnt(0)" ::: "memory");
}

__device__ __forceinline__ void transpose_item_fp8(const float* W, int ld, int K, unsigned char* WT, int drow0, int k0, int n0, LAS float* scr, int lane, float scale) {
#pragma unroll 8
    for (int i = 0; i < 32; ++i) { const int kk = 2 * i + (lane >> 5); scr[kk * 33 + (lane & 31)] = __builtin_nontemporal_load(W + (size_t)(k0 + kk) * ld + n0 + (lane & 31)) * scale; }
    asm volatile("s_waitcnt lgkmcnt(0)" ::: "memory");
    const int c = lane & 7;
#pragma unroll
    for (int j = 0; j < 4; ++j) { const int n = (lane >> 3) + 8 * j; const LAS float* s = scr + (8 * c) * 33 + n;
        u32x2 o; o.x = pg8::pk4_fp8(s[0 * 33], s[1 * 33], s[2 * 33], s[3 * 33]); o.y = pg8::pk4_fp8(s[4 * 33], s[5 * 33], s[6 * 33], s[7 * 33]);
        *(u32x2*)(WT + (size_t)(drow0 + n) * K + k0 + 8 * c) = o; }
    asm volatile("s_waitcnt lgkmcnt(0)" ::: "memory");
}

__device__ __forceinline__ void p0_prologue(LAS unsigned char* L, kaptr ka, unsigned char* ws, int tid, int lane, int wave, int bx, int G, int vcu) {
    LAS float* sc = (LAS float*)L;
    LAS float* part = (LAS float*)(L + 32768);
    const float* cin = INP(1);
    for (int i = tid; i < NB * DM; i += NWAVES * 64) { const float v = cin[i]; sc[i] = v / (1.0f + __expf(-v)); }
    __syncthreads();
    for (int task = bx; task < 208; task += G) {
        const float* W; const float* bias; float* out; int ld, n0;
        if (task < 192) { const int l = task / 48, ch = task % 48; W = INP(2) + (size_t)l * DM * 6144; ld = 6144; n0 = ch * 128; bias = INP(3) + l * 6144; out = (float*)(ws + WS_MOD) + (size_t)l * NB * 6144; }
        else { const int ch = task - 192; W = INP(11); ld = 2048; n0 = ch * 128; bias = INP(12); out = (float*)(ws + WS_KVMOD); }
        float acc[8][2];
#pragma unroll
        for (int b = 0; b < 8; ++b) { acc[b][0] = 0.f; acc[b][1] = 0.f; }
        const float* wp = W + (size_t)(wave * 128) * ld + n0 + 2 * lane;
        for (int k4 = 0; k4 < 32; ++k4) {
            f32x2 wv[4];
#pragma unroll
            for (int kk = 0; kk < 4; ++kk) wv[kk] = __builtin_nontemporal_load((const f32x2*)(wp + (size_t)(4 * k4 + kk) * ld));
#pragma unroll
            for (int b = 0; b < 8; ++b) { const f32x4 s = *(const LAS f32x4*)(sc + b * DM + wave * 128 + 4 * k4);
#pragma unroll
                for (int kk = 0; kk < 4; ++kk) { acc[b][0] += s[kk] * wv[kk].x; acc[b][1] += s[kk] * wv[kk].y; } }
        }
#pragma unroll
        for (int b = 0; b < 8; ++b) *(LAS f32x2*)(part + (wave * 8 + b) * 128 + 2 * lane) = (f32x2){acc[b][0], acc[b][1]};
        __syncthreads();
        for (int o = tid; o < 8 * 128; o += NWAVES * 64) { const int b = o >> 7, col = o & 127; float s = bias[n0 + col];
#pragma unroll
            for (int w = 0; w < 8; ++w) s += part[(w * 8 + b) * 128 + col];
            out[(size_t)b * ld + n0 + col] = s; }
        __syncthreads();
    }
    __syncthreads();
    LAS float* scr = (LAS float*)(L + wave * 16384);
    const int gw = vcu * NWAVES + wave, NGW = G * NWAVES;
    constexpr int I_IN = 16 * 96, I_SQ = 16 * 32, I_KV = 16 * 64;
#define HEADPERM(n0) (((n0) & ~255) + 128 * ((((n0) & 255) & 63) >> 5) + 32 * (((n0) & 255) >> 6))
    constexpr int NITEMS = 2 * I_IN + 2 * I_SQ + I_KV + 2 * I_SQ + 2 * I_SQ;
    for (int it = gw; it < NITEMS; it += NGW) {
        int r = it;
        if (r < 2 * I_IN) { const int l = r / I_IN; r %= I_IN; transpose_item_fp8(INP(8) + (size_t)l * DM * 3088, 3088, DM, (unsigned char*)(ws + WS_FOXIN) + (size_t)l * 3072 * DM, HEADPERM(32 * (r % 96)), 64 * (r / 96), 32 * (r % 96), scr, lane, (r % 96) < 64 ? WQK : WV); continue; } r -= 2 * I_IN;
        if (r < 2 * I_SQ) { const int l = r / I_SQ; r %= I_SQ; transpose_item_fp8(INP(10) + (size_t)l * DM * DM, DM, DM, (unsigned char*)(ws + WS_FOXO) + (size_t)l * DM * DM, 32 * (r % 32), 64 * (r / 32), 32 * (r % 32), scr, lane, WV); continue; } r -= 2 * I_SQ;
        if (r < I_KV) { transpose_item_fp8(INP(13), 2048, DM, (unsigned char*)(ws + WS_KVW), HEADPERM(32 * (r % 64)), 64 * (r / 64), 32 * (r % 64), scr, lane, (r % 64) < 32 ? WQK : WV); continue; } r -= I_KV;
        if (r < 2 * I_SQ) { const int l = r / I_SQ; r %= I_SQ; transpose_item_fp8(INP(14) + (size_t)l * DM * DM, DM, DM, (unsigned char*)(ws + WS_DQ) + (size_t)l * DM * DM, HEADPERM(32 * (r % 32)), 64 * (r / 32), 32 * (r % 32), scr, lane, WQK); continue; } r -= 2 * I_SQ;
        { const int l = r / I_SQ; r %= I_SQ; transpose_item_fp8(INP(17) + (size_t)l * DM * DM, DM, DM, (unsigned char*)(ws + WS_DO) + (size_t)l * DM * DM, 32 * (r % 32), 64 * (r / 32), 32 * (r % 32), scr, lane, WV); }
    }
}
__device__ __forceinline__ void moe_weight_copies(LAS unsigned char* L, kaptr ka, unsigned char* ws, int l, int lane, int wave, int G, int vcu) {
    LAS float* scr = (LAS float*)(L + wave * 16384);
    const int gw = vcu * NWAVES + wave, NGW = G * NWAVES;
    for (int it = gw; it < 12288; it += NGW) {
        const int which = it >> 12, e = (it >> 8) & 15, r = it & 255;
        if (which < 2) { const int kb = r >> 4, nb = r & 15, n0 = 32 * nb;
            transpose_item_fp8((which == 0 ? INP(20) : INP(21)) + (size_t)(l * 16 + e) * DM * 512, 512, DM, (unsigned char*)(ws + WS_MOE1) + (size_t)e * DM * DM, (n0 >> 7) * 256 + (n0 & 127) + which * 128, 64 * kb, n0, scr, lane, W1SCALE); }
        else { const int kb = r >> 5, nb = r & 31;
            transpose_item_fp8(INP(22) + (size_t)(l * 16 + e) * 512 * DM, DM, 512, (unsigned char*)(ws + WS_MOE2) + (size_t)e * DM * 512, 32 * nb, 64 * kb, 32 * nb, scr, lane, W2SCALE); }
    }
}

__device__ __forceinline__ void route16(const float (&lg)[16], const LAS float* rb, int& e0, int& e1, float& w0, float& w1) {
    float mx = lg[0];
#pragma unroll
    for (int e = 1; e < 16; ++e) mx = fmaxf(mx, lg[e]);
    float p[16], sum = 0.f;
#pragma unroll
    for (int e = 0; e < 16; ++e) { p[e] = __expf(lg[e] - mx); sum += p[e]; }
    const float inv = 1.0f / sum;
    int be0 = 0, be1 = 1; float bp0 = 0.f, bp1 = 0.f, gbest = -INFINITY;
#pragma unroll
    for (int g = 0; g < 4; ++g) {
        float a[4], q[4];
#pragma unroll
        for (int i = 0; i < 4; ++i) { q[i] = p[4 * g + i] * inv; a[i] = q[i] + rb[4 * g + i]; }
        int i0 = 0; float v0 = a[0], q0 = q[0];
#pragma unroll
        for (int i = 1; i < 4; ++i) if (a[i] > v0) { v0 = a[i]; i0 = i; q0 = q[i]; }
        int i1 = 0; float v1 = -INFINITY, q1 = 0.f;
#pragma unroll
        for (int i = 0; i < 4; ++i) if (i != i0 && a[i] > v1) { v1 = a[i]; i1 = i; q1 = q[i]; }
        const float gs = v0 + v1;
        if (gs > gbest) { gbest = gs; be0 = 4 * g + i0; be1 = 4 * g + i1; bp0 = q0; bp1 = q1; }
    }
    e0 = be0; e1 = be1; const float ws_ = 1.0f / (bp0 + bp1); w0 = bp0 * ws_; w1 = bp1 * ws_;
}

struct RowsCfg {
    const float* xin_f32; const bf16* xin_bf;
    bf16* xout_bf; float* xout_f32;
    const unsigned char* src; float src_inv;
    const float* gate; const float* gamma; const float* beta;
    const float* sc; const float* sh; bf16* hout; int hout_fp8;
    const float* sc2; const float* sh2; bf16* hout2;
    const float* w16; int w16_ld; int dotmode;
    const float* rb;
    unsigned* cnt; int* perm; float* gwt; unsigned* tokslot;
    float* lc; float* bt;
};
template <int MODE, bool XF32>
__device__ __forceinline__ void rows_load(f32x4 (&xf)[4], u32x4 (&xb)[2], u32x2 (&s0)[2], u32x2 (&s1)[2], const RowsCfg& c, int row, int slot0, int slot1, int lane) {
    if (XF32) { const f32x4* xr = (const f32x4*)(c.xin_f32 + (size_t)row * DM) + 2 * lane;
#pragma unroll
        for (int q = 0; q < 4; ++q) xf[q] = xr[128 * (q >> 1) + (q & 1)]; }
    else { const u32x4* xr = (const u32x4*)(c.xin_bf + (size_t)row * DM) + lane;
#pragma unroll
        for (int j = 0; j < 2; ++j) xb[j] = xr[64 * j]; }
    if (MODE == 1) { const u32x2* yr = (const u32x2*)(c.src + (size_t)row * DM) + lane;
#pragma unroll
        for (int j = 0; j < 2; ++j) s0[j] = yr[64 * j]; }
    if (MODE == 2) { const u32x2* r0 = (const u32x2*)(c.src + (size_t)slot0 * DM) + lane; const u32x2* r1 = (const u32x2*)(c.src + (size_t)slot1 * DM) + lane;
#pragma unroll
        for (int j = 0; j < 2; ++j) { s0[j] = r0[64 * j]; s1[j] = r1[64 * j]; } }
}
template <int MODE, bool XF32>
__device__ __forceinline__ void rows_phase(LAS unsigned char* L, const RowsCfg& c, int tid, int lane, int wave, int bx) {
    LAS u32x4* WB = (LAS u32x4*)L;
    LAS u32x4* ST = (LAS u32x4*)(L + 32768 + wave * 8192);
    LAS f32x4* VEC = (LAS f32x4*)(L + 98304);
    LAS float* LF = (LAS float*)(L + 126976);
    LAS int* RE = (LAS int*)(L + 135168);
    LAS float* RW = (LAS float*)(L + 136192);
    LAS int* LP = (LAS int*)(L + 137216);
    LAS int* HIST = (LAS int*)(L + 138240);
    LAS int* GB = HIST + 16; LAS int* OFF = HIST + 32; LAS float* RB = (LAS float*)(HIST + 48);
    LAS float* LG2 = (LAS float*)(L + 126976);
    if (tid < 256) {
        if (MODE != 0) { VEC[0 * 256 + tid] = (((const f32x4*)c.gate)[tid] + 1.0f) * c.src_inv;     VEC[1 * 256 + tid] = ((const f32x4*)c.gamma)[tid]; VEC[2 * 256 + tid] = ((const f32x4*)c.beta)[tid]; }
        if (c.hout) { VEC[3 * 256 + tid] = ((const f32x4*)c.sc)[tid]; VEC[4 * 256 + tid] = ((const f32x4*)c.sh)[tid]; }
        if (c.hout2) { VEC[5 * 256 + tid] = ((const f32x4*)c.sc2)[tid]; VEC[6 * 256 + tid] = ((const f32x4*)c.sh2)[tid]; }
    }
    if (tid < 16) { HIST[tid] = 0; if (c.dotmode) RB[tid] = c.rb[tid]; }
    if (MODE == 2 && tid < 16) GB[tid] = (int)__hip_atomic_load(c.cnt + tid, RLX_AGENT);
    if (c.dotmode) for (int idx = tid; idx < 2048; idx += NWAVES * 64) { const int s = idx >> 6, ln = idx & 63, e = ln & 15, k0 = 32 * s + 8 * (ln >> 4); float w[8];
#pragma unroll
        for (int j = 0; j < 8; ++j) w[j] = c.w16[(size_t)(k0 + j) * c.w16_ld + e];
        WB[idx] = (u32x4){pk2(w[0], w[1]), pk2(w[2], w[3]), pk2(w[4], w[5]), pk2(w[6], w[7])}; }
    __syncthreads();
    if (MODE == 2) { if (tid == 0) { int so = 0;
#pragma unroll
        for (int e = 0; e < 16; ++e) { OFF[e] = so; so += GB[e]; } }
        __syncthreads(); }
    const int rowb = bx * 128 + wave * 16;
#define VQ(vec, q) VEC[(vec) * 256 + 2 * lane + 128 * ((q) >> 1) + ((q) & 1)]
    int myslot = 0; float myw = 0.f;
    if (MODE == 2) { const unsigned t = c.tokslot[rowb * 2 + (lane & 31)]; myslot = OFF[t >> 16] + (int)(t & 0xffffu); myw = c.gwt[rowb * 2 + (lane & 31)]; }
#define ROWS_SLOT(r, k) (MODE == 2 ? __builtin_amdgcn_readlane(myslot, 2 * (r) + (k)) : 0)
    auto compute = [&](f32x4 (&Bxf)[2][4], u32x4 (&Bxb)[2][2], u32x2 (&Bs0)[2][2], u32x2 (&Bs1)[2][2], const int g, const bool mma) __attribute__((always_inline)) {
        f32x4 hv[2][4];
#pragma unroll
        for (int rr = 0; rr < 2; ++rr) {
            const int row = rowb + 2 * g + rr;
            f32x4 v[4];
#pragma unroll
            for (int q = 0; q < 4; ++q) { if (XF32) v[q] = Bxf[rr][q]; else { const u32x4 w = Bxb[rr][q >> 1]; v[q] = (q & 1) ? unpack4((u32x2){w.z, w.w}) : unpack4((u32x2){w.x, w.y}); } }
            if (MODE != 0) {
                float gw0 = 1.f, gw1 = 1.f; if (MODE == 2) { gw0 = __uint_as_float(__builtin_amdgcn_readlane(__float_as_uint(myw), 2 * (2 * g + rr))); gw1 = __uint_as_float(__builtin_amdgcn_readlane(__float_as_uint(myw), 2 * (2 * g + rr) + 1)); }
                float sm = 0.f;
#pragma unroll
                for (int q = 0; q < 4; ++q) { const unsigned w0 = (q & 1) ? Bs0[rr][q >> 1].y : Bs0[rr][q >> 1].x; f32x4 s = unpack4_fp8(w0);
                    if (MODE == 2) { const unsigned w1 = (q & 1) ? Bs1[rr][q >> 1].y : Bs1[rr][q >> 1].x; s = s * gw0 + unpack4_fp8(w1) * gw1; }
                    const f32x4 gt = VQ(0, q); v[q] = v[q] * ALPHA + gt * s; sm += (v[q].x + v[q].y) + (v[q].z + v[q].w); }
                const float mean = wave_sum(sm, lane) * (1.0f / DM); float s2 = 0.f;
#pragma unroll
                for (int q = 0; q < 4; ++q) { v[q] = v[q] - mean; s2 += (v[q].x * v[q].x + v[q].y * v[q].y) + (v[q].z * v[q].z + v[q].w * v[q].w); }
                const float rstd = 1.0f / sqrtf(wave_sum(s2, lane) * (1.0f / DM) + LN_EPS);
#pragma unroll
                for (int q = 0; q < 4; ++q) v[q] = v[q] * rstd * VQ(1, q) + VQ(2, q);
                if (c.xout_f32) { f32x4* xo = (f32x4*)(c.xout_f32 + (size_t)row * DM) + 2 * lane;
#pragma unroll
                    for (int q = 0; q < 4; ++q) xo[128 * (q >> 1) + (q & 1)] = v[q]; }
                else { u32x4* xo = (u32x4*)(c.xout_bf + (size_t)row * DM) + lane;
#pragma unroll
                    for (int j = 0; j < 2; ++j) xo[64 * j] = (u32x4){pk2(v[2 * j].x, v[2 * j].y), pk2(v[2 * j].z, v[2 * j].w), pk2(v[2 * j + 1].x, v[2 * j + 1].y), pk2(v[2 * j + 1].z, v[2 * j + 1].w)}; }
            }
            if (c.hout) { u32x2* ho = (u32x2*)((unsigned char*)c.hout + (size_t)row * DM) + lane;
#pragma unroll
                for (int q = 0; q < 4; ++q) hv[rr][q] = v[q] * (VQ(3, q) + 1.0f) + VQ(4, q);
#pragma unroll
                for (int j = 0; j < 2; ++j) ho[64 * j] = (u32x2){pg8::pk4_fp8(hv[rr][2 * j].x, hv[rr][2 * j].y, hv[rr][2 * j].z, hv[rr][2 * j].w), pg8::pk4_fp8(hv[rr][2 * j + 1].x, hv[rr][2 * j + 1].y, hv[rr][2 * j + 1].z, hv[rr][2 * j + 1].w)}; }
            if (c.hout2) { u32x2* ho = (u32x2*)((unsigned char*)c.hout2 + (size_t)row * DM) + lane;
#pragma unroll
                for (int j = 0; j < 2; ++j) { const f32x4 ha = v[2 * j] * (VQ(5, 2 * j) + 1.0f) + VQ(6, 2 * j), hb = v[2 * j + 1] * (VQ(5, 2 * j + 1) + 1.0f) + VQ(6, 2 * j + 1);
                    ho[64 * j] = (u32x2){pg8::pk4_fp8(ha.x, ha.y, ha.z, ha.w), pg8::pk4_fp8(hb.x, hb.y, hb.z, hb.w)}; } }
        }
        if (c.dotmode) {
#pragma unroll
            for (int rr = 0; rr < 2; ++rr)
#pragma unroll
                for (int j = 0; j < 2; ++j) ST[(2 * (g & 1) + rr) * 128 + lane + 64 * j] = (u32x4){pk2(hv[rr][2 * j].x, hv[rr][2 * j].y), pk2(hv[rr][2 * j].z, hv[rr][2 * j].w), pk2(hv[rr][2 * j + 1].x, hv[rr][2 * j + 1].y), pk2(hv[rr][2 * j + 1].z, hv[rr][2 * j + 1].w)};
            if (mma) {
                f32x4 acc = {0.f, 0.f, 0.f, 0.f};
                const LAS u32x4* ap = ST + (lane & 3) * 128 + (lane >> 4);
#pragma unroll 8
                for (int s = 0; s < 32; ++s) acc = __builtin_amdgcn_mfma_f32_16x16x32_bf16(__builtin_bit_cast(pg8::bf16x8, ap[4 * s]), __builtin_bit_cast(pg8::bf16x8, WB[64 * s + lane]), acc, 0, 0, 0);
                if (lane < 16) {
#pragma unroll
                    for (int rr = 0; rr < 4; ++rr) { const float tot = acc[rr]; const int rl = wave * 16 + 2 * (g - 1) + rr;
                        if (c.dotmode == 2) { const float z = tot + RB[lane]; LF[rl * 16 + lane] = fminf(z, 0.f) - 0.6931471805599453f * __builtin_amdgcn_logf(1.0f + __builtin_amdgcn_exp2f(-LOG2E * fabsf(z))); }
                        else LG2[rl * 16 + lane] = tot; } }
            }
        }
    };
    f32x4 Axf[2][4], Bxf[2][4]; u32x4 Axb[2][2], Bxb[2][2]; u32x2 As0[2][2], Bs0[2][2], As1[2][2], Bs1[2][2];
#define ROWS_LD(P, rr, r) rows_load<MODE, XF32>(P##xf[rr], P##xb[rr], P##s0[rr], P##s1[rr], c, rowb + (r), ROWS_SLOT((r), 0), ROWS_SLOT((r), 1), lane)
    ROWS_LD(A, 0, 0); ROWS_LD(A, 1, 1);
#pragma unroll 1
    for (int g = 0; g < 8; g += 2) {
        ROWS_LD(B, 0, 2 * g + 2); ROWS_LD(B, 1, 2 * g + 3);
        compute(Axf, Axb, As0, As1, g, false);
        if (g + 2 < 8) { ROWS_LD(A, 0, 2 * g + 4); ROWS_LD(A, 1, 2 * g + 5); }
        compute(Bxf, Bxb, Bs0, Bs1, g + 1, true);
    }
#undef ROWS_LD
#undef ROWS_SLOT
#undef VQ
    if (c.dotmode == 1) {
        asm volatile("s_waitcnt lgkmcnt(0)" ::: "memory");
        if (lane < 16) { float lg[16];
#pragma unroll
            for (int e = 0; e < 16; ++e) lg[e] = LG2[(wave * 16 + lane) * 16 + e];
            int e0, e1; float w0, w1; route16(lg, RB, e0, e1, w0, w1);
            const int rl = wave * 16 + lane;
            RE[rl * 2] = e0; RE[rl * 2 + 1] = e1; RW[rl * 2] = w0; RW[rl * 2 + 1] = w1;
            LP[rl * 2] = __hip_atomic_fetch_add(HIST + e0, 1, __ATOMIC_RELAXED, __HIP_MEMORY_SCOPE_WORKGROUP);
            LP[rl * 2 + 1] = __hip_atomic_fetch_add(HIST + e1, 1, __ATOMIC_RELAXED, __HIP_MEMORY_SCOPE_WORKGROUP); }
    }
    __syncthreads();
    if (c.dotmode == 2) {
        const int b = bx >> 5, blk = bx & 31;
        if (tid < 16) { float run = 0.f;
            for (int i = 0; i < 128; ++i) { run += LF[i * 16 + tid]; LF[i * 16 + tid] = run; }
            c.bt[(b * 16 + tid) * 32 + blk] = run; }
        __syncthreads();
        { const int e = tid >> 5, i0 = 4 * (tid & 31);
          const f32x4 o = {LF[(i0 + 0) * 16 + e], LF[(i0 + 1) * 16 + e], LF[(i0 + 2) * 16 + e], LF[(i0 + 3) * 16 + e]};
          *(f32x4*)(c.lc + (size_t)(b * 16 + e) * SEQ + blk * 128 + i0) = o; }
    }
    if (c.dotmode == 1) {
        if (c.cnt == nullptr) { __syncthreads(); return; }
        if (tid < 16) GB[tid] = (int)__hip_atomic_fetch_add(c.cnt + tid, (unsigned)HIST[tid], RLX_AGENT);
        __syncthreads();
        if (tid < 128) { const int row = bx * 128 + tid;
#pragma unroll
            for (int k = 0; k < 2; ++k) { const int e = RE[tid * 2 + k], pos = GB[e] + LP[tid * 2 + k];
                c.perm[e * 32768 + pos] = row; c.gwt[row * 2 + k] = RW[tid * 2 + k]; c.tokslot[row * 2 + k] = ((unsigned)e << 16) | (unsigned)pos; } }
    }
    __syncthreads();
}

__device__ __forceinline__ void combine_phase(const bf16* O1, const bf16* O2, bf16* O, const float* lamp  , const float* gnorm  , float lam_init, int lane, int wave, int bx) {
    float pa = lamp[lane] * lamp[64 + lane], pb = lamp[128 + lane] * lamp[192 + lane];
    pa = wave_sum(pa, lane); pb = wave_sum(pb, lane);
    const float lam = __expf(pa) - __expf(pb) + lam_init, post = (1.0f - lam_init) * OSC;
    float g[16];
#pragma unroll
    for (int k = 0; k < 16; ++k) g[k] = gnorm[(lane & 7) * 16 + k] * post;
    const int rowb = bx * 128 + wave * 16;
    for (int i = 0; i < 16; ++i) {
        const size_t off = (size_t)(rowb + i) * DM + 16 * lane;
        const u32x4 a0 = *(const u32x4*)(O1 + off), a1 = *(const u32x4*)(O1 + off + 8), b0 = *(const u32x4*)(O2 + off), b1 = *(const u32x4*)(O2 + off + 8);
        float d[16];
        { const f32x4 x0 = unpack4((u32x2){a0.x, a0.y}), x1 = unpack4((u32x2){a0.z, a0.w}), x2 = unpack4((u32x2){a1.x, a1.y}), x3 = unpack4((u32x2){a1.z, a1.w});
          const f32x4 y0 = unpack4((u32x2){b0.x, b0.y}), y1 = unpack4((u32x2){b0.z, b0.w}), y2 = unpack4((u32x2){b1.x, b1.y}), y3 = unpack4((u32x2){b1.z, b1.w});
          const f32x4 r0 = x0 - y0 * lam, r1 = x1 - y1 * lam, r2 = x2 - y2 * lam, r3 = x3 - y3 * lam;
#pragma unroll
          for (int k = 0; k < 4; ++k) { d[k] = r0[k]; d[4 + k] = r1[k]; d[8 + k] = r2[k]; d[12 + k] = r3[k]; } }
        float ss = 0.f;
#pragma unroll
        for (int k = 0; k < 16; ++k) ss += d[k] * d[k];
        ss += xshfl(ss, 1, lane); ss += xshfl(ss, 2, lane); ss += xshfl(ss, 4, lane);
        const float r = 1.0f / sqrtf(ss * (1.0f / 128.0f) + LN_EPS);
        u32x4 w0;
        w0.x = pg8::pk4_fp8(d[0] * r * g[0], d[1] * r * g[1], d[2] * r * g[2], d[3] * r * g[3]); w0.y = pg8::pk4_fp8(d[4] * r * g[4], d[5] * r * g[5], d[6] * r * g[6], d[7] * r * g[7]);
        w0.z = pg8::pk4_fp8(d[8] * r * g[8], d[9] * r * g[9], d[10] * r * g[10], d[11] * r * g[11]); w0.w = pg8::pk4_fp8(d[12] * r * g[12], d[13] * r * g[13], d[14] * r * g[14], d[15] * r * g[15]);
        *(u32x4*)((unsigned char*)O + off) = w0;
    }
}

__device__ __forceinline__ void fill_bias(LAS unsigned char* L, bool fox, const float* lc, const float* bt, float slope, int nkeys, int tid, int lane, int kaoff) {
    LAS u32x4* bias = (LAS u32x4*)(L + kaoff);
    const int s = 8 * tid;
    float pre = 0.f;
    if (fox) { const int blk = tid >> 4; const int l5 = lane & 31; float inc = bt[l5];
        const float own = inc;
#pragma unroll
        for (int o = 1; o < 32; o <<= 1) { const float t = __uint_as_float((unsigned)__builtin_amdgcn_ds_bpermute((lane - o) << 2, (int)__float_as_uint(inc))); inc += (l5 >= o) ? t : 0.f; }
        pre = __uint_as_float((unsigned)__builtin_amdgcn_ds_bpermute(blk << 2, (int)__float_as_uint(inc - own))); }
    if (s < nkeys) {
        f32x4 o0, o1;
        if (fox) { const f32x4 a = *(const f32x4*)(lc + s), b = *(const f32x4*)(lc + s + 4);
            o0 = (a + pre) * (-LOG2E); o1 = (b + pre) * (-LOG2E); }
        else { const float k = slope * LOG2E;
            o0 = (f32x4){k * (float)s, k * (float)(s + 1), k * (float)(s + 2), k * (float)(s + 3)}; o1 = (f32x4){k * (float)(s + 4), k * (float)(s + 5), k * (float)(s + 6), k * (float)(s + 7)}; }
        const attn_body::u32x2v k0 = attn_body::ka_split(o0.x), k1 = attn_body::ka_split(o0.y), k2 = attn_body::ka_split(o0.z), k3 = attn_body::ka_split(o0.w);
        const attn_body::u32x2v k4 = attn_body::ka_split(o1.x), k5 = attn_body::ka_split(o1.y), k6 = attn_body::ka_split(o1.z), k7 = attn_body::ka_split(o1.w);
        bias[4 * tid] = (u32x4){k0[0], k0[1], k1[0], k1[1]}; bias[4 * tid + 1] = (u32x4){k2[0], k2[1], k3[0], k3[1]}; bias[4 * tid + 2] = (u32x4){k4[0], k4[1], k5[0], k5[1]}; bias[4 * tid + 3] = (u32x4){k6[0], k6[1], k7[0], k7[1]};
    }
}

struct Args { const float* in[23]; float* out; unsigned char* ws; int ph_lo, ph_hi, li, pad; };
__global__ void __launch_bounds__(NWAVES * 64, 2) mk_fwd(Args args) {
    extern __shared__ __attribute__((aligned(16))) unsigned char lds[];
    LAS unsigned char* L = (LAS unsigned char*)lds;
    const int tid0 = threadIdx.x; const int wave0 = __builtin_amdgcn_readfirstlane(tid0 >> 6);
    const int bx0 = blockIdx.x;
    for (int u = tid0; u < (LDS_BYTES - LDSCTL_OFF) / 4; u += NWAVES * 64) ((LAS unsigned*)(L + LDSCTL_OFF))[u] = 0u;
    __syncthreads();
    volatile LAS unsigned* MISC = (volatile LAS unsigned*)(L + MISC_OFF);
    XcdBarrier bar = xcd_barrier_post((unsigned*)(args.ws + WS_CTL) + CW_BAR + args.li * XCD_BAR_WORDS, MISC + 8);
    const int lo = args.ph_lo, hi = args.ph_hi;
    int ph = 0;
    constexpr size_t AE = ACT_BYTES / 2;
#define PH_ON (ph >= lo && ph < hi)
#define FRESH_TID() int lane; asm volatile("v_mbcnt_lo_u32_b32 %0, -1, 0\n\tv_mbcnt_hi_u32_b32 %0, -1, %0" : "=v"(lane)); const int wave = wave0; const int tid = wave * 64 + lane; (void)tid; \
    int bx = bx0; asm volatile("" : "+s"(bx)); const int G = 256; const int vcu = (bx % 8) * (G / 8) + bx / 8; (void)vcu; const int bb = bx >> 5; (void)bb; \
    kaptr ka = (kaptr)__builtin_amdgcn_kernarg_segment_ptr(); asm volatile("" : "+s"(ka)); \
    unsigned char* ws = *(unsigned char* const __attribute__((address_space(4)))*)(ka + 8 * 24); float* out = *(float* const __attribute__((address_space(4)))*)(ka + 8 * 23); (void)out; \
    unsigned* ctl = (unsigned*)(ws + WS_CTL); (void)ctl; bf16* ACT = (bf16*)(ws + WS_ACT); \
    bf16 *B0 = ACT, *B1 = ACT + AE, *B2 = ACT + 2 * AE, *B3 = ACT + 3 * AE, *B4 = ACT + 4 * AE, *B5 = ACT + 5 * AE; (void)B0; (void)B1; (void)B2; (void)B3; (void)B4; (void)B5; \
    float* MOD = (float*)(ws + WS_MOD); float* KVMOD = (float*)(ws + WS_KVMOD); float* BT = (float*)(ws + WS_BT); float* LC = (float*)(ws + WS_LC); (void)MOD; (void)KVMOD; (void)BT; (void)LC; \
    unsigned* TOK = (unsigned*)(ws + WS_TOK); int* PERM = (int*)(ws + WS_PERM); float* GWT = (float*)(ws + WS_GWT); (void)TOK; (void)PERM; (void)GWT
#define PH_END do { if (PH_ON && ph + 1 < hi) { XcdBarrier b_ = bar; asm volatile("" : "+s"(b_.bar), "+s"(b_.x)); for (int rb_ = 0; rb_ < REP_BAR; ++rb_) xcd_barrier(b_); } ++ph; } while (0)


    if (PH_ON) { FRESH_TID(); for (int rep_ = 0; rep_ < REP_P0; ++rep_) p0_prologue(L, ka, ws, tid, lane, wave, bx, G, vcu); }
    PH_END;
    if (PH_ON) { FRESH_TID();
        RowsCfg c{}; c.xin_f32 = INP(0); c.sh = MOD + (size_t)bb * 6144; c.sc = MOD + (size_t)bb * 6144 + DM; c.hout = B5; c.hout_fp8 = 1;
        c.w16 = INP(8) + 3072; c.w16_ld = 3088; c.dotmode = 2; c.rb = INP(9); c.lc = LC; c.bt = BT;
        for (int rep_ = 0; rep_ < REP_P0B; ++rep_) rows_phase<0, true>(L, c, tid, lane, wave, bx);
    }
    PH_END;

    for (int l = 0; l < 4; ++l) {
        const bool fox = l < 2;
        if (PH_ON) { FRESH_TID();
            for (int rep_ = 0; rep_ < REP_P1; ++rep_)
            for (int pass = (l == 2 ? 0 : 1); pass < 2; ++pass) {
                pg8::Gemm g; pg8::EpiBf16 E; int N;
                if (fox) { g = pg8::Gemm{B5, (const bf16*)((const unsigned char*)(ws + WS_FOXIN) + (size_t)l * 3072 * DM), DM / 2}; N = 3072; E = pg8::EpiBf16{B2, DM, DM, AE, {QSCALE / WQK, 1.0f / WQK, 1.0f / WV}, ctl + CW_NORM + 1024 * l, 32, DRY_REP && rep_ > 0}; }
                else if (pass == 0) { g = pg8::Gemm{B2, (const bf16*)(ws + WS_KVW), DM / 2}; N = 2048; E = pg8::EpiBf16{B3, DM, DM, AE, {1.0f / WQK, 1.0f / WV, 0.f}, ctl + CW_KVN, 16, DRY_REP && rep_ > 0}; }
                else { g = pg8::Gemm{B5, (const bf16*)((const unsigned char*)(ws + WS_DQ) + (size_t)(l - 2) * DM * DM), DM / 2}; N = 1024; E = pg8::EpiBf16{B0, DM, DM, AE, {QSCALE / WQK, 0.f, 0.f}, ctl + CW_NORM + 1024 * l, 16, DRY_REP && rep_ > 0}; }
                pg8::DenseSched S; S.init(NT, N, DM / 2, G, bx);
                pg8::gemm_phase<pg8::EpiBf16, pg8::DenseSched, true, true>(L, g, S, E, tid, L + PARK_OFF);
            }
        }
        PH_END;
        if (PH_ON) { FRESH_TID();
            LAS int* QW = (LAS int*)(L + QW_OFF);
            unsigned* qctr = ctl + CW_QUEUE + 64 * l;
            const int total = fox ? 2048 : 1024;
            if (!fox && tid < 64) { const float* lamp = INP(15) + (size_t)(l - 2) * 256; const float lam_init = (l == 2) ? 0.47071302f : 0.55605820f;
                float pa = lamp[tid] * lamp[64 + tid], pb = lamp[128 + tid] * lamp[192 + tid];
                pa = wave_sum(pa, tid); pb = wave_sum(pb, tid);
                if (tid == 0) ((LAS float*)QW)[16] = __expf(pa) - __expf(pb) + lam_init; }
            int jph = 0;
            if (!fox && tid < 128) { const int hh = tid >> 4, qq = tid & 15;
                auto est = [](int h_, int q_) { const int w = 5 + (int)(0.823f * (float)(2 << h_)); const int c = 4 * q_ + 4; return c < w ? c : w; };
                const int e = est(hh, qq); int rank = 0;
                for (int c2 = 0; c2 < 128; ++c2) { const int e2 = est(c2 >> 4, c2 & 15); rank += (e2 > e || (e2 == e && c2 < tid)) ? 1 : 0; }
                ((LAS unsigned char*)QW)[128 + rank] = (unsigned char)tid; }
            const int kaoff = fox ? attn_body::LDS_BIAS : attn_body::LDS128_BIAS;
            { LAS float* NL = (LAS float*)(L + NORML_OFF);
              for (int i = tid; i < 512; i += NWAVES * 64) { const int b = i >> 6, s = i & 63; unsigned v = 0u;
                  if (fox) { if ((s & 31) < 16) v = __hip_atomic_load(ctl + CW_NORM + 1024 * l + b * 32 + (s < 32 ? s : 16 + (s - 32)), RLX_AGENT); }
                  else { if (s < 16) v = __hip_atomic_load(ctl + CW_NORM + 1024 * l + b * 16 + s, RLX_AGENT); else if (s >= 32 && s < 48) v = __hip_atomic_load(ctl + CW_KVN + b * 16 + (s - 32), RLX_AGENT); }
                  NL[i] = __uint_as_float(v); } }
            for (int rep_ = 0; rep_ < (fox ? REP_ATTN_FOX : REP_ATTN); ++rep_) {
            unsigned* qc = qctr + 16 * rep_;
            int pvh = -1, pnk = 0;
            if (tid == 0) QW[0] = (int)__hip_atomic_fetch_add(qc, 1u, RLX_AGENT);
            __syncthreads();
            for (;;) {
                const int u = __builtin_amdgcn_readfirstlane(QW[0]);
                __syncthreads();
                if (u >= total) break;
                const bool grab = fox || jph == 1;
                int nxt = 0; if (grab && tid == 0) nxt = (int)__hip_atomic_fetch_add(qc, 1u, RLX_AGENT);
                int vh, qb;
                if (fox) { vh = u & 127; qb = 15 - (u >> 7); }
                else { const int cls = ((const LAS unsigned char*)QW)[128 + (u >> 3)]; vh = (u & 7) * 8 + (cls >> 4); qb = cls & 15; }
                const bf16 *Qb, *Kb, *Vb; bf16* Ob; const float *lc = nullptr, *bt = nullptr; float slope = 0.f; int nqi;
                if (fox) { const int b = vh >> 4, h = vh & 15; const size_t o = (size_t)b * SEQ * DM + h * 64;
                    Qb = B2 + o; Kb = B3 + o; Vb = B4 + o; Ob = (bf16*)((unsigned char*)B0 + o);   lc = LC + (size_t)vh * SEQ; bt = BT + vh * 32;
                    nqi = b * 64 + h; }
                else { const int b = vh >> 3, h = vh & 7, j = jph; const size_t o = (size_t)b * SEQ * DM + h * 128;
                    Qb = B0 + o + j * 64; Kb = B3 + o + j * 64; Vb = B4 + o; Ob = B1 + o; slope = exp2f(-(float)(h + 1));
                    nqi = b * 64 + 2 * h + j; }
                const LAS float* NL = (const LAS float*)(L + NORML_OFF);
                const float q2 = NL[nqi], k2 = NL[nqi + 32];
                const float bh = 1.01f * sqrtf(q2 * k2), bound = 2.0f * bh + 32.0f;
                int tu = tid; int t0;
                asm volatile("" : "+v"(tu));
                if (!(vh == pvh && (qb + 1) * 256 <= pnk)) {
                    fill_bias(L, fox, lc, bt, slope, (qb + 1) * 256, tu, tu & 63, kaoff);
                    asm volatile("s_waitcnt lgkmcnt(0)\n\ts_barrier" ::: "memory");
                    pvh = vh; pnk = (qb + 1) * 256; }
                { const LAS attn_body::u32x2v* bias = (const LAS attn_body::u32x2v*)(L + kaoff); const int jl = tu & 63;
                  const bool c = (jl < 4 * qb) && (attn_body::ka_value(bias[64 * jl + 63]) - attn_body::ka_value(bias[256 * qb]) + bound < 0.0f);
                  t0 = (int)__builtin_popcountll(__ballot(c)) & ~1; }
                if (fox) attn_body::attn_unit<8>(qb, t0, (const attn_body::bf16*)Qb, (const attn_body::bf16*)Kb, (const attn_body::bf16*)Vb, (attn_body::bf16*)Ob, (char*)lds, tu, bh, OSC);
                else attn_body::attn_unit128(qb, t0, (const attn_body::bf16*)Qb, (const attn_body::bf16*)Kb, (const attn_body::bf16*)Vb, (attn_body::bf16*)Ob, (char*)lds, tu, bh, jph, (unsigned char*)B2 + (Ob - B1), (const float*)((char*)lds + QW_OFF + 64), INP(16) + (size_t)(l - 2) * 128, (1.0f - ((l == 2) ? 0.47071302f : 0.55605820f)) * OSC, LN_EPS);
                if (grab && tid == 0) QW[0] = nxt;
                if (!fox) jph ^= 1;
                __syncthreads();
            }
            }
        }
        PH_END;
        ++ph;
        if (PH_ON) { FRESH_TID();
            pg8::Gemm g{fox ? B0 : B2, (const bf16*)((const unsigned char*)(ws + (fox ? WS_FOXO : WS_DO)) + (size_t)(fox ? l : l - 2) * DM * DM), DM / 2};
            pg8::DenseSched S; S.init(NT, DM, DM / 2, G, bx);
            for (int rep_ = 0; rep_ < REP_P3; ++rep_) { pg8::EpiFp8 E{(unsigned char*)B1, DM, YSC / (WV * OSC), DRY_REP && rep_ > 0};
            if (rep_ == 0) pg8::gemm_phase<pg8::EpiFp8, pg8::DenseSched, true, true>(L, g, S, E, tid, L + PARK_OFF); else pg8::gemm_phase<pg8::EpiFp8, pg8::DenseSched, true, true, ABLP>(L, g, S, E, tid, L + PARK_OFF); }
        }
        PH_END;
        if (PH_ON) { FRESH_TID();
            const float* modl = MOD + ((size_t)l * NB + bb) * 6144; bf16* XB = (bf16*)out + (size_t)NT * DM;     RowsCfg c{}; c.xin_f32 = INP(0); c.xin_bf = XB; c.xout_bf = (l == 3) ? B5 : XB; c.src = (const unsigned char*)B1; c.src_inv = 1.0f / YSC; c.gate = modl + 2 * DM; c.gamma = INP(4) + l * DM; c.beta = INP(5) + l * DM;
            c.sh = modl + 3 * DM; c.sc = modl + 4 * DM; c.hout = B0; c.hout_fp8 = 1; c.w16 = INP(18); c.w16_ld = 16; c.dotmode = 1; c.rb = INP(19);
            c.cnt = ctl + CW_CNT + 64 * l; c.perm = PERM; c.gwt = GWT; c.tokslot = TOK;
            for (int rep_ = 0; rep_ < REP_LN1; ++rep_) { RowsCfg c2 = c; if (rep_ + 1 < REP_LN1) { c2.xout_bf = (l == 3) ? B5 : B5; c2.cnt = nullptr; if (PROBE_NODOT) c2.dotmode = 0; }
            if (l == 0) rows_phase<1, true>(L, c2, tid, lane, wave, bx); else rows_phase<1, false>(L, c2, tid, lane, wave, bx); }
            for (int rep_ = 0; rep_ < REP_CONV; ++rep_) moe_weight_copies(L, ka, ws, l, lane, wave, G, vcu);
        }
        PH_END;
        if (PH_ON) { FRESH_TID();
            LAS int* TAB = (LAS int*)(L + MOETAB_OFF);
            if (tid < 16) TAB[32 + tid] = (int)__hip_atomic_load(ctl + CW_CNT + 64 * l + tid, RLX_AGENT);
            __syncthreads();
            if (tid == 0) { int tp = 0, so = 0;
#pragma unroll
                for (int e = 0; e < 16; ++e) { const int cn = TAB[32 + e]; TAB[e] = tp; TAB[64 + e] = so; tp += (cn + 255) >> 8; so += cn; } TAB[16] = tp; }
            __syncthreads();
            pg8::Gemm g{B0, (const bf16*)(ws + WS_MOE1), DM / 2};
            pg8::MoeSched<true> S{TAB, G, vcu, DM / 2, PERM, (unsigned)(DM * DM), (const LAS int*)(L + PARK_OFF)};
            S.fill_tokens((LAS int*)(L + PARK_OFF), tid); __syncthreads();
            pg8::EpiMoe1 E{(unsigned char*)B2, 1.0f / W1SCALE, ASCALE};
            for (int rep_ = 0; rep_ < REP_P5; ++rep_)
            pg8::gemm_phase<pg8::EpiMoe1, pg8::MoeSched<true>, true, true>(L, g, S, E, tid, L + PARK_OFF);
        }
        PH_END;
        if (PH_ON) { FRESH_TID();
            LAS int* TAB = (LAS int*)(L + MOETAB_OFF);
            if (tid < 16) TAB[32 + tid] = (int)__hip_atomic_load(ctl + CW_CNT + 64 * l + tid, RLX_AGENT);
            __syncthreads();
            if (tid == 0) { int tp = 0, so = 0;
#pragma unroll
                for (int e = 0; e < 16; ++e) { const int cn = TAB[32 + e]; TAB[e] = tp; TAB[64 + e] = so; tp += (cn + 255) >> 8; so += cn; } TAB[16] = tp; }
            __syncthreads();
            pg8::Gemm g{B2, (const bf16*)(ws + WS_MOE2), 256};
            pg8::MoeSched<false> S{TAB, G, vcu, 256, PERM, (unsigned)(DM * 512), nullptr};
            pg8::EpiMoe2 E{(unsigned char*)B0, DNSC / (W2SCALE * ASCALE)};
            for (int rep_ = 0; rep_ < REP_P6; ++rep_)
            pg8::gemm_phase<pg8::EpiMoe2, pg8::MoeSched<false>, true, true>(L, g, S, E, tid, L + PARK_OFF);
        }
        PH_END;
        if (PH_ON) { FRESH_TID();
            const float* modl = MOD + ((size_t)l * NB + bb) * 6144; bf16* XB = (bf16*)out + (size_t)NT * DM; RowsCfg c{}; c.xin_bf = (l == 3) ? B5 : XB; if (l == 3) c.xout_f32 = out; else c.xout_bf = XB; c.src = (const unsigned char*)B0; c.src_inv = 1.0f / DNSC; c.gate = modl + 5 * DM; c.gamma = INP(6) + l * DM; c.beta = INP(7) + l * DM;
            c.cnt = ctl + CW_CNT + 64 * l; c.tokslot = TOK; c.gwt = GWT;
            if (l < 3) { const float* modn = MOD + ((size_t)(l + 1) * NB + bb) * 6144; c.sh = modn; c.sc = modn + DM; c.hout = B5; c.hout_fp8 = 1; }
            if (l == 0) { c.w16 = INP(8) + (size_t)DM * 3088 + 3072; c.w16_ld = 3088; c.dotmode = 2; c.rb = INP(9) + 16; c.lc = LC; c.bt = BT; }
            if (l == 1) { c.sh2 = KVMOD + (size_t)bb * 2048; c.sc2 = KVMOD + (size_t)bb * 2048 + DM; c.hout2 = B2; }
            for (int rep_ = 0; rep_ < REP_LN2; ++rep_) { RowsCfg c2 = c; if (rep_ + 1 < REP_LN2) { c2.xout_f32 = nullptr; c2.xout_bf = (l == 1) ? B3 : B2; }
            rows_phase<2, false>(L, c2, tid, lane, wave, bx); }
        }
        PH_END;
    }
#undef PH_ON
#undef PH_END
}

extern "C" void kernel_launch(void* const* d_in, const int* in_sizes, int n_in, void* d_out, int out_size, void* d_ws, size_t ws_size, hipStream_t stream) {
    static int grid = 0;
    if (grid == 0) {
        if (n_in != 23 || in_sizes[0] != NT * DM || out_size != NT * DM || ws_size < WS_END) { fprintf(stderr, "kernel_launch: unexpected problem (n_in %d, in0 %d, out %d, ws %zu < %zu)\n", n_in, n_in > 0 ? in_sizes[0] : -1, out_size, ws_size, (size_t)WS_END); grid = -1; return; }
        if (hipFuncSetAttribute((const void*)mk_fwd, hipFuncAttributeMaxDynamicSharedMemorySize, LDS_BYTES) != hipSuccess) { fprintf(stderr, "kernel_launch: hipFuncSetAttribute failed\n"); grid = -1; return; }
        int per_cu = 0;
        if (hipOccupancyMaxActiveBlocksPerMultiprocessor(&per_cu, (const void*)mk_fwd, NWAVES * 64, LDS_BYTES) != hipSuccess || per_cu < 1) fprintf(stderr, "kernel_launch: occupancy query reports %d\n", per_cu);
        (void)hipGetLastError();
        grid = 256;
    }
    if (grid < 0) return;
    if (hipMemsetAsync((char*)d_ws + WS_CTL, 0, CTL_ZERO_BYTES, stream) != hipSuccess) { fprintf(stderr, "kernel_launch: memset failed\n"); return; }
    Args a{};
    for (int i = 0; i < 23; ++i) a.in[i] = (const float*)d_in[i];
    a.out = (float*)d_out; a.ws = (unsigned char*)d_ws;
#if MK_PER_PHASE
    for (int p = 0; p < NPH; ++p) { a.ph_lo = p; a.ph_hi = p + 1; a.li = p; hipLaunchKernelGGL(mk_fwd, dim3(grid), dim3(NWAVES * 64), LDS_BYTES, stream, a); }
#else
    a.ph_lo = 0; a.ph_hi = NPH; a.li = 0;
    hipLaunchKernelGGL(mk_fwd, dim3(grid), dim3(NWAVES * 64), LDS_BYTES, stream, a);
#endif
    const hipError_t le = hipPeekAtLastError();
    if (le != hipSuccess) fprintf(stderr, "kernel_launch: launch failed: %s\n", hipGetErrorName(le));
}
```

```cpp
#include <hip/hip_runtime.h>
#include <hip/hip_bf16.h>
#include <cstdio>
#include <cstdint>
#include <cmath>
#define LAS __attribute__((address_space(3)))
namespace pg8 {
#define PG8_LAS __attribute__((address_space(3)))
typedef unsigned short bf16_t;
typedef short bf16x8 __attribute__((ext_vector_type(8)));
typedef float f32x4 __attribute__((ext_vector_type(4)));
typedef unsigned u32x4 __attribute__((ext_vector_type(4)));
constexpr int BM = 256, BK = 64, HALF = 128, HTB = HALF * BK * 2  , STAGE_BYTES = 8 * HTB, NXCD = 8, WGM = 8;

__host__ __device__ __forceinline__ int lds_byte(int r, int c) { const int st = (r >> 4) * 2 + (c >> 5), rr = r & 15, cc = c & 31, ob = rr * 64 + cc * 2; return st * 1024 + (ob ^ (((ob >> 9) & 1) << 5)); }
__host__ __device__ __forceinline__ void stage_rc(int b, int& R, int& C) { const int st = b / 1024, sb = b % 1024, swz = sb ^ (((sb >> 9) & 1) << 5); R = (st >> 1) * 16 + swz / 64; C = (st & 1) * 32 + (swz % 64) / 2; }
__host__ __device__ __forceinline__ int perm32(int rho) { const int n = rho >> 4, i = rho & 15; return 8 * (i >> 2) + 4 * n + (i & 3); }
struct Unit0 { int pm, pn; };
struct StaticOrder {
    int nM, nN, nwg, G, c;
    __host__ __device__ void init(int M, int N, int G_, int c_) { nM = M / BM; nN = N / BM; nwg = nM * nN; G = G_; c = c_; }
    __host__ __device__ bool next(int i, Unit0& u) const {
        const long L = (long)i * G + c; if (L >= nwg) return false;
        int wgid = (int)L; { const int q = nwg / NXCD, r = nwg % NXCD, xcd = wgid % NXCD, off = wgid / NXCD; wgid = (xcd < r ? xcd * (q + 1) : r * (q + 1) + (xcd - r) * q) + off; }
        const int nig = WGM * nN, gid = wgid / nig, fm = gid * WGM, gsz = (nM - fm) < WGM ? (nM - fm) : WGM;
        u.pm = fm + ((wgid % nig) % gsz); u.pn = (wgid % nig) / gsz; return true;
    }
    __device__ __forceinline__ void a_ready(const Unit0&) const {}
    __device__ __forceinline__ void done(const Unit0&) const {}
};

struct Unit { int pm, pn, e, nrows, row0, ord; unsigned boff; };
struct Gemm { const bf16_t* A; const bf16_t* Bt; int K; };

struct DenseSched {
    StaticOrder so; int K;
    __device__ __forceinline__ void init(int M, int N, int K_, int G, int c) { so.init(M, N, G, c); K = K_; }
    __device__ __forceinline__ bool next(int i, Unit& u) const { Unit0 t; if (!so.next(i, t)) return false; u.pm = t.pm; u.pn = t.pn; u.e = 0; u.ord = i; u.nrows = BM; u.row0 = t.pm * BM; u.boff = (unsigned)t.pn * (unsigned)(BM * 2) * (unsigned)K; return true; }
    static constexpr bool GATHER = false;
    __device__ __forceinline__ void aoff(const Unit& u, int tid, unsigned (&off)[2][2]) const {
#pragma unroll
        for (int i = 0; i < 2; ++i) { int R, C; stage_rc(tid * 16 + i * 8192, R, C);
#pragma unroll
            for (int h = 0; h < 2; ++h) off[h][i] = (unsigned)((u.row0 + h * HALF + R) * K + C) * 2u; } }
};
template <bool GATHER_> struct MoeSched {
    static constexpr bool GATHER = GATHER_;
    const PG8_LAS int* tab; int G, c, K; const int* perm; unsigned wstride; const PG8_LAS int* toks;
    __device__ __forceinline__ bool next(int i, Unit& u) const {
        const int L = i * G + c; const int tot = tab[16] * 4; if (L >= tot) return false;
        const int g = L >> 2; int e = 0;
#pragma unroll
        for (int k = 1; k < 16; ++k) e += (tab[k] <= g) ? 1 : 0;
        const int mt = g - tab[e], cnt = tab[32 + e];
        u.pm = mt; u.pn = L & 3; u.e = e; u.ord = i; u.nrows = (cnt - BM * mt) < BM ? (cnt - BM * mt) : BM; u.row0 = tab[64 + e] + BM * mt;
        u.boff = (unsigned)e * wstride + (unsigned)(L & 3) * (unsigned)(BM * 2) * (unsigned)K; return true; }
    __device__ __forceinline__ void fill_tokens(PG8_LAS int* dst, int tid) const {
        Unit u;
        for (int i = 0; i < 8 && next(i, u); ++i) for (int r = tid; r < BM; r += 512) dst[i * BM + r] = r < u.nrows ? perm[u.e * 32768 + u.pm * BM + r] : 0; }
    __device__ __forceinline__ void aoff(const Unit& u, int tid, unsigned (&off)[2][2]) const {
#pragma unroll
        for (int i = 0; i < 2; ++i) { int R, C; stage_rc(tid * 16 + i * 8192, R, C);
#pragma unroll
            for (int h = 0; h < 2; ++h) {
                int row;
                if (GATHER) row = toks[u.ord * BM + h * HALF + R];
                else row = u.row0 + h * HALF + R;
                off[h][i] = (unsigned)(row * K + C) * 2u; } } }
};

typedef float f32x2 __attribute__((ext_vector_type(2))); typedef __bf16 bf16x2_t __attribute__((ext_vector_type(2)));
__device__ __forceinline__ unsigned cvt_pk_bf16(float lo, float hi) { f32x2 v = {lo, hi}; bf16x2_t b = __builtin_convertvector(v, bf16x2_t); return __builtin_bit_cast(unsigned, b); }

struct EpiBf16 {
    static constexpr bool PERM = true, AFTER_DRAIN = false;
    bf16_t* O; int ldc; int split_cols; size_t split_stride; float scv[3]; unsigned* norm; int nslots; int dry;
    __device__ __forceinline__ void operator()(const f32x4 (&acc)[2][2][4][2], const Unit& u, int wr, int wc, int fr, int fq) const {
        const int row0 = u.row0 + wr * 64 + fr; int colt = u.pn * BM; bf16_t* base = O;
        float sc = scv[0]; int tt = 0; if (split_cols) { const int t = colt / split_cols; tt = t; base += (size_t)t * split_stride; colt -= t * split_cols; sc = t == 0 ? scv[0] : (t == 1 ? scv[1] : scv[2]); }
        const int col0 = colt + wc * 64 + 8 * fq;
#pragma unroll
        for (int ai = 0; ai < 2; ++ai)
#pragma unroll
            for (int m = 0; m < 4; ++m) { bf16_t* rowp = base + (size_t)(row0 + ai * HALF + m * 16) * ldc + col0;
#pragma unroll
                for (int bj = 0; bj < 2; ++bj) { const f32x4 v0 = acc[ai][bj][m][0] * sc, v1 = acc[ai][bj][m][1] * sc;
                    u32x4 w; w.x = cvt_pk_bf16(v0[0], v0[1]); w.y = cvt_pk_bf16(v0[2], v0[3]); w.z = cvt_pk_bf16(v1[0], v1[1]); w.w = cvt_pk_bf16(v1[2], v1[3]);
                    if (!dry) *(u32x4*)(rowp + bj * 32) = w; else asm volatile("" :: "v"(w)); } }
        if (norm && !dry && tt < nslots / 16) { const int lane = fq * 16 + fr; float mx = 0.f;
#pragma unroll
            for (int ai = 0; ai < 2; ++ai)
#pragma unroll
                for (int m = 0; m < 4; ++m) { float ss = 0.f;
#pragma unroll
                    for (int bj = 0; bj < 2; ++bj) { const f32x4 v0 = acc[ai][bj][m][0] * sc, v1 = acc[ai][bj][m][1] * sc;
                        ss += (v0[0] * v0[0] + v0[1] * v0[1]) + (v0[2] * v0[2] + v0[3] * v0[3]) + (v1[0] * v1[0] + v1[1] * v1[1]) + (v1[2] * v1[2] + v1[3] * v1[3]); }
                    ss += __uint_as_float((unsigned)__builtin_amdgcn_ds_bpermute((lane ^ 16) << 2, (int)__float_as_uint(ss)));
                    ss += __uint_as_float((unsigned)__builtin_amdgcn_ds_bpermute((lane ^ 32) << 2, (int)__float_as_uint(ss)));
                    mx = fmaxf(mx, ss); }
#pragma unroll
            for (int o = 1; o < 16; o <<= 1) mx = fmaxf(mx, __uint_as_float((unsigned)__builtin_amdgcn_ds_bpermute((lane ^ o) << 2, (int)__float_as_uint(mx))));
            if (lane == 0) __hip_atomic_fetch_max(norm + (u.row0 >> 12) * nslots + u.pn * 4 + wc, __float_as_uint(mx), __ATOMIC_RELAXED, __HIP_MEMORY_SCOPE_AGENT);
        }
    }
};
__device__ __forceinline__ unsigned pk4_fp8(float a, float b, float c, float d) { unsigned w = __builtin_amdgcn_cvt_pk_fp8_f32(a, b, 0u, false); return __builtin_amdgcn_cvt_pk_fp8_f32(c, d, w, true); }
typedef unsigned u32x2e_t __attribute__((ext_vector_type(2)));
__device__ __forceinline__ u32x4 widen16(u32x2e_t w0, u32x2e_t w1) {
    const auto a = __builtin_amdgcn_permlane16_swap(w0[0], w1[0], false, false), b = __builtin_amdgcn_permlane16_swap(w0[1], w1[1], false, false);
    return (u32x4){a[0], b[0], a[1], b[1]}; }
struct EpiFp8 {
    static constexpr bool PERM = true, AFTER_DRAIN = false;
    unsigned char* O; int ldc; float sc; int dry;
    __device__ __forceinline__ void operator()(const f32x4 (&acc)[2][2][4][2], const Unit& u, int wr, int wc, int fr, int fq) const {
        const int row0 = u.row0 + wr * 64 + fr + 16 * (fq & 1), col0 = u.pn * BM + wc * 32 + 8 * (fq & ~1);
#pragma unroll
        for (int ai = 0; ai < 2; ++ai)
#pragma unroll
            for (int mp = 0; mp < 4; mp += 2) { unsigned char* rowp = O + (size_t)(row0 + ai * HALF + mp * 16) * ldc + col0;
#pragma unroll
                for (int bj = 0; bj < 2; ++bj) { const f32x4 a0 = acc[ai][bj][mp][0] * sc, a1 = acc[ai][bj][mp][1] * sc, b0 = acc[ai][bj][mp + 1][0] * sc, b1 = acc[ai][bj][mp + 1][1] * sc;
                    const u32x4 w = widen16((u32x2e_t){pk4_fp8(a0[0], a0[1], a0[2], a0[3]), pk4_fp8(a1[0], a1[1], a1[2], a1[3])}, (u32x2e_t){pk4_fp8(b0[0], b0[1], b0[2], b0[3]), pk4_fp8(b1[0], b1[1], b1[2], b1[3])});
                    if (!dry) *(u32x4*)(rowp + bj * HALF) = w; else asm volatile("" :: "v"(w)); } }
    }
};
__device__ __forceinline__ float silu_mul(float g, float u) { return g * u * __builtin_amdgcn_rcpf(1.0f + __builtin_amdgcn_exp2f(-1.4426950408889634f * g)); }
struct EpiMoe1 {
    static constexpr bool PERM = true, AFTER_DRAIN = false;
    unsigned char* O; float inv_wscale, ascale;
    __device__ __forceinline__ void operator()(const f32x4 (&acc)[2][2][4][2], const Unit& u, int wr, int wc, int fr, int fq) const {
        const int col0 = u.pn * 128 + wc * 32 + 8 * (fq & ~1); const float us = inv_wscale * ascale;
#pragma unroll
        for (int ai = 0; ai < 2; ++ai)
#pragma unroll
            for (int mp = 0; mp < 4; mp += 2) { const int r = ai * HALF + wr * 64 + (mp + (fq & 1)) * 16 + fr; u32x2e_t wv[2];
#pragma unroll
                for (int k = 0; k < 2; ++k) { const f32x4 g0 = acc[ai][0][mp + k][0] * inv_wscale, g1 = acc[ai][0][mp + k][1] * inv_wscale, u0 = acc[ai][1][mp + k][0] * us, u1 = acc[ai][1][mp + k][1] * us;
                    wv[k] = (u32x2e_t){pk4_fp8(silu_mul(g0[0], u0[0]), silu_mul(g0[1], u0[1]), silu_mul(g0[2], u0[2]), silu_mul(g0[3], u0[3])), pk4_fp8(silu_mul(g1[0], u1[0]), silu_mul(g1[1], u1[1]), silu_mul(g1[2], u1[2]), silu_mul(g1[3], u1[3]))}; }
                const u32x4 w = widen16(wv[0], wv[1]);
                if (r < u.nrows) *(u32x4*)(O + (size_t)(u.row0 + r) * 512 + col0) = w; }
    }
};
struct EpiMoe2 {
    static constexpr bool PERM = true, AFTER_DRAIN = false;
    unsigned char* O; float oscale;
    __device__ __forceinline__ void operator()(const f32x4 (&acc)[2][2][4][2], const Unit& u, int wr, int wc, int fr, int fq) const {
        const int col0 = u.pn * BM + wc * 32 + 8 * (fq & ~1); const float s = oscale;
#pragma unroll
        for (int ai = 0; ai < 2; ++ai)
#pragma unroll
            for (int mp = 0; mp < 4; mp += 2) { const int r = ai * HALF + wr * 64 + (mp + (fq & 1)) * 16 + fr; unsigned char* rowp = O + (size_t)(u.row0 + r) * 1024 + col0;
#pragma unroll
                for (int bj = 0; bj < 2; ++bj) { const f32x4 a0 = acc[ai][bj][mp][0] * s, a1 = acc[ai][bj][mp][1] * s, b0 = acc[ai][bj][mp + 1][0] * s, b1 = acc[ai][bj][mp + 1][1] * s;
                    const u32x4 w = widen16((u32x2e_t){pk4_fp8(a0[0], a0[1], a0[2], a0[3]), pk4_fp8(a1[0], a1[1], a1[2], a1[3])}, (u32x2e_t){pk4_fp8(b0[0], b0[1], b0[2], b0[3]), pk4_fp8(b1[0], b1[1], b1[2], b1[3])});
                    if (r < u.nrows) *(u32x4*)(rowp + bj * HALF) = w; } }
    }
};

typedef int v8i32 __attribute__((ext_vector_type(8))); typedef int v4i32 __attribute__((ext_vector_type(4)));
__device__ __forceinline__ v8i32 cat8(bf16x8 a, bf16x8 b) { const v4i32 x = __builtin_bit_cast(v4i32, a), y = __builtin_bit_cast(v4i32, b); return (v8i32){x[0], x[1], x[2], x[3], y[0], y[1], y[2], y[3]}; }
__device__ __forceinline__ void glds_s(const void* sbase, unsigned voff, unsigned lds_dst) { unsigned keep;
    asm volatile("s_mov_b32 %0, m0\n\ts_mov_b32 m0, %3\n\ts_nop 2\n\tglobal_load_lds_dwordx4 %1, %2\n\ts_mov_b32 m0, %0" : "=&s"(keep) : "v"(voff), "s"(sbase), "s"(lds_dst) : "memory"); }
__device__ __forceinline__ const char* uni_ptr(const char* p) { const unsigned long long v = (unsigned long long)p; const unsigned lo = __builtin_amdgcn_readfirstlane((unsigned)v), hi = __builtin_amdgcn_readfirstlane((unsigned)(v >> 32)); return (const char*)(((unsigned long long)hi << 32) | lo); }
template <class Epi, class Sched, bool ALIGN_EPI, bool FP8 = false, int ABL = 0>
__device__ __forceinline__ void gemm_phase(PG8_LAS unsigned char* lds, const Gemm g, const Sched& S, const Epi& E, const int tid, PG8_LAS unsigned char* park) {
    const int wid = __builtin_amdgcn_readfirstlane(tid >> 6), lane = tid & 63, wr = wid >> 2, wc = wid & 3, fr = lane & 15, fq = lane >> 4;
    const int K = g.K, nt = K / BK;
    unsigned voffB[2];
#pragma unroll
    for (int i = 0; i < 2; ++i) { int R, C; stage_rc(tid * 16 + i * 8192, R, C); const int Rb = Epi::PERM ? ((R & ~31) + perm32(R & 31)) : R; voffB[i] = (unsigned)(Rb * K + C) * 2u; }
    const unsigned kstep = (unsigned)(BK * 2);
    const unsigned hstep = (unsigned)HALF * (unsigned)K * 2u;
    const unsigned ldsw = (unsigned)wid * 1024u;
    const int aoff = lds_byte(wr * 64 + fr, fq * 8), boff = lds_byte(wc * 32 + fr, fq * 8);
    const char* gA = (const char*)g.A;
    const unsigned ldsbase = (unsigned)(size_t)lds;
#define PG8_SA(b, h) (((b) * 2 + (h)) * HTB)
#define PG8_SB(b, h) ((4 + (b) * 2 + (h)) * HTB)
#define PG8_STAGE(bufoff, gbase, voff) do { if constexpr (!(((ABL & 4) && (bufoff) < 4 * HTB) || ((ABL & 8) && (bufoff) >= 4 * HTB))) _Pragma("unroll") for (int _i = 0; _i < 2; ++_i) \
        glds_s(uni_ptr(gbase), (voff)[_i], (unsigned)__builtin_amdgcn_readfirstlane((int)(ldsbase + (unsigned)(bufoff) + ldsw + (unsigned)(_i * 8192)))); } while (0)
#define PG8_LDA(dst, b, h) do { if constexpr (!(ABL & 16)) _Pragma("unroll") for (int m = 0; m < 4; ++m) _Pragma("unroll") for (int k = 0; k < 2; ++k) dst[m][k] = *(const PG8_LAS bf16x8*)(lds + PG8_SA(b, h) + aoff + m * 2048 + k * 1024); } while (0)
#define PG8_LDB(dst, b, h) do { if constexpr (!(ABL & 16)) _Pragma("unroll") for (int n = 0; n < 2; ++n) _Pragma("unroll") for (int k = 0; k < 2; ++k) dst[n][k] = *(const PG8_LAS bf16x8*)(lds + PG8_SB(b, h) + boff + n * 2048 + k * 1024); } while (0)
#define PG8_MMA(ai, bj, At, Bt) do { __builtin_amdgcn_s_setprio(1); if constexpr (!(ABL & 1)) _Pragma("unroll") for (int m = 0; m < 4; ++m) _Pragma("unroll") for (int n = 0; n < 2; ++n) { \
        if constexpr (FP8) acc[ai][bj][m][n] = __builtin_amdgcn_mfma_scale_f32_16x16x128_f8f6f4(cat8(Bt[n][0], Bt[n][1]), cat8(At[m][0], At[m][1]), acc[ai][bj][m][n], 0, 0, 0, 0x7F7F7F7F, 0, 0x7F7F7F7F); \
        else { _Pragma("unroll") for (int k = 0; k < 2; ++k) acc[ai][bj][m][n] = __builtin_amdgcn_mfma_f32_16x16x32_bf16(Bt[n][k], At[m][k], acc[ai][bj][m][n], 0, 0, 0); } } __builtin_amdgcn_s_setprio(0); } while (0)
#define PG8_WAIT_V(n) asm volatile("s_waitcnt vmcnt(" #n ")" ::: "memory")
#define PG8_WAIT_L(n) asm volatile("s_waitcnt lgkmcnt(" #n ")" ::: "memory")
#define PG8_BAR __builtin_amdgcn_s_barrier()
#define PG8_SCHED __builtin_amdgcn_sched_barrier(0)
    Unit cur, nxt; int ui = 0;
    if (!S.next(0, cur)) return;
    f32x4 acc[2][2][4][2];
#pragma unroll
    for (int a = 0; a < 2; ++a)
#pragma unroll
        for (int b = 0; b < 2; ++b)
#pragma unroll
            for (int m = 0; m < 4; ++m)
#pragma unroll
                for (int n = 0; n < 2; ++n) acc[a][b][m][n] = (f32x4){0.f, 0.f, 0.f, 0.f};
    bf16x8 At[4][2], B0[2][2], B1[2][2];
    if constexpr (ABL & 16) { _Pragma("unroll") for (int m = 0; m < 4; ++m) _Pragma("unroll") for (int k = 0; k < 2; ++k) { At[m][k] = (bf16x8){0,0,0,0,0,0,0,0}; asm volatile("" : "+v"(At[m][k])); }
        _Pragma("unroll") for (int n = 0; n < 2; ++n) _Pragma("unroll") for (int k = 0; k < 2; ++k) { B0[n][k] = (bf16x8){0,0,0,0,0,0,0,0}; B1[n][k] = B0[n][k]; asm volatile("" : "+v"(B0[n][k]), "+v"(B1[n][k])); } }
    unsigned offC[2][2];
    S.aoff(cur, tid, offC);
    const char* cB = (const char*)g.Bt + cur.boff;
    PG8_STAGE(PG8_SB(0, 0), cB, voffB); PG8_STAGE(PG8_SB(0, 1), cB + hstep, voffB); PG8_STAGE(PG8_SA(0, 0), gA, offC[0]); PG8_STAGE(PG8_SA(0, 1), gA, offC[1]);
    if (wr == 1) PG8_BAR;
    PG8_WAIT_V(2); PG8_BAR;
    PG8_STAGE(PG8_SB(1, 0), cB + kstep, voffB); PG8_STAGE(PG8_SA(1, 0), gA + kstep, offC[0]); PG8_STAGE(PG8_SB(1, 1), cB + hstep + kstep, voffB);
    PG8_WAIT_V(6); PG8_BAR;
    for (;;) {
        const bool has_next = S.next(ui + 1, nxt);
        const char* nB = has_next ? (const char*)g.Bt + nxt.boff : cB;
#pragma unroll 1
        for (int t = 0; t < nt; t += 2) {
            const bool last = (t == nt - 2);
            const char* a1 = gA + (size_t)(t + 1) * kstep;
            const char* a2 = last ? gA : gA + (size_t)(t + 2) * kstep; const char* b2 = last ? nB : cB + (size_t)(t + 2) * kstep;
            const char* a3 = a2 + kstep; const char* b3 = b2 + kstep;
            PG8_LDB(B0, 0, 0); PG8_LDB(B1, 0, 1); PG8_SCHED; PG8_LDA(At, 0, 0); PG8_STAGE(PG8_SA(1, 1), a1, offC[1]);
            if (last && has_next) {
                { int t2 = tid; asm volatile("" : "+v"(t2)); S.aoff(nxt, t2, offC); } }
            PG8_WAIT_V(8); PG8_WAIT_L(0); PG8_BAR; PG8_MMA(0, 0, At, B0); PG8_MMA(0, 1, At, B1); PG8_BAR; PG8_SCHED;
            PG8_LDA(At, 0, 1); PG8_STAGE(PG8_SB(0, 0), b2, voffB); PG8_STAGE(PG8_SB(0, 1), b2 + hstep, voffB); PG8_STAGE(PG8_SA(0, 0), a2, offC[0]);
            PG8_WAIT_V(8); PG8_WAIT_L(0); PG8_BAR; PG8_MMA(1, 0, At, B0); PG8_MMA(1, 1, At, B1); PG8_BAR; PG8_SCHED;
            PG8_LDB(B0, 1, 0); PG8_LDB(B1, 1, 1); PG8_SCHED; PG8_LDA(At, 1, 0); PG8_STAGE(PG8_SA(0, 1), a2, offC[1]);
            PG8_WAIT_V(8); PG8_WAIT_L(0); PG8_BAR; PG8_MMA(0, 0, At, B0); PG8_MMA(0, 1, At, B1); PG8_BAR; PG8_SCHED;
            PG8_LDA(At, 1, 1); PG8_STAGE(PG8_SB(1, 0), b3, voffB); PG8_STAGE(PG8_SB(1, 1), b3 + hstep, voffB); PG8_STAGE(PG8_SA(1, 0), a3, offC[0]);
            PG8_WAIT_V(8); PG8_WAIT_L(0); PG8_BAR; PG8_MMA(1, 0, At, B0); PG8_MMA(1, 1, At, B1); PG8_BAR; PG8_SCHED;
        }
        if constexpr (ALIGN_EPI) { if (wr == 0) PG8_BAR; }
        if constexpr (!(ABL & 2)) E(acc, cur, wr, wc, fr, fq); else { _Pragma("unroll") for (int a = 0; a < 2; ++a) _Pragma("unroll") for (int b = 0; b < 2; ++b) _Pragma("unroll") for (int m = 0; m < 4; ++m) _Pragma("unroll") for (int n = 0; n < 2; ++n) asm volatile("" :: "v"(acc[a][b][m][n])); }
        if (!has_next) break;
#pragma unroll
        for (int a = 0; a < 2; ++a)
#pragma unroll
            for (int b = 0; b < 2; ++b)
#pragma unroll
                for (int m = 0; m < 4; ++m)
#pragma unroll
                    for (int n = 0; n < 2; ++n) acc[a][b][m][n] = (f32x4){0.f, 0.f, 0.f, 0.f};
        cur = nxt; cB = nB; ++ui;
        if constexpr (ALIGN_EPI) { if (wr == 1) PG8_BAR; }
    }
    PG8_WAIT_V(0);
    if constexpr (!ALIGN_EPI) { if (wr == 0) PG8_BAR; }
    PG8_BAR;
#undef PG8_SA
#undef PG8_SB
#undef PG8_STAGE
#undef PG8_LDA
#undef PG8_LDB
#undef PG8_MMA
#undef PG8_WAIT_V
#undef PG8_WAIT_L
#undef PG8_BAR
#undef PG8_SCHED
}
}

namespace attn_body {
using bf16=__hip_bfloat16;
using bf16x8=__attribute__((ext_vector_type(8)))short;
using s16x4=__attribute__((ext_vector_type(4)))short;
using f32x16=__attribute__((ext_vector_type(16)))float;
using u32x4=__attribute__((ext_vector_type(4)))unsigned;
#ifndef EMU8
#define EMU8 0
#endif
__device__ __forceinline__ float q8(float x,float s){ if(!EMU8) return x; const unsigned w=__builtin_amdgcn_cvt_pk_fp8_f32(x*s,0.f,0u,false); return __builtin_amdgcn_cvt_f32_fp8((int)w,0)*(1.0f/s); }
constexpr int SEQ=4096,D=64,DM=1024;
constexpr int NW=8,QBLK=32,QB=QBLK*NW,KVBLK=64,NQB=SEQ/QB;
constexpr int ATTN_PITCH=DM, ATTN_UNIT_ROWS=QB;
__device__ __forceinline__ int crow(int r,int hi){return (r&3)+8*(r>>2)+4*hi;}
#define SBAR() __builtin_amdgcn_sched_barrier(0)
__device__ __forceinline__ void cmask(f32x16&p0,f32x16&p1,int jb,int qrel,int hi){
  const float NEG=-INFINITY; int kb=64*jb+4*hi;
  #pragma unroll
  for(int r=0;r<16;++r){int kv=kb+(r&3)+8*(r>>2); if(kv>qrel)p0[r]=NEG; if(kv+32>qrel)p1[r]=NEG;}
}

constexpr int NSLOT=3, SLOTB=8192;
constexpr int LDS_K=0, LDS_V=NSLOT*SLOTB, LDS_WS=2*NSLOT*SLOTB, LDS_OST=LDS_WS+NW*64*4, LDS_BIAS=LDS_OST+NW*4096, LDS_BYTES=LDS_BIAS+SEQ*8;
constexpr float C2=0.125f*1.4426950408889634f;
__device__ __forceinline__ void glds16(const void*sbase,unsigned voff,unsigned lds_dst){unsigned keep;
  asm volatile("s_mov_b32 %0, m0\n\ts_mov_b32 m0, %3\n\ts_nop 2\n\tglobal_load_lds_dwordx4 %1, %2\n\ts_mov_b32 m0, %0":"=&s"(keep):"v"(voff),"s"(sbase),"s"(lds_dst):"memory");}
__device__ __forceinline__ float max3f(float a,float b,float c){float r;asm("v_max3_f32 %0, %1, %2, %3":"=v"(r):"v"(a),"v"(b),"v"(c));return r;}
__device__ __forceinline__ float max2f(float a,float b){float r;asm("v_max_f32_e32 %0, %1, %2":"=v"(r):"v"(a),"v"(b));return r;}
__device__ __forceinline__ float fadd_s(float a,float b){float r;asm("v_add_f32_e32 %0, %1, %2":"=v"(r):"v"(a),"v"(b));return r;}
__device__ __forceinline__ float fsub_s(float a,float b){float r;asm("v_sub_f32_e32 %0, %1, %2":"=v"(r):"v"(a),"v"(b));return r;}
typedef float f32x2_t __attribute__((ext_vector_type(2))); typedef __bf16 bf16x2_t __attribute__((ext_vector_type(2)));
__device__ __forceinline__ unsigned cvtpk_s(float lo,float hi){f32x2_t v={lo,hi};bf16x2_t b=__builtin_convertvector(v,bf16x2_t);return __builtin_bit_cast(unsigned,b);}
#define WAIT_BAR(N) asm volatile("s_waitcnt vmcnt(" #N ") lgkmcnt(0)\n\ts_barrier":::"memory")

__device__ __forceinline__ void qkt(f32x16&p0,f32x16&p1,const char*Kslot,const bf16x8*qr,int r32,int hi){
  const char*kb=Kslot+hi*1024+r32*16;
  #pragma unroll
  for(int d0=0;d0<4;++d0){
    const bf16x8 b0=*reinterpret_cast<const bf16x8*>(kb+d0*2048);
    const bf16x8 b1=*reinterpret_cast<const bf16x8*>(kb+d0*2048+512);
    {p0=__builtin_amdgcn_mfma_f32_32x32x16_bf16(b0,qr[d0],p0,0,0,0);p1=__builtin_amdgcn_mfma_f32_32x32x16_bf16(b1,qr[d0],p1,0,0,0);}}
}
typedef __attribute__((address_space(3))) const char* lds_cptr;
typedef short v4i16_t __attribute__((ext_vector_type(4)));
__device__ __forceinline__ void kload8(bf16x8*kf,lds_cptr kp){
  kf[0]=*(const __attribute__((address_space(3))) bf16x8*)(kp);      kf[1]=*(const __attribute__((address_space(3))) bf16x8*)(kp+512);
  kf[2]=*(const __attribute__((address_space(3))) bf16x8*)(kp+2048); kf[3]=*(const __attribute__((address_space(3))) bf16x8*)(kp+2560);
  kf[4]=*(const __attribute__((address_space(3))) bf16x8*)(kp+4096); kf[5]=*(const __attribute__((address_space(3))) bf16x8*)(kp+4608);
  kf[6]=*(const __attribute__((address_space(3))) bf16x8*)(kp+6144); kf[7]=*(const __attribute__((address_space(3))) bf16x8*)(kp+6656);
}
__device__ __forceinline__ void kload2(bf16x8*kf,lds_cptr kp,int j){ kf[2*j]=*(const __attribute__((address_space(3))) bf16x8*)(kp+j*2048); kf[2*j+1]=*(const __attribute__((address_space(3))) bf16x8*)(kp+j*2048+512); }
__device__ __forceinline__ s16x4 vtr(lds_cptr p){ return __builtin_bit_cast(s16x4,__builtin_amdgcn_ds_read_tr16_b64_v4i16((__attribute__((address_space(3))) v4i16_t*)p)); }
__device__ __forceinline__ float rowmax(const f32x16&p0,const f32x16&p1){
  float a=max3f(p0[0],p0[1],p1[0]),b=max3f(p0[2],p0[3],p1[1]);a=max3f(a,p1[2],p1[3]);
  #pragma unroll
  for(int r=4;r<16;r+=4){a=max3f(a,p0[r],p0[r+1]);b=max3f(b,p0[r+2],p0[r+3]);a=max3f(a,p1[r],p1[r+1]);b=max3f(b,p1[r+2],p1[r+3]);}
  const float m=max2f(a,b);
  auto rr=__builtin_amdgcn_permlane32_swap(__float_as_uint(m),__float_as_uint(m),false,false);
  return max2f(__uint_as_float(rr[0]),__uint_as_float(rr[1]));
}
__device__ __forceinline__ void pv(f32x16*o,int vb,bf16x8 pa0,bf16x8 pa1,bf16x8 pa2,bf16x8 pa3){
  #pragma unroll
  for(int d0=0;d0<2;++d0){s16x4 lo[4],hi[4];
    #pragma unroll
    for(int ks=0;ks<4;++ks){
      asm volatile("ds_read_b64_tr_b16 %0,%1 offset:%c2":"=&v"(lo[ks]):"v"(vb),"i"(d0*4096+ks*1024):"memory");
      asm volatile("ds_read_b64_tr_b16 %0,%1 offset:%c2":"=&v"(hi[ks]):"v"(vb),"i"(d0*4096+ks*1024+512):"memory");}
    asm volatile("s_waitcnt lgkmcnt(0)":::"memory");SBAR();
    #define PK(k) (bf16x8){lo[k][0],lo[k][1],lo[k][2],lo[k][3],hi[k][0],hi[k][1],hi[k][2],hi[k][3]}
    o[d0]=__builtin_amdgcn_mfma_f32_32x32x16_bf16(pa0,PK(0),o[d0],0,0,0);
    o[d0]=__builtin_amdgcn_mfma_f32_32x32x16_bf16(pa1,PK(1),o[d0],0,0,0);
    o[d0]=__builtin_amdgcn_mfma_f32_32x32x16_bf16(pa2,PK(2),o[d0],0,0,0);
    o[d0]=__builtin_amdgcn_mfma_f32_32x32x16_bf16(pa3,PK(3),o[d0],0,0,0);
    #undef PK
  }
}

#ifndef ATTN_STORE16
#define ATTN_STORE16(p,v) (*(u32x4*)(p)=(v))
#endif
typedef float f32x4v __attribute__((ext_vector_type(4)));
typedef unsigned u32x2v __attribute__((ext_vector_type(2)));
#define KAF(ka) __builtin_bit_cast(bf16x8,(u32x4){(ka)[0],(ka)[1],0x3F803F80u,0x00003F80u})
#define KAR(tt) do{ ka0=*(const __attribute__((address_space(3))) u32x2v*)(kap+(tt)*512); ka1=*(const __attribute__((address_space(3))) u32x2v*)(kap+(tt)*512+256); }while(0)
__device__ __forceinline__ float ka_value(u32x2v w){ return (__uint_as_float(w[0]<<16)+__uint_as_float(w[0]&0xffff0000u))+__uint_as_float(w[1]<<16); }
__device__ __forceinline__ u32x2v ka_split(float b){ const unsigned h=cvtpk_s(b,0.f)&0xffffu; const float r1=b-__uint_as_float(h<<16); const unsigned m=cvtpk_s(r1,0.f)&0xffffu; const float r2=r1-__uint_as_float(m<<16); const unsigned l=cvtpk_s(r2,0.f)&0xffffu; return (u32x2v){h|(m<<16),l}; }
template<int THRL> __device__ __forceinline__ void attn_unit(int qb,int t0,const bf16*Qb,const bf16*__restrict__ Kb,const bf16*__restrict__ Vb,bf16*Ob,char*shm,const int tid,const float bh,const float osc){
  const int lane=tid&63,r32=lane&31,hi=lane>>5; const int wid=__builtin_amdgcn_readfirstlane(tid>>6);
  const int q0=qb*QB;
  const bf16*Qw=Qb+(long)(q0+wid*QBLK)*DM;
  const bf16*Kh=Kb+(long)t0*KVBLK*DM,*Vh=Vb+(long)t0*KVBLK*DM;
  const unsigned lds0=(unsigned)(uintptr_t)shm;
  float*wsf=(float*)(shm+LDS_WS)+wid*64;
  const unsigned ksrc=(unsigned)(lane*DM+wid*8)*2u;
  const unsigned vsrc=(unsigned)((16*(wid&3)+(lane>>2))*DM+(wid>>2)*32+(lane&3)*8)*2u;
  const unsigned kdst=lds0+LDS_K+wid*1024, vdst=lds0+LDS_V+wid*1024;
  #define DMA_K(t,slot) glds16(Kh+(long)(t)*KVBLK*DM,ksrc,(unsigned)__builtin_amdgcn_readfirstlane(kdst+(slot)))
  #define DMA_V(t,slot) glds16(Vh+(long)(t)*KVBLK*DM,vsrc,(unsigned)__builtin_amdgcn_readfirstlane(vdst+(slot)))
  const int vb0=(int)(lds0+LDS_V)+((lane>>4)&1)*32+(lane&3)*8+(4*hi+((lane&15)>>2))*64;
  const char*Kbase=shm+LDS_K; bf16x8 kf[8];
  const lds_cptr shm3=(lds_cptr)shm; const lds_cptr kap=shm3+LDS_BIAS+t0*512+r32*8; const lds_cptr kp0=shm3+LDS_K+hi*1024+r32*16; const lds_cptr vp0=shm3+LDS_V+((lane>>4)&1)*32+(lane&3)*8+(4*hi+((lane&15)>>2))*64;
  const int NT=(q0+QB)/KVBLK-t0;
  DMA_K(0,0);DMA_V(0,0);DMA_K(1,SLOTB);
  bf16x8 qr[4];
  #pragma unroll
  for(int d0=0;d0<4;++d0)qr[d0]=*reinterpret_cast<const bf16x8*>(&Qw[(long)r32*DM+d0*16+hi*8]);
  float z_=0.f;asm volatile("":"+v"(z_));float l_reg=z_;f32x16 o[2];
  const float mhat=ka_value(*(const __attribute__((address_space(3))) u32x2v*)((lds_cptr)shm+LDS_BIAS+(q0+wid*QBLK+r32)*8))+bh;
  bf16x8 qa; { const u32x2v nm=ka_split(-mhat); const u32x4 w=hi==0?(u32x4){0x3F803F80u,0x00003F80u,nm[0],nm[1]}:(u32x4){0u,0u,0u,0u}; qa=__builtin_bit_cast(bf16x8,w); }
  u32x2v ka0,ka1;
  #pragma unroll
  for(int r=0;r<16;++r){o[0][r]=z_;o[1][r]=z_;}
  const int qrel=wid*QBLK+r32;
  #define CMASK(P0,P1,t) do{int jb_=(t)-(NT-4); if(jb_>=0)cmask(P0,P1,jb_,qrel,hi);}while(0)
  #define START(P0,P1) do{ _Pragma("unroll") for(int r=0;r<16;++r)P0[r]=__builtin_amdgcn_exp2f(P0[r]); }while(0)
  #define RESC() do{}while(0)
  f32x16 pA0,pA1,pB0,pB1;
  int sl_prev=0,sl_cur=0,sl_next=SLOTB;
  #define ROT() do{sl_prev=sl_cur;sl_cur=sl_next;sl_next=(sl_next==(NSLOT-1)*SLOTB)?0:sl_next+SLOTB;}while(0)
  DMA_K(2,2*SLOTB);
  WAIT_BAR(3);
  KAR(0); pA0=__builtin_amdgcn_mfma_f32_32x32x16_bf16(KAF(ka0),qa,f32x16{},0,0,0); pA1=__builtin_amdgcn_mfma_f32_32x32x16_bf16(KAF(ka1),qa,f32x16{},0,0,0);
  qkt(pA0,pA1,Kbase,qr,r32,hi);asm volatile("s_nop 15\n\ts_nop 7":"+v"(pA0),"+v"(pA1));CMASK(pA0,pA1,0);
  START(pA0,pA1);
  _Pragma("unroll") for(int r=0;r<16;++r)pA1[r]=__builtin_amdgcn_exp2f(pA1[r]);
  WAIT_BAR(0);
  DMA_K(3,0);DMA_V(1,SLOTB);
  ROT();
  kload8(kf,kp0+sl_cur); KAR(1);
  WAIT_BAR(2);
  s16x4 vlo[8],vhi[8]; u32x4 pw0,pw1,pw2,pw3;
  #define PKW(P,B) cvtpk_s(P[B],P[B+1])
  #define PAF(k) __builtin_bit_cast(bf16x8,pw##k)
  #define VFR(i) (bf16x8){vlo[i][0],vlo[i][1],vlo[i][2],vlo[i][3],vhi[i][0],vhi[i][1],vhi[i][2],vhi[i][3]}
  #define PIN(x) asm volatile("":"+v"(x))
  #define MX3(a,b,c) __builtin_fmaxf(__builtin_fmaxf((a),(b)),(c))
  #define GAPA(MF,A0,A1,A2,A3,W0,W1,PW) do{ MF; sacc+=A0; sacc+=A1; sacc+=A2; sacc+=A3; PIN(sacc); W0; W1; PIN(PW); SBAR(); }while(0)
  #define EX(v) __builtin_amdgcn_exp2f(v)
  #define GAPB(MF,X,B) do{ MF; X[B]=EX(X[B]); X[B+1]=EX(X[B+1]); X[B+2]=EX(X[B+2]); X[B+3]=EX(X[B+3]); PIN(X); SBAR(); }while(0)
  #define VRD(i) do{ vlo[i]=vtr(vp_+(((i)>>2)*4096+((i)&3)*1024)); vhi[i]=vtr(vp_+(((i)>>2)*4096+((i)&3)*1024+512)); }while(0)
  #define KRD(G,j) do{ if(G){ kload2(kf,kp0+sl_next,j); SBAR(); } }while(0)
  #define STEP(C0,C1,P0,P1,t,GK,GV,GL) do{ SBAR(); \
    const lds_cptr vp_=vp0+sl_prev; \
    C0=__builtin_amdgcn_mfma_f32_32x32x16_bf16(KAF(ka0),qa,f32x16{},0,0,0); C1=__builtin_amdgcn_mfma_f32_32x32x16_bf16(KAF(ka1),qa,f32x16{},0,0,0); SBAR(); \
    VRD(0); SBAR(); float sacc=(P0[0]+P0[1]); \
    GAPA(C0=__builtin_amdgcn_mfma_f32_32x32x16_bf16(kf[0],qr[0],C0,0,0,0), P0[2],P0[3],P0[4],P0[5],     pw0[0]=PKW(P0,0), pw0[1]=PKW(P0,2), pw0); \
    VRD(4); SBAR(); GAPA(C1=__builtin_amdgcn_mfma_f32_32x32x16_bf16(kf[1],qr[0],C1,0,0,0), P0[6],P0[7],P0[8],P0[9],     pw0[2]=PKW(P0,4), pw0[3]=PKW(P0,6), pw0); \
    VRD(1); SBAR(); GAPA(C0=__builtin_amdgcn_mfma_f32_32x32x16_bf16(kf[2],qr[1],C0,0,0,0),   P0[10],P0[11],P0[12],P0[13], pw1[0]=PKW(P0,8), pw1[1]=PKW(P0,10), pw1); \
    VRD(5); SBAR(); GAPA(C1=__builtin_amdgcn_mfma_f32_32x32x16_bf16(kf[3],qr[1],C1,0,0,0),   P0[14],P0[15],P1[0],P1[1],   pw1[2]=PKW(P0,12),pw1[3]=PKW(P0,14), pw1); \
    VRD(2); SBAR(); GAPA(C0=__builtin_amdgcn_mfma_f32_32x32x16_bf16(kf[4],qr[2],C0,0,0,0),   P1[2],P1[3],P1[4],P1[5],     pw2[0]=PKW(P1,0), pw2[1]=PKW(P1,2), pw2); \
    VRD(6); SBAR(); GAPA(C1=__builtin_amdgcn_mfma_f32_32x32x16_bf16(kf[5],qr[2],C1,0,0,0),   P1[6],P1[7],P1[8],P1[9],     pw2[2]=PKW(P1,4), pw2[3]=PKW(P1,6), pw2); \
    VRD(3); SBAR(); GAPA(C0=__builtin_amdgcn_mfma_f32_32x32x16_bf16(kf[6],qr[3],C0,0,0,0),   P1[10],P1[11],P1[12],P1[13], pw3[0]=PKW(P1,8), pw3[1]=PKW(P1,10), pw3); \
    VRD(7); SBAR(); GAPA(C1=__builtin_amdgcn_mfma_f32_32x32x16_bf16(kf[7],qr[3],C1,0,0,0),   P1[14],P1[15],0.f,0.f,       pw3[2]=PKW(P1,12),pw3[3]=PKW(P1,14), pw3); \
    l_reg+=sacc; \
    if(GK){DMA_K((t)+3,sl_cur);} if(GV){DMA_V((t)+1,sl_next);} \
    CMASK(C0,C1,t); \
    SBAR(); \
    GAPB(o[0]=__builtin_amdgcn_mfma_f32_32x32x16_bf16(PAF(0),VFR(0),o[0],0,0,0), C0,0); \
    GAPB(o[1]=__builtin_amdgcn_mfma_f32_32x32x16_bf16(PAF(0),VFR(4),o[1],0,0,0), C0,4); \
    if(GL){KAR((t)+1);} KRD(GL,0); GAPB(o[0]=__builtin_amdgcn_mfma_f32_32x32x16_bf16(PAF(1),VFR(1),o[0],0,0,0), C0,8); \
    KRD(GL,1); GAPB(o[1]=__builtin_amdgcn_mfma_f32_32x32x16_bf16(PAF(1),VFR(5),o[1],0,0,0), C0,12); \
    KRD(GL,2); GAPB(o[0]=__builtin_amdgcn_mfma_f32_32x32x16_bf16(PAF(2),VFR(2),o[0],0,0,0), C1,0); \
    KRD(GL,3); GAPB(o[1]=__builtin_amdgcn_mfma_f32_32x32x16_bf16(PAF(2),VFR(6),o[1],0,0,0), C1,4); \
    GAPB(o[0]=__builtin_amdgcn_mfma_f32_32x32x16_bf16(PAF(3),VFR(3),o[0],0,0,0), C1,8); \
    GAPB(o[1]=__builtin_amdgcn_mfma_f32_32x32x16_bf16(PAF(3),VFR(7),o[1],0,0,0), C1,12); \
    }while(0)
  int t=1;
  #undef CMASK
  #define CMASK(P0,P1,t) do{}while(0)
  for(;t+5<NT;t+=2){
    STEP(pB0,pB1,pA0,pA1,t,true,true,true);     WAIT_BAR(2); RESC(); ROT();
    STEP(pA0,pA1,pB0,pB1,t+1,true,true,true);   WAIT_BAR(2); RESC(); ROT();
  }
  #undef CMASK
  #define CMASK(P0,P1,t) do{int jb_=(t)-(NT-4); if(jb_>=0)cmask(P0,P1,jb_,qrel,hi);}while(0)
  #define ENDW(tt) do{ if((tt)+3<NT){WAIT_BAR(2);} else if((tt)+2<NT){WAIT_BAR(1);} else {WAIT_BAR(0);} }while(0)
  for(;t+1<NT;t+=2){
    STEP(pB0,pB1,pA0,pA1,t,(t+3<NT),(t+1<NT),(t+1<NT));       ENDW(t);   RESC(); ROT();
    STEP(pA0,pA1,pB0,pB1,t+1,(t+4<NT),(t+2<NT),(t+2<NT));     ENDW(t+1); RESC(); ROT();
  }
  STEP(pB0,pB1,pA0,pA1,NT-1,false,false,false); RESC();
  { float sacc=pB0[0]+pB0[1]; _Pragma("unroll") for(int r=2;r<16;++r)sacc+=pB0[r]; _Pragma("unroll") for(int r=0;r<16;++r)sacc+=pB1[r]; l_reg+=sacc;
    pw0=(u32x4){PKW(pB0,0),PKW(pB0,2),PKW(pB0,4),PKW(pB0,6)};pw1=(u32x4){PKW(pB0,8),PKW(pB0,10),PKW(pB0,12),PKW(pB0,14)};pw2=(u32x4){PKW(pB1,0),PKW(pB1,2),PKW(pB1,4),PKW(pB1,6)};pw3=(u32x4){PKW(pB1,8),PKW(pB1,10),PKW(pB1,12),PKW(pB1,14)};
    SBAR(); pv(o,vb0+sl_cur,PAF(0),PAF(1),PAF(2),PAF(3)); }
  #undef PKW
  #undef PAF
  #undef VFR
  #undef PIN
  #undef MX3
  #undef GAPA
  #undef GAPB
  #undef EX
  #undef VRD
  #undef KRD
  #undef STEP
  #undef ENDW
  {auto rr=__builtin_amdgcn_permlane32_swap(__float_as_uint(l_reg),__float_as_uint(l_reg),false,false);l_reg=__uint_as_float(rr[0])+__uint_as_float(rr[1]);}
  if(hi==0)wsf[32+r32]=l_reg;asm volatile("s_waitcnt lgkmcnt(0)":::"memory");
  float rli[16];
  #pragma unroll
  for(int r=0;r<16;++r)rli[r]=__builtin_amdgcn_rcpf(wsf[32+crow(r,hi)]);
  { unsigned char*stg=(unsigned char*)(shm+LDS_OST)+wid*4096;
    unsigned char*Ow8=(unsigned char*)Ob+(long)(q0+wid*QBLK)*DM;
    #pragma unroll
    for(int r=0;r<16;++r){const int orow=crow(r,hi); const float s_=rli[r]*osc;
      #pragma unroll
      for(int d0=0;d0<2;++d0)stg[orow*64+d0*32+r32]=(unsigned char)(__builtin_amdgcn_cvt_pk_fp8_f32(o[d0][r]*s_,0.f,0u,false)&0xffu);}
    asm volatile("s_waitcnt lgkmcnt(0)":::"memory");
    #pragma unroll
    for(int i=0;i<2;++i){const int row=i*16+(lane>>2),ch=lane&3; const u32x4 v=*(const u32x4*)(stg+row*64+ch*16); ATTN_STORE16(Ow8+(long)row*DM+ch*16,v);} }
  asm volatile("s_waitcnt lgkmcnt(0)\n\ts_barrier":::"memory");
  #undef DMA_K
  #undef DMA_V
  #undef CMASK
  #undef START
  #undef RESC
  #undef ROT
}

constexpr int V128_SLOTB=16384, LDS128_K=0, LDS128_V=NSLOT*SLOTB, LDS128_WS=LDS128_V+NSLOT*V128_SLOTB, LDS128_OST=LDS128_WS+NW*64*4, LDS128_BIAS=LDS128_OST+NW*4096, LDS128_BYTES=LDS128_BIAS+SEQ*8;
__device__ __forceinline__ void pv4(f32x16*o,int vb,bf16x8 pa0,bf16x8 pa1,bf16x8 pa2,bf16x8 pa3){
  #pragma unroll
  for(int d0=0;d0<4;++d0){s16x4 lo[4],hi[4];
    #pragma unroll
    for(int ks=0;ks<4;++ks){
      asm volatile("ds_read_b64_tr_b16 %0,%1 offset:%c2":"=&v"(lo[ks]):"v"(vb),"i"(d0*4096+ks*1024):"memory");
      asm volatile("ds_read_b64_tr_b16 %0,%1 offset:%c2":"=&v"(hi[ks]):"v"(vb),"i"(d0*4096+ks*1024+512):"memory");}
    asm volatile("s_waitcnt lgkmcnt(0)":::"memory");SBAR();
    #define PK(k) (bf16x8){lo[k][0],lo[k][1],lo[k][2],lo[k][3],hi[k][0],hi[k][1],hi[k][2],hi[k][3]}
    o[d0]=__builtin_amdgcn_mfma_f32_32x32x16_bf16(pa0,PK(0),o[d0],0,0,0);
    o[d0]=__builtin_amdgcn_mfma_f32_32x32x16_bf16(pa1,PK(1),o[d0],0,0,0);
    o[d0]=__builtin_amdgcn_mfma_f32_32x32x16_bf16(pa2,PK(2),o[d0],0,0,0);
    o[d0]=__builtin_amdgcn_mfma_f32_32x32x16_bf16(pa3,PK(3),o[d0],0,0,0);
    #undef PK
  }
}
__device__ __forceinline__ void attn_unit128(int qb,int t0,const bf16*Qb,const bf16*__restrict__ Kb,const bf16*__restrict__ Vb,bf16*Ob,char*shm,const int tid,const float bh,const int comb,unsigned char*Oc,const float*lamp,const float*gnorm,const float post,const float eps){
  const int lane=tid&63,r32=lane&31,hi=lane>>5; const int wid=__builtin_amdgcn_readfirstlane(tid>>6);
  const int q0=qb*QB;
  const bf16*Qw=Qb+(long)(q0+wid*QBLK)*DM;
  const bf16*Kh=Kb+(long)t0*KVBLK*DM,*Vh=Vb+(long)t0*KVBLK*DM;
  const unsigned lds0=(unsigned)(uintptr_t)shm;
  float*wsf=(float*)(shm+LDS128_WS)+wid*64;
  const unsigned ksrc=(unsigned)(lane*DM+wid*8)*2u;
  const unsigned vsrc=(unsigned)((16*(wid&3)+(lane>>2))*DM+(wid>>2)*32+(lane&3)*8)*2u;
  const unsigned kdst=lds0+LDS128_K+wid*1024, vdst=lds0+LDS128_V+wid*1024;
  #define DMA_K(t,slot) glds16(Kh+(long)(t)*KVBLK*DM,ksrc,(unsigned)__builtin_amdgcn_readfirstlane(kdst+(slot)))
  #define DMA_V(t,slot) do{ glds16(Vh+(long)(t)*KVBLK*DM,vsrc,(unsigned)__builtin_amdgcn_readfirstlane(vdst+2*(slot))); glds16(Vh+(long)(t)*KVBLK*DM+64,vsrc,(unsigned)__builtin_amdgcn_readfirstlane(vdst+2*(slot)+8192)); }while(0)
  const int vb0=(int)(lds0+LDS128_V)+((lane>>4)&1)*32+(lane&3)*8+(4*hi+((lane&15)>>2))*64;
  const char*Kbase=shm+LDS128_K; bf16x8 kf[8];
  const lds_cptr shm3=(lds_cptr)shm; const lds_cptr kap=shm3+LDS128_BIAS+t0*512+r32*8; const lds_cptr kp0=shm3+LDS128_K+hi*1024+r32*16; const lds_cptr vp0=shm3+LDS128_V+((lane>>4)&1)*32+(lane&3)*8+(4*hi+((lane&15)>>2))*64;
  const int NT=(q0+QB)/KVBLK-t0;
  DMA_K(0,0);DMA_V(0,0);DMA_K(1,SLOTB);
  bf16x8 qr[4];
  #pragma unroll
  for(int d0=0;d0<4;++d0)qr[d0]=*reinterpret_cast<const bf16x8*>(&Qw[(long)r32*DM+d0*16+hi*8]);
  float z_=0.f;asm volatile("":"+v"(z_));float l_reg=z_;f32x16 o[4];
  const float mhat=ka_value(*(const __attribute__((address_space(3))) u32x2v*)((lds_cptr)shm+LDS128_BIAS+(q0+wid*QBLK+r32)*8))+bh;
  bf16x8 qa; { const u32x2v nm=ka_split(-mhat); const u32x4 w=hi==0?(u32x4){0x3F803F80u,0x00003F80u,nm[0],nm[1]}:(u32x4){0u,0u,0u,0u}; qa=__builtin_bit_cast(bf16x8,w); }
  u32x2v ka0,ka1;
  #pragma unroll
  for(int r=0;r<16;++r){o[0][r]=z_;o[1][r]=z_;o[2][r]=z_;o[3][r]=z_;}
  const int qrel=wid*QBLK+r32;
  #define CMASK(P0,P1,t) do{int jb_=(t)-(NT-4); if(jb_>=0)cmask(P0,P1,jb_,qrel,hi);}while(0)
  f32x16 C0,C1;
  int sl_prev=0,sl_cur=0,sl_next=SLOTB;
  #define ROT() do{sl_prev=sl_cur;sl_cur=sl_next;sl_next=(sl_next==(NSLOT-1)*SLOTB)?0:sl_next+SLOTB;}while(0)
  DMA_K(2,2*SLOTB);
  WAIT_BAR(4);
  s16x4 vlo[8],vhi[8]; u32x4 pwA0,pwA1,pwA2,pwA3,pwB0,pwB1,pwB2,pwB3;
  #define PKW(P,B) cvtpk_s(P[B],P[B+1])
  #define PAF(S,k) __builtin_bit_cast(bf16x8,pw##S##k)
  #define VFR(i) (bf16x8){vlo[i][0],vlo[i][1],vlo[i][2],vlo[i][3],vhi[i][0],vhi[i][1],vhi[i][2],vhi[i][3]}
  #define PIN(x) asm volatile("":"+v"(x))
  #define EX(v) __builtin_amdgcn_exp2f(v)
  KAR(0); C0=__builtin_amdgcn_mfma_f32_32x32x16_bf16(KAF(ka0),qa,f32x16{},0,0,0); C1=__builtin_amdgcn_mfma_f32_32x32x16_bf16(KAF(ka1),qa,f32x16{},0,0,0);
  qkt(C0,C1,Kbase,qr,r32,hi);asm volatile("s_nop 15\n\ts_nop 7":"+v"(C0),"+v"(C1));CMASK(C0,C1,0);
  { float sacc=z_;
    _Pragma("unroll") for(int r=0;r<16;++r){C0[r]=EX(C0[r]);C1[r]=EX(C1[r]);}
    _Pragma("unroll") for(int r=0;r<16;++r){sacc+=C0[r];sacc+=C1[r];}
    l_reg+=sacc;
    pwA0=(u32x4){PKW(C0,0),PKW(C0,2),PKW(C0,4),PKW(C0,6)};pwA1=(u32x4){PKW(C0,8),PKW(C0,10),PKW(C0,12),PKW(C0,14)};pwA2=(u32x4){PKW(C1,0),PKW(C1,2),PKW(C1,4),PKW(C1,6)};pwA3=(u32x4){PKW(C1,8),PKW(C1,10),PKW(C1,12),PKW(C1,14)}; }
  WAIT_BAR(0);
  DMA_K(3,0);DMA_V(1,SLOTB);
  ROT();
  kload8(kf,kp0+sl_cur); KAR(1);
  WAIT_BAR(3);
  #define VRD(i) do{ vlo[i]=vtr(vp_+(((i)>>2)*4096+((i)&3)*1024)); vhi[i]=vtr(vp_+(((i)>>2)*4096+((i)&3)*1024+512)); }while(0)
  #define VRD2(i) do{ vlo[i]=vtr(vp_+((2+((i)>>2))*4096+((i)&3)*1024)); vhi[i]=vtr(vp_+((2+((i)>>2))*4096+((i)&3)*1024+512)); }while(0)
  #define KRD(G,j) do{ if(G){ kload2(kf,kp0+sl_next,j); SBAR(); } }while(0)
  #define QKG(V,MF) do{ VRD(V); SBAR(); MF; SBAR(); }while(0)
  #define GB(MF,X,B,W,AFTER) do{ MF; { const float e0_=EX(X[B]), e1_=EX(X[B+1]); sacc+=e0_; sacc+=e1_; W=cvtpk_s(e0_,e1_); } PIN(sacc); PIN(W); AFTER; SBAR(); }while(0)
  #define STEP128(P,N,t,GK,GV,GL) do{ SBAR(); \
    const lds_cptr vp_=vp0+2*sl_prev; \
    C0=__builtin_amdgcn_mfma_f32_32x32x16_bf16(KAF(ka0),qa,f32x16{},0,0,0); C1=__builtin_amdgcn_mfma_f32_32x32x16_bf16(KAF(ka1),qa,f32x16{},0,0,0); SBAR(); \
    QKG(0,C0=__builtin_amdgcn_mfma_f32_32x32x16_bf16(kf[0],qr[0],C0,0,0,0)); \
    QKG(4,C1=__builtin_amdgcn_mfma_f32_32x32x16_bf16(kf[1],qr[0],C1,0,0,0)); \
    QKG(1,C0=__builtin_amdgcn_mfma_f32_32x32x16_bf16(kf[2],qr[1],C0,0,0,0)); \
    QKG(5,C1=__builtin_amdgcn_mfma_f32_32x32x16_bf16(kf[3],qr[1],C1,0,0,0)); \
    QKG(2,C0=__builtin_amdgcn_mfma_f32_32x32x16_bf16(kf[4],qr[2],C0,0,0,0)); \
    QKG(6,C1=__builtin_amdgcn_mfma_f32_32x32x16_bf16(kf[5],qr[2],C1,0,0,0)); \
    QKG(3,C0=__builtin_amdgcn_mfma_f32_32x32x16_bf16(kf[6],qr[3],C0,0,0,0)); \
    QKG(7,C1=__builtin_amdgcn_mfma_f32_32x32x16_bf16(kf[7],qr[3],C1,0,0,0)); \
    if(GK){DMA_K((t)+3,sl_cur);} if(GV){DMA_V((t)+1,sl_next);} \
    CMASK(C0,C1,t); \
    SBAR(); \
    float sacc=z_; \
    GB(o[0]=__builtin_amdgcn_mfma_f32_32x32x16_bf16(PAF(P,0),VFR(0),o[0],0,0,0), C0,0, pw##N##0[0], VRD2(0)); \
    GB(o[1]=__builtin_amdgcn_mfma_f32_32x32x16_bf16(PAF(P,0),VFR(4),o[1],0,0,0), C0,2, pw##N##0[1], VRD2(4)); \
    GB(o[0]=__builtin_amdgcn_mfma_f32_32x32x16_bf16(PAF(P,1),VFR(1),o[0],0,0,0), C0,4, pw##N##0[2], VRD2(1)); \
    GB(o[1]=__builtin_amdgcn_mfma_f32_32x32x16_bf16(PAF(P,1),VFR(5),o[1],0,0,0), C0,6, pw##N##0[3], VRD2(5)); \
    GB(o[0]=__builtin_amdgcn_mfma_f32_32x32x16_bf16(PAF(P,2),VFR(2),o[0],0,0,0), C0,8, pw##N##1[0], VRD2(2)); \
    GB(o[1]=__builtin_amdgcn_mfma_f32_32x32x16_bf16(PAF(P,2),VFR(6),o[1],0,0,0), C0,10,pw##N##1[1], VRD2(6)); \
    GB(o[0]=__builtin_amdgcn_mfma_f32_32x32x16_bf16(PAF(P,3),VFR(3),o[0],0,0,0), C0,12,pw##N##1[2], VRD2(3)); \
    GB(o[1]=__builtin_amdgcn_mfma_f32_32x32x16_bf16(PAF(P,3),VFR(7),o[1],0,0,0), C0,14,pw##N##1[3], VRD2(7)); \
    GB(o[2]=__builtin_amdgcn_mfma_f32_32x32x16_bf16(PAF(P,0),VFR(0),o[2],0,0,0), C1,0, pw##N##2[0], if(GL){KAR((t)+1);}); \
    GB(o[3]=__builtin_amdgcn_mfma_f32_32x32x16_bf16(PAF(P,0),VFR(4),o[3],0,0,0), C1,2, pw##N##2[1], KRD(GL,0)); \
    GB(o[2]=__builtin_amdgcn_mfma_f32_32x32x16_bf16(PAF(P,1),VFR(1),o[2],0,0,0), C1,4, pw##N##2[2], KRD(GL,1)); \
    GB(o[3]=__builtin_amdgcn_mfma_f32_32x32x16_bf16(PAF(P,1),VFR(5),o[3],0,0,0), C1,6, pw##N##2[3], KRD(GL,2)); \
    GB(o[2]=__builtin_amdgcn_mfma_f32_32x32x16_bf16(PAF(P,2),VFR(2),o[2],0,0,0), C1,8, pw##N##3[0], KRD(GL,3)); \
    GB(o[3]=__builtin_amdgcn_mfma_f32_32x32x16_bf16(PAF(P,2),VFR(6),o[3],0,0,0), C1,10,pw##N##3[1], (void)0); \
    GB(o[2]=__builtin_amdgcn_mfma_f32_32x32x16_bf16(PAF(P,3),VFR(3),o[2],0,0,0), C1,12,pw##N##3[2], (void)0); \
    GB(o[3]=__builtin_amdgcn_mfma_f32_32x32x16_bf16(PAF(P,3),VFR(7),o[3],0,0,0), C1,14,pw##N##3[3], (void)0); \
    l_reg+=sacc; \
    }while(0)
  int t=1;
  #undef CMASK
  #define CMASK(P0,P1,t) do{}while(0)
  for(;t+5<NT;t+=2){
    STEP128(A,B,t,true,true,true);     WAIT_BAR(3); ROT();
    STEP128(B,A,t+1,true,true,true);   WAIT_BAR(3); ROT();
  }
  #undef CMASK
  #define CMASK(P0,P1,t) do{int jb_=(t)-(NT-4); if(jb_>=0)cmask(P0,P1,jb_,qrel,hi);}while(0)
  #define ENDW(tt) do{ if((tt)+3<NT){WAIT_BAR(3);} else if((tt)+2<NT){WAIT_BAR(2);} else {WAIT_BAR(0);} }while(0)
  for(;t+1<NT;t+=2){
    STEP128(A,B,t,(t+3<NT),(t+1<NT),(t+1<NT));       ENDW(t);   ROT();
    STEP128(B,A,t+1,(t+4<NT),(t+2<NT),(t+2<NT));     ENDW(t+1); ROT();
  }
  STEP128(A,B,NT-1,false,false,false);
  bf16*Ow=Ob+(long)(q0+wid*QBLK)*DM;
  u32x4 v1r[2][4]; f32x4v gr[2][2];
  if(comb){
    #pragma unroll
    for(int hf=0;hf<2;++hf){
      #pragma unroll
      for(int i=0;i<4;++i)v1r[hf][i]=*(const u32x4*)(Ow+(long)(i*8+(lane>>3))*DM+hf*64+(lane&7)*8);
      gr[hf][0]=*(const f32x4v*)(gnorm+hf*64+(lane&7)*8); gr[hf][1]=*(const f32x4v*)(gnorm+hf*64+(lane&7)*8+4); } }
  SBAR(); pv4(o,vb0+2*sl_cur,PAF(B,0),PAF(B,1),PAF(B,2),PAF(B,3));
  #undef PKW
  #undef PAF
  #undef VFR
  #undef PIN
  #undef EX
  #undef VRD
  #undef VRD2
  #undef KRD
  #undef QKG
  #undef GB
  #undef STEP128
  #undef ENDW
  {auto rr=__builtin_amdgcn_permlane32_swap(__float_as_uint(l_reg),__float_as_uint(l_reg),false,false);l_reg=__uint_as_float(rr[0])+__uint_as_float(rr[1]);}
  if(hi==0)wsf[32+r32]=l_reg;asm volatile("s_waitcnt lgkmcnt(0)":::"memory");
  float rli[16];
  #pragma unroll
  for(int r=0;r<16;++r)rli[r]=__builtin_amdgcn_rcpf(wsf[32+crow(r,hi)]);
  if(!comb){
  #pragma unroll
  for(int hf=0;hf<2;++hf){ bf16*stg=(bf16*)(shm+LDS128_OST)+wid*2048;
    #pragma unroll
    for(int r=0;r<16;++r){const int orow=crow(r,hi);
      #pragma unroll
      for(int d0=0;d0<2;++d0)stg[orow*64+d0*32+r32]=__float2bfloat16(o[2*hf+d0][r]*rli[r]);}
    asm volatile("s_waitcnt lgkmcnt(0)":::"memory");
    #pragma unroll
    for(int i=0;i<4;++i){const int row=i*8+(lane>>3),ch=lane&7; const u32x4 v=*(const u32x4*)(stg+row*64+ch*8); ATTN_STORE16(Ow+(long)row*DM+hf*64+ch*8,v);}
    asm volatile("s_waitcnt lgkmcnt(0)":::"memory"); }
  } else {
    unsigned char*Ocw=Oc+(long)(q0+wid*QBLK)*DM;
    float dd[2][4][8]; float ss[4]={0.f,0.f,0.f,0.f}; const float lam=*lamp;
    #pragma unroll
    for(int hf=0;hf<2;++hf){ bf16*stg=(bf16*)(shm+LDS128_OST)+wid*2048;
      #pragma unroll
      for(int r=0;r<16;++r){const int orow=crow(r,hi);
        #pragma unroll
        for(int d0=0;d0<2;++d0)stg[orow*64+d0*32+r32]=__float2bfloat16(o[2*hf+d0][r]*rli[r]);}
      asm volatile("s_waitcnt lgkmcnt(0)":::"memory");
      #pragma unroll
      for(int i=0;i<4;++i){const int row=i*8+(lane>>3),ch=lane&7; const u32x4 v2=*(const u32x4*)(stg+row*64+ch*8); const u32x4 v1=v1r[hf][i];
        #pragma unroll
        for(int k=0;k<4;++k){ const float a0=__uint_as_float(v1[k]<<16),a1=__uint_as_float(v1[k]&0xffff0000u),b0=__uint_as_float(v2[k]<<16),b1=__uint_as_float(v2[k]&0xffff0000u);
          const float d0_=a0-b0*lam,d1_=a1-b1*lam; dd[hf][i][2*k]=d0_; dd[hf][i][2*k+1]=d1_; ss[i]+=d0_*d0_; ss[i]+=d1_*d1_; } }
      asm volatile("s_waitcnt lgkmcnt(0)":::"memory"); }
    float gg[2][8];
    #pragma unroll
    for(int hf=0;hf<2;++hf){ const f32x4v g0=gr[hf][0], g1=gr[hf][1];
      #pragma unroll
      for(int k=0;k<4;++k){gg[hf][k]=g0[k]*post;gg[hf][4+k]=g1[k]*post;} }
    #pragma unroll
    for(int i=0;i<4;++i){ float s_=ss[i];
      s_+=__uint_as_float((unsigned)__builtin_amdgcn_ds_bpermute((lane^1)<<2,(int)__float_as_uint(s_)));
      s_+=__uint_as_float((unsigned)__builtin_amdgcn_ds_bpermute((lane^2)<<2,(int)__float_as_uint(s_)));
      s_+=__uint_as_float((unsigned)__builtin_amdgcn_ds_bpermute((lane^4)<<2,(int)__float_as_uint(s_)));
      const float rn=1.0f/sqrtf(s_*(1.0f/128.0f)+eps);
      const int row=i*8+(lane>>3),ch=lane&7;
      #pragma unroll
      for(int hf=0;hf<2;++hf){ float e[8];
        #pragma unroll
        for(int k=0;k<8;++k)e[k]=dd[hf][i][k]*rn*gg[hf][k];
        unsigned w0=__builtin_amdgcn_cvt_pk_fp8_f32(e[0],e[1],0u,false); w0=__builtin_amdgcn_cvt_pk_fp8_f32(e[2],e[3],w0,true);
        unsigned w1=__builtin_amdgcn_cvt_pk_fp8_f32(e[4],e[5],0u,false); w1=__builtin_amdgcn_cvt_pk_fp8_f32(e[6],e[7],w1,true);
        *(u32x2v*)(Ocw+(long)row*DM+hf*64+ch*8)=(u32x2v){w0,w1}; } }
  }
  asm volatile("s_waitcnt lgkmcnt(0)\n\ts_barrier":::"memory");
  #undef DMA_K
  #undef DMA_V
  #undef CMASK
  #undef ROT
}
constexpr int ATTN_LDS_BYTES=LDS_BYTES;
#undef SBAR
#undef WAIT_BAR
}


#ifndef CONV_PER_WAVE
#define CONV_PER_WAVE 6
#endif
#ifndef ABLP
#define ABLP 0
#endif
#ifndef REP_ATTN
#define REP_ATTN 1
#endif
#ifndef REP_P1
#define REP_P1 1
#endif
#ifndef REP_P3
#define REP_P3 1
#endif
#ifndef REP_P5
#define REP_P5 1
#endif
#ifndef REP_P6
#define REP_P6 1
#endif
#ifndef REP_LN1
#define REP_LN1 1
#endif
#ifndef REP_LN2
#define REP_LN2 1
#endif
#ifndef REP_COMB
#define REP_COMB 1
#endif
#ifndef REP_BAR
#define REP_BAR 1
#endif
#ifndef REP_FILL
#define REP_FILL 1
#endif
#ifndef DRY_REP
#define DRY_REP 0
#endif
#ifndef REP_ATTN_FOX
#define REP_ATTN_FOX REP_ATTN
#endif
#ifndef PROBE_NODOT
#define PROBE_NODOT 0
#endif
#ifndef REP_CONV
#define REP_CONV 1
#endif
#ifndef REP_P0B
#define REP_P0B 1
#endif
#ifndef REP_P0
#define REP_P0 1
#endif
#ifndef MK_PER_PHASE
#define MK_PER_PHASE 0
#endif
constexpr int NWAVES = 8;
constexpr int NB = 8, SEQ = 4096, DM = 1024, NT = NB * SEQ;
constexpr int NPH = 2 + 8 * 4;
constexpr float ALPHA = 1.6817928305074292f;
constexpr float LN_EPS = 1e-5f;
constexpr float LOG2E = 1.4426950408889634f;
constexpr float QSCALE = 0.125f * LOG2E;
constexpr float W1SCALE = 32.0f, W2SCALE = 64.0f, ASCALE = 4.0f, WQK = 32.0f, WV = 64.0f, OSC = 4.0f, YSC = 8.0f, DNSC = 16.0f;

typedef unsigned short bf16;
typedef float f32x4 __attribute__((ext_vector_type(4)));
typedef float f32x2 __attribute__((ext_vector_type(2)));
typedef unsigned u32x4 __attribute__((ext_vector_type(4)));
typedef unsigned u32x2 __attribute__((ext_vector_type(2)));

typedef const __attribute__((address_space(4))) unsigned char* kaptr;
#define INP(k) (*(const float* const __attribute__((address_space(4)))*)(ka + 8 * (k)))
constexpr size_t MiB = 1u << 20;
constexpr size_t WS_CTL = 0, CTL_ZERO_BYTES = 1 * MiB;
constexpr size_t WS_MOD = 1 * MiB;
constexpr size_t WS_KVMOD = WS_MOD + 768 * 1024;
constexpr size_t WS_BT = WS_MOD + 896 * 1024;
constexpr size_t WS_LC = 2 * MiB;
constexpr size_t WS_TOK = 4 * MiB;
constexpr size_t WS_PERM = 5 * MiB;
constexpr size_t WS_GWT = 7 * MiB;
constexpr size_t WS_FOXIN = 10 * MiB, WS_FOXO = 22 * MiB, WS_KVW = 26 * MiB, WS_DQ = 30 * MiB, WS_DO = 34 * MiB, WS_MOE1 = 38 * MiB, WS_MOE2 = 70 * MiB;
constexpr size_t WS_ACT = 86 * MiB, ACT_BYTES = 64 * MiB;
constexpr size_t WS_END = WS_ACT + 6 * ACT_BYTES;
constexpr int CW_TMO = 0;
constexpr int CW_BAR = 4096;
constexpr int CW_QUEUE = 190000;
constexpr int CW_NORM = 210000, CW_KVN = CW_NORM + 4096;
constexpr int CW_CNT = 200000;
constexpr int RING_BYTES = 131072, LDSCTL_OFF = 141312  , MISC_OFF = LDSCTL_OFF + 320, MOETAB_OFF = LDSCTL_OFF + 1024, PARK_OFF = LDSCTL_OFF + 2048  , NORML_OFF = LDSCTL_OFF + 10240  , QW_OFF = LDSCTL_OFF + 512, LDS_BYTES = LDSCTL_OFF + 16384;

#define RLX_AGENT __ATOMIC_RELAXED, __HIP_MEMORY_SCOPE_AGENT
__device__ __forceinline__ unsigned pk2(float lo, float hi) { return pg8::cvt_pk_bf16(lo, hi); }
__device__ __forceinline__ f32x4 unpack4(u32x2 w) { f32x4 r; r.x = __uint_as_float(w.x << 16); r.y = __uint_as_float(w.x & 0xffff0000u); r.z = __uint_as_float(w.y << 16); r.w = __uint_as_float(w.y & 0xffff0000u); return r; }
__device__ __forceinline__ f32x4 unpack4_fp8(unsigned w) { const f32x2 lo = __builtin_amdgcn_cvt_pk_f32_fp8((int)w, false), hi = __builtin_amdgcn_cvt_pk_f32_fp8((int)w, true); return (f32x4){lo.x, lo.y, hi.x, hi.y}; }
__device__ __forceinline__ float xshfl(float v, int m, int lane) { return __uint_as_float((unsigned)__builtin_amdgcn_ds_bpermute((lane ^ m) << 2, (int)__float_as_uint(v))); }
__device__ __forceinline__ float wave_sum(float v, int lane) {
#pragma unroll
    for (int o = 1; o < 64; o <<= 1) v += xshfl(v, o, lane);
    return v;
}

#define XB_TMO      128
#define XB_XCNT(j)  (256  + 64 * (j))
#define XB_XSUB(j)  (1280 + 64 * (j))
#define XB_XGEN(j)  (2304 + 64 * (j))
#define XB_TOP      3328
#define XB_TOPGEN   3392
#define XCD_BAR_WORDS 3456
#define XB_SPIN_CAP (1u << 18)

__device__ __forceinline__ unsigned xb_ld(unsigned* p)              { return __hip_atomic_load(p, __ATOMIC_RELAXED, __HIP_MEMORY_SCOPE_AGENT); }
__device__ __forceinline__ unsigned xb_add(unsigned* p, unsigned v) { return __hip_atomic_fetch_add(p, v, __ATOMIC_RELAXED, __HIP_MEMORY_SCOPE_AGENT); }
__device__ __forceinline__ unsigned xb_xcc_id() { return (unsigned)__builtin_amdgcn_s_getreg((3 << 11) | 20) & 0xFu; }
#define XB_SPIN(cond, bar) do { unsigned _sp = 0; while (cond) { __builtin_amdgcn_s_sleep(1); \
    if ((++_sp & 255u) == 0u) { if (xb_ld(&(bar)[XB_TMO])) break; if (_sp > XB_SPIN_CAP) { atomicAdd(&(bar)[XB_TMO], 1u); break; } } } } while (0)

struct XcdBarrier {
    unsigned* bar; unsigned x;
    volatile LAS unsigned* st;
};

__device__ __forceinline__ XcdBarrier xcd_barrier_post(unsigned* bar, volatile LAS unsigned* st) {
    XcdBarrier b; b.bar = bar; b.x = xb_xcc_id(); b.st = st;
    if (threadIdx.x == 0) (void)xb_add(&bar[XB_XCNT(b.x)], 1u);
    return b;
}
__device__ __forceinline__ void xcd_barrier_complete(unsigned* bar, unsigned x, unsigned& nloc, unsigned& nx) {
    const unsigned G = gridDim.x * gridDim.y * gridDim.z;
    unsigned sum, cnt, mine, sp = 0u;
    for (;;) {
        sum = 0u; cnt = 0u; mine = 0u;
#pragma unroll
        for (unsigned j = 0; j < 16; ++j) { const unsigned c = xb_ld(&bar[XB_XCNT(j)]); sum += c; cnt += (c > 0u) ? 1u : 0u; mine = (j == x) ? c : mine; }
        if (sum == G) break;
        __builtin_amdgcn_s_sleep(1);
        if ((++sp & 255u) == 0u) { if (xb_ld(&bar[XB_TMO])) break; if (sp > XB_SPIN_CAP) { atomicAdd(&bar[XB_TMO], 1u); break; } }
    }
    nloc = mine > 0u ? mine : 1u; nx = cnt > 0u ? cnt : 1u;
}

__device__ __forceinline__ void xcd_barrier(const XcdBarrier& b) {
    asm volatile("s_waitcnt vmcnt(0)" ::: "memory");
    __syncthreads();
    if (threadIdx.x == 0) {
        unsigned* bar = b.bar;
        __builtin_amdgcn_s_waitcnt(0);
        unsigned nloc = b.st[0], nx = b.st[1];
        if (nloc == 0u) { xcd_barrier_complete(bar, b.x, nloc, nx); b.st[0] = nloc; b.st[1] = nx; }
        const unsigned old = xb_add(&bar[XB_XSUB(b.x)], 1u);
        const unsigned gen = old / nloc;
        if (old + 1u == (gen + 1u) * nloc) {
            __builtin_amdgcn_fence(__ATOMIC_RELEASE, "agent");
            asm volatile("s_waitcnt vmcnt(0)" ::: "memory");
            const unsigned og = xb_add(&bar[XB_TOP], 1u);
            const unsigned tg = og / nx;
            if (og + 1u == (tg + 1u) * nx) xb_add(&bar[XB_TOPGEN], 1u);
            else XB_SPIN(xb_ld(&bar[XB_TOPGEN]) == tg, bar);
            __builtin_amdgcn_fence(__ATOMIC_ACQUIRE, "agent");
            xb_add(&bar[XB_XGEN(b.x)], 1u);
            asm volatile("s_waitcnt vmcnt(0)" ::: "memory");
        } else {
            XB_SPIN(xb_ld(&bar[XB_XGEN(b.x)]) == gen, bar);
            __builtin_amdgcn_fence(__ATOMIC_ACQUIRE, "agent");
            asm volatile("s_waitcnt vmcnt(0)" ::: "memory");
        }
    }
    __syncthreads();
}

__device__ __forceinline__ void transpose_item(const float* W, int ld, int K, bf16* WT, int drow0, int k0, int n0, LAS float* scr, int lane, float qs) {
#pragma unroll 8
    for (int i = 0; i < 32; ++i) { const int kk = 2 * i + (lane >> 5); scr[kk * 33 + (lane & 31)] = W[(size_t)(k0 + kk) * ld + n0 + (lane & 31)]; (void)qs; }
    asm volatile("s_waitcnt lgkmcnt(0)" ::: "memory");
    const int c = lane & 7;
#pragma unroll
    for (int j = 0; j < 4; ++j) { const int n = (lane >> 3) + 8 * j; const LAS float* s = scr + (8 * c) * 33 + n;
        u32x4 o; o.x = pk2(s[0 * 33], s[1 * 33]); o.y = pk2(s[2 * 33], s[3 * 33]); o.z = pk2(s[4 * 33], s[5 * 33]); o.w = pk2(s[6 * 33], s[7 * 33]);
        *(u32x4*)(WT + (size_t)(drow0 + n) * K + k0 + 8 * c) = o; }
    asm volatile("s_waitcnt lgkmcnt(0)" ::: "memory");
}

__device__ __forceinline__ void transpose_item_fp8(const float* W, int ld, int K, unsigned char* WT, int drow0, int k0, int n0, LAS float* scr, int lane, float scale) {
#pragma unroll 8
    for (int i = 0; i < 32; ++i) { const int kk = 2 * i + (lane >> 5); scr[kk * 33 + (lane & 31)] = __builtin_nontemporal_load(W + (size_t)(k0 + kk) * ld + n0 + (lane & 31)) * scale; }
    asm volatile("s_waitcnt lgkmcnt(0)" ::: "memory");
    const int c = lane & 7;
#pragma unroll
    for (int j = 0; j < 4; ++j) { const int n = (lane >> 3) + 8 * j; const LAS float* s = scr + (8 * c) * 33 + n;
        u32x2 o; o.x = pg8::pk4_fp8(s[0 * 33], s[1 * 33], s[2 * 33], s[3 * 33]); o.y = pg8::pk4_fp8(s[4 * 33], s[5 * 33], s[6 * 33], s[7 * 33]);
        *(u32x2*)(WT + (size_t)(drow0 + n) * K + k0 + 8 * c) = o; }
    asm volatile("s_waitcnt lgkmcnt(0)" ::: "memory");
}

__device__ __forceinline__ void p0_prologue(LAS unsigned char* L, kaptr ka, unsigned char* ws, int tid, int lane, int wave, int bx, int G, int vcu) {
    LAS float* sc = (LAS float*)L;
    LAS float* part = (LAS float*)(L + 32768);
    const float* cin = INP(1);
    for (int i = tid; i < NB * DM; i += NWAVES * 64) { const float v = cin[i]; sc[i] = v / (1.0f + __expf(-v)); }
    __syncthreads();
    for (int task = bx; task < 208; task += G) {
        const float* W; const float* bias; float* out; int ld, n0;
        if (task < 192) { const int l = task / 48, ch = task % 48; W = INP(2) + (size_t)l * DM * 6144; ld = 6144; n0 = ch * 128; bias = INP(3) + l * 6144; out = (float*)(ws + WS_MOD) + (size_t)l * NB * 6144; }
        else { const int ch = task - 192; W = INP(11); ld = 2048; n0 = ch * 128; bias = INP(12); out = (float*)(ws + WS_KVMOD); }
        float acc[8][2];
#pragma unroll
        for (int b = 0; b < 8; ++b) { acc[b][0] = 0.f; acc[b][1] = 0.f; }
        const float* wp = W + (size_t)(wave * 128) * ld + n0 + 2 * lane;
        for (int k4 = 0; k4 < 32; ++k4) {
            f32x2 wv[4];
#pragma unroll
            for (int kk = 0; kk < 4; ++kk) wv[kk] = __builtin_nontemporal_load((const f32x2*)(wp + (size_t)(4 * k4 + kk) * ld));
#pragma unroll
            for (int b = 0; b < 8; ++b) { const f32x4 s = *(const LAS f32x4*)(sc + b * DM + wave * 128 + 4 * k4);
#pragma unroll
                for (int kk = 0; kk < 4; ++kk) { acc[b][0] += s[kk] * wv[kk].x; acc[b][1] += s[kk] * wv[kk].y; } }
        }
#pragma unroll
        for (int b = 0; b < 8; ++b) *(LAS f32x2*)(part + (wave * 8 + b) * 128 + 2 * lane) = (f32x2){acc[b][0], acc[b][1]};
        __syncthreads();
        for (int o = tid; o < 8 * 128; o += NWAVES * 64) { const int b = o >> 7, col = o & 127; float s = bias[n0 + col];
#pragma unroll
            for (int w = 0; w < 8; ++w) s += part[(w * 8 + b) * 128 + col];
            out[(size_t)b * ld + n0 + col] = s; }
        __syncthreads();
    }
    __syncthreads();
    LAS float* scr = (LAS float*)(L + wave * 16384);
    const int gw = vcu * NWAVES + wave, NGW = G * NWAVES;
    constexpr int I_IN = 16 * 96, I_SQ = 16 * 32, I_KV = 16 * 64;
#define HEADPERM(n0) (((n0) & ~255) + 128 * ((((n0) & 255) & 63) >> 5) + 32 * (((n0) & 255) >> 6))
    constexpr int NITEMS = 2 * I_IN + 2 * I_SQ + I_KV + 2 * I_SQ + 2 * I_SQ;
    for (int it = gw; it < NITEMS; it += NGW) {
        int r = it;
        if (r < 2 * I_IN) { const int l = r / I_IN; r %= I_IN; transpose_item_fp8(INP(8) + (size_t)l * DM * 3088, 3088, DM, (unsigned char*)(ws + WS_FOXIN) + (size_t)l * 3072 * DM, HEADPERM(32 * (r % 96)), 64 * (r / 96), 32 * (r % 96), scr, lane, (r % 96) < 64 ? WQK : WV); continue; } r -= 2 * I_IN;
        if (r < 2 * I_SQ) { const int l = r / I_SQ; r %= I_SQ; transpose_item_fp8(INP(10) + (size_t)l * DM * DM, DM, DM, (unsigned char*)(ws + WS_FOXO) + (size_t)l * DM * DM, 32 * (r % 32), 64 * (r / 32), 32 * (r % 32), scr, lane, WV); continue; } r -= 2 * I_SQ;
        if (r < I_KV) { transpose_item_fp8(INP(13), 2048, DM, (unsigned char*)(ws + WS_KVW), HEADPERM(32 * (r % 64)), 64 * (r / 64), 32 * (r % 64), scr, lane, (r % 64) < 32 ? WQK : WV); continue; } r -= I_KV;
        if (r < 2 * I_SQ) { const int l = r / I_SQ; r %= I_SQ; transpose_item_fp8(INP(14) + (size_t)l * DM * DM, DM, DM, (unsigned char*)(ws + WS_DQ) + (size_t)l * DM * DM, HEADPERM(32 * (r % 32)), 64 * (r / 32), 32 * (r % 32), scr, lane, WQK); continue; } r -= 2 * I_SQ;
        { const int l = r / I_SQ; r %= I_SQ; transpose_item_fp8(INP(17) + (size_t)l * DM * DM, DM, DM, (unsigned char*)(ws + WS_DO) + (size_t)l * DM * DM, 32 * (r % 32), 64 * (r / 32), 32 * (r % 32), scr, lane, WV); }
    }
}
__device__ __forceinline__ void transpose_item_fp8_deep(const float* W, int ld, int K, unsigned char* WT, int drow0, int k0, int n0, LAS float* scr, int lane, float scale) {
    float v[32];
#pragma unroll
    for (int i = 0; i < 32; ++i) v[i] = __builtin_nontemporal_load(W + (size_t)(k0 + 2 * i + (lane >> 5)) * ld + n0 + (lane & 31));
#pragma unroll
    for (int i = 0; i < 32; ++i) scr[(2 * i + (lane >> 5)) * 33 + (lane & 31)] = v[i] * scale;
    asm volatile("s_waitcnt lgkmcnt(0)" ::: "memory");
    const int c = lane & 7;
#pragma unroll
    for (int j = 0; j < 4; ++j) { const int n = (lane >> 3) + 8 * j; const LAS float* s = scr + (8 * c) * 33 + n;
        u32x2 o; o.x = pg8::pk4_fp8(s[0 * 33], s[1 * 33], s[2 * 33], s[3 * 33]); o.y = pg8::pk4_fp8(s[4 * 33], s[5 * 33], s[6 * 33], s[7 * 33]);
        *(u32x2*)(WT + (size_t)(drow0 + n) * K + k0 + 8 * c) = o; }
    asm volatile("s_waitcnt lgkmcnt(0)" ::: "memory");
}
__device__ __forceinline__ void moe_convert_item(LAS float* scr, kaptr ka, unsigned char* ws, int l, int lane, int wave, int G, int vcu, int k) {
    const int it = vcu * NWAVES + wave + k * (G * NWAVES);
    const int which = it >> 12, e = (it >> 8) & 15, r = it & 255;
    if (which < 2) { const int kb = r >> 4, nb = r & 15, n0 = 32 * nb;
        transpose_item_fp8_deep((which == 0 ? INP(20) : INP(21)) + (size_t)(l * 16 + e) * DM * 512, 512, DM, (unsigned char*)(ws + WS_MOE1) + (size_t)e * DM * DM, (n0 >> 7) * 256 + (n0 & 127) + which * 128, 64 * kb, n0, scr, lane, W1SCALE); }
    else { const int kb = r >> 5, nb = r & 31;
        transpose_item_fp8_deep(INP(22) + (size_t)(l * 16 + e) * 512 * DM, DM, 512, (unsigned char*)(ws + WS_MOE2) + (size_t)e * DM * 512, 32 * nb, 64 * kb, 32 * nb, scr, lane, W2SCALE); }
}
__device__ __forceinline__ void moe_weight_copies(LAS unsigned char* L, kaptr ka, unsigned char* ws, int l, int lane, int wave, int G, int vcu) {
    LAS float* scr = (LAS float*)(L + wave * 16384);
    const int gw = vcu * NWAVES + wave, NGW = G * NWAVES;
    for (int it = gw; it < 12288; it += NGW) {
        const int which = it >> 12, e = (it >> 8) & 15, r = it & 255;
        if (which < 2) { const int kb = r >> 4, nb = r & 15, n0 = 32 * nb;
            transpose_item_fp8((which == 0 ? INP(20) : INP(21)) + (size_t)(l * 16 + e) * DM * 512, 512, DM, (unsigned char*)(ws + WS_MOE1) + (size_t)e * DM * DM, (n0 >> 7) * 256 + (n0 & 127) + which * 128, 64 * kb, n0, scr, lane, W1SCALE); }
        else { const int kb = r >> 5, nb = r & 31;
            transpose_item_fp8(INP(22) + (size_t)(l * 16 + e) * 512 * DM, DM, 512, (unsigned char*)(ws + WS_MOE2) + (size_t)e * DM * 512, 32 * nb, 64 * kb, 32 * nb, scr, lane, W2SCALE); }
    }
}

__device__ __forceinline__ void route16(const float (&lg)[16], const LAS float* rb, int& e0, int& e1, float& w0, float& w1) {
    float mx = lg[0];
#pragma unroll
    for (int e = 1; e < 16; ++e) mx = fmaxf(mx, lg[e]);
    float p[16], sum = 0.f;
#pragma unroll
    for (int e = 0; e < 16; ++e) { p[e] = __expf(lg[e] - mx); sum += p[e]; }
    const float inv = 1.0f / sum;
    int be0 = 0, be1 = 1; float bp0 = 0.f, bp1 = 0.f, gbest = -INFINITY;
#pragma unroll
    for (int g = 0; g < 4; ++g) {
        float a[4], q[4];
#pragma unroll
        for (int i = 0; i < 4; ++i) { q[i] = p[4 * g + i] * inv; a[i] = q[i] + rb[4 * g + i]; }
        int i0 = 0; float v0 = a[0], q0 = q[0];
#pragma unroll
        for (int i = 1; i < 4; ++i) if (a[i] > v0) { v0 = a[i]; i0 = i; q0 = q[i]; }
        int i1 = 0; float v1 = -INFINITY, q1 = 0.f;
#pragma unroll
        for (int i = 0; i < 4; ++i) if (i != i0 && a[i] > v1) { v1 = a[i]; i1 = i; q1 = q[i]; }
        const float gs = v0 + v1;
        if (gs > gbest) { gbest = gs; be0 = 4 * g + i0; be1 = 4 * g + i1; bp0 = q0; bp1 = q1; }
    }
    e0 = be0; e1 = be1; const float ws_ = 1.0f / (bp0 + bp1); w0 = bp0 * ws_; w1 = bp1 * ws_;
}

struct RowsCfg {
    const float* xin_f32; const bf16* xin_bf;
    bf16* xout_bf; float* xout_f32;
    const unsigned char* src; float src_inv;
    const float* gate; const float* gamma; const float* beta;
    const float* sc; const float* sh; bf16* hout; int hout_fp8;
    const float* sc2; const float* sh2; bf16* hout2;
    const float* w16; int w16_ld; int dotmode;
    const float* rb;
    unsigned* cnt; int* perm; float* gwt; unsigned* tokslot;
    float* lc; float* bt;
};
template <int MODE, bool XF32>
__device__ __forceinline__ void rows_load(f32x4 (&xf)[4], u32x4 (&xb)[2], u32x2 (&s0)[2], u32x2 (&s1)[2], const RowsCfg& c, int row, int slot0, int slot1, int lane) {
    if (XF32) { const f32x4* xr = (const f32x4*)(c.xin_f32 + (size_t)row * DM) + 2 * lane;
#pragma unroll
        for (int q = 0; q < 4; ++q) xf[q] = xr[128 * (q >> 1) + (q & 1)]; }
    else { const u32x4* xr = (const u32x4*)(c.xin_bf + (size_t)row * DM) + lane;
#pragma unroll
        for (int j = 0; j < 2; ++j) xb[j] = xr[64 * j]; }
    if (MODE == 1) { const u32x2* yr = (const u32x2*)(c.src + (size_t)row * DM) + lane;
#pragma unroll
        for (int j = 0; j < 2; ++j) s0[j] = yr[64 * j]; }
    if (MODE == 2) { const u32x2* r0 = (const u32x2*)(c.src + (size_t)slot0 * DM) + lane; const u32x2* r1 = (const u32x2*)(c.src + (size_t)slot1 * DM) + lane;
#pragma unroll
        for (int j = 0; j < 2; ++j) { s0[j] = r0[64 * j]; s1[j] = r1[64 * j]; } }
}
template <int MODE, bool XF32>
__device__ __forceinline__ void rows_phase(LAS unsigned char* L, const RowsCfg& c, int tid, int lane, int wave, int bx) {
    LAS u32x4* WB = (LAS u32x4*)L;
    LAS u32x4* ST = (LAS u32x4*)(L + 32768 + wave * 8192);
    LAS f32x4* VEC = (LAS f32x4*)(L + 98304);
    LAS float* LF = (LAS float*)(L + 126976);
    LAS int* RE = (LAS int*)(L + 135168);
    LAS float* RW = (LAS float*)(L + 136192);
    LAS int* LP = (LAS int*)(L + 137216);
    LAS int* HIST = (LAS int*)(L + 138240);
    LAS int* GB = HIST + 16; LAS int* OFF = HIST + 32; LAS float* RB = (LAS float*)(HIST + 48);
    LAS float* LG2 = (LAS float*)(L + 126976);
    if (tid < 256) {
        if (MODE != 0) { VEC[0 * 256 + tid] = (((const f32x4*)c.gate)[tid] + 1.0f) * c.src_inv;     VEC[1 * 256 + tid] = ((const f32x4*)c.gamma)[tid]; VEC[2 * 256 + tid] = ((const f32x4*)c.beta)[tid]; }
        if (c.hout) { VEC[3 * 256 + tid] = ((const f32x4*)c.sc)[tid]; VEC[4 * 256 + tid] = ((const f32x4*)c.sh)[tid]; }
        if (c.hout2) { VEC[5 * 256 + tid] = ((const f32x4*)c.sc2)[tid]; VEC[6 * 256 + tid] = ((const f32x4*)c.sh2)[tid]; }
    }
    if (tid < 16) { HIST[tid] = 0; if (c.dotmode) RB[tid] = c.rb[tid]; }
    if (MODE == 2 && tid < 16) GB[tid] = (int)__hip_atomic_load(c.cnt + tid, RLX_AGENT);
    if (c.dotmode) for (int idx = tid; idx < 2048; idx += NWAVES * 64) { const int s = idx >> 6, ln = idx & 63, e = ln & 15, k0 = 32 * s + 8 * (ln >> 4); float w[8];
#pragma unroll
        for (int j = 0; j < 8; ++j) w[j] = c.w16[(size_t)(k0 + j) * c.w16_ld + e];
        WB[idx] = (u32x4){pk2(w[0], w[1]), pk2(w[2], w[3]), pk2(w[4], w[5]), pk2(w[6], w[7])}; }
    __syncthreads();
    if (MODE == 2) { if (tid == 0) { int so = 0;
#pragma unroll
        for (int e = 0; e < 16; ++e) { OFF[e] = so; so += GB[e]; } }
        __syncthreads(); }
    const int rowb = bx * 128 + wave * 16;
#define VQ(vec, q) VEC[(vec) * 256 + 2 * lane + 128 * ((q) >> 1) + ((q) & 1)]
    int myslot = 0; float myw = 0.f;
    if (MODE == 2) { const unsigned t = c.tokslot[rowb * 2 + (lane & 31)]; myslot = OFF[t >> 16] + (int)(t & 0xffffu); myw = c.gwt[rowb * 2 + (lane & 31)]; }
#define ROWS_SLOT(r, k) (MODE == 2 ? __builtin_amdgcn_readlane(myslot, 2 * (r) + (k)) : 0)
    auto compute = [&](f32x4 (&Bxf)[2][4], u32x4 (&Bxb)[2][2], u32x2 (&Bs0)[2][2], u32x2 (&Bs1)[2][2], const int g, const bool mma) __attribute__((always_inline)) {
        f32x4 hv[2][4];
#pragma unroll
        for (int rr = 0; rr < 2; ++rr) {
            const int row = rowb + 2 * g + rr;
            f32x4 v[4];
#pragma unroll
            for (int q = 0; q < 4; ++q) { if (XF32) v[q] = Bxf[rr][q]; else { const u32x4 w = Bxb[rr][q >> 1]; v[q] = (q & 1) ? unpack4((u32x2){w.z, w.w}) : unpack4((u32x2){w.x, w.y}); } }
            if (MODE != 0) {
                float gw0 = 1.f, gw1 = 1.f; if (MODE == 2) { gw0 = __uint_as_float(__builtin_amdgcn_readlane(__float_as_uint(myw), 2 * (2 * g + rr))); gw1 = __uint_as_float(__builtin_amdgcn_readlane(__float_as_uint(myw), 2 * (2 * g + rr) + 1)); }
                float sm = 0.f;
#pragma unroll
                for (int q = 0; q < 4; ++q) { const unsigned w0 = (q & 1) ? Bs0[rr][q >> 1].y : Bs0[rr][q >> 1].x; f32x4 s = unpack4_fp8(w0);
                    if (MODE == 2) { const unsigned w1 = (q & 1) ? Bs1[rr][q >> 1].y : Bs1[rr][q >> 1].x; s = s * gw0 + unpack4_fp8(w1) * gw1; }
                    const f32x4 gt = VQ(0, q); v[q] = v[q] * ALPHA + gt * s; sm += (v[q].x + v[q].y) + (v[q].z + v[q].w); }
                const float mean = wave_sum(sm, lane) * (1.0f / DM); float s2 = 0.f;
#pragma unroll
                for (int q = 0; q < 4; ++q) { v[q] = v[q] - mean; s2 += (v[q].x * v[q].x + v[q].y * v[q].y) + (v[q].z * v[q].z + v[q].w * v[q].w); }
                const float rstd = 1.0f / sqrtf(wave_sum(s2, lane) * (1.0f / DM) + LN_EPS);
#pragma unroll
                for (int q = 0; q < 4; ++q) v[q] = v[q] * rstd * VQ(1, q) + VQ(2, q);
                if (c.xout_f32) { f32x4* xo = (f32x4*)(c.xout_f32 + (size_t)row * DM) + 2 * lane;
#pragma unroll
                    for (int q = 0; q < 4; ++q) xo[128 * (q >> 1) + (q & 1)] = v[q]; }
                else { u32x4* xo = (u32x4*)(c.xout_bf + (size_t)row * DM) + lane;
#pragma unroll
                    for (int j = 0; j < 2; ++j) xo[64 * j] = (u32x4){pk2(v[2 * j].x, v[2 * j].y), pk2(v[2 * j].z, v[2 * j].w), pk2(v[2 * j + 1].x, v[2 * j + 1].y), pk2(v[2 * j + 1].z, v[2 * j + 1].w)}; }
            }
            if (c.hout) { u32x2* ho = (u32x2*)((unsigned char*)c.hout + (size_t)row * DM) + lane;
#pragma unroll
                for (int q = 0; q < 4; ++q) hv[rr][q] = v[q] * (VQ(3, q) + 1.0f) + VQ(4, q);
#pragma unroll
                for (int j = 0; j < 2; ++j) ho[64 * j] = (u32x2){pg8::pk4_fp8(hv[rr][2 * j].x, hv[rr][2 * j].y, hv[rr][2 * j].z, hv[rr][2 * j].w), pg8::pk4_fp8(hv[rr][2 * j + 1].x, hv[rr][2 * j + 1].y, hv[rr][2 * j + 1].z, hv[rr][2 * j + 1].w)}; }
            if (c.hout2) { u32x2* ho = (u32x2*)((unsigned char*)c.hout2 + (size_t)row * DM) + lane;
#pragma unroll
                for (int j = 0; j < 2; ++j) { const f32x4 ha = v[2 * j] * (VQ(5, 2 * j) + 1.0f) + VQ(6, 2 * j), hb = v[2 * j + 1] * (VQ(5, 2 * j + 1) + 1.0f) + VQ(6, 2 * j + 1);
                    ho[64 * j] = (u32x2){pg8::pk4_fp8(ha.x, ha.y, ha.z, ha.w), pg8::pk4_fp8(hb.x, hb.y, hb.z, hb.w)}; } }
        }
        if (c.dotmode) {
#pragma unroll
            for (int rr = 0; rr < 2; ++rr)
#pragma unroll
                for (int j = 0; j < 2; ++j) ST[(2 * (g & 1) + rr) * 128 + lane + 64 * j] = (u32x4){pk2(hv[rr][2 * j].x, hv[rr][2 * j].y), pk2(hv[rr][2 * j].z, hv[rr][2 * j].w), pk2(hv[rr][2 * j + 1].x, hv[rr][2 * j + 1].y), pk2(hv[rr][2 * j + 1].z, hv[rr][2 * j + 1].w)};
            if (mma) {
                f32x4 acc = {0.f, 0.f, 0.f, 0.f};
                const LAS u32x4* ap = ST + (lane & 3) * 128 + (lane >> 4);
#pragma unroll 8
                for (int s = 0; s < 32; ++s) acc = __builtin_amdgcn_mfma_f32_16x16x32_bf16(__builtin_bit_cast(pg8::bf16x8, ap[4 * s]), __builtin_bit_cast(pg8::bf16x8, WB[64 * s + lane]), acc, 0, 0, 0);
                if (lane < 16) {
#pragma unroll
                    for (int rr = 0; rr < 4; ++rr) { const float tot = acc[rr]; const int rl = wave * 16 + 2 * (g - 1) + rr;
                        if (c.dotmode == 2) { const float z = tot + RB[lane]; LF[rl * 16 + lane] = fminf(z, 0.f) - 0.6931471805599453f * __builtin_amdgcn_logf(1.0f + __builtin_amdgcn_exp2f(-LOG2E * fabsf(z))); }
                        else LG2[rl * 16 + lane] = tot; } }
            }
        }
    };
    f32x4 Axf[2][4], Bxf[2][4]; u32x4 Axb[2][2], Bxb[2][2]; u32x2 As0[2][2], Bs0[2][2], As1[2][2], Bs1[2][2];
#define ROWS_LD(P, rr, r) rows_load<MODE, XF32>(P##xf[rr], P##xb[rr], P##s0[rr], P##s1[rr], c, rowb + (r), ROWS_SLOT((r), 0), ROWS_SLOT((r), 1), lane)
    ROWS_LD(A, 0, 0); ROWS_LD(A, 1, 1);
#pragma unroll 1
    for (int g = 0; g < 8; g += 2) {
        ROWS_LD(B, 0, 2 * g + 2); ROWS_LD(B, 1, 2 * g + 3);
        compute(Axf, Axb, As0, As1, g, false);
        if (g + 2 < 8) { ROWS_LD(A, 0, 2 * g + 4); ROWS_LD(A, 1, 2 * g + 5); }
        compute(Bxf, Bxb, Bs0, Bs1, g + 1, true);
    }
#undef ROWS_LD
#undef ROWS_SLOT
#undef VQ
    if (c.dotmode == 1) {
        asm volatile("s_waitcnt lgkmcnt(0)" ::: "memory");
        if (lane < 16) { float lg[16];
#pragma unroll
            for (int e = 0; e < 16; ++e) lg[e] = LG2[(wave * 16 + lane) * 16 + e];
            int e0, e1; float w0, w1; route16(lg, RB, e0, e1, w0, w1);
            const int rl = wave * 16 + lane;
            RE[rl * 2] = e0; RE[rl * 2 + 1] = e1; RW[rl * 2] = w0; RW[rl * 2 + 1] = w1;
            LP[rl * 2] = __hip_atomic_fetch_add(HIST + e0, 1, __ATOMIC_RELAXED, __HIP_MEMORY_SCOPE_WORKGROUP);
            LP[rl * 2 + 1] = __hip_atomic_fetch_add(HIST + e1, 1, __ATOMIC_RELAXED, __HIP_MEMORY_SCOPE_WORKGROUP); }
    }
    __syncthreads();
    if (c.dotmode == 2) {
        const int b = bx >> 5, blk = bx & 31;
        if (tid < 16) { float run = 0.f;
            for (int i = 0; i < 128; ++i) { run += LF[i * 16 + tid]; LF[i * 16 + tid] = run; }
            c.bt[(b * 16 + tid) * 32 + blk] = run; }
        __syncthreads();
        { const int e = tid >> 5, i0 = 4 * (tid & 31);
          const f32x4 o = {LF[(i0 + 0) * 16 + e], LF[(i0 + 1) * 16 + e], LF[(i0 + 2) * 16 + e], LF[(i0 + 3) * 16 + e]};
          *(f32x4*)(c.lc + (size_t)(b * 16 + e) * SEQ + blk * 128 + i0) = o; }
    }
    if (c.dotmode == 1) {
        if (c.cnt == nullptr) { __syncthreads(); return; }
        if (tid < 16) GB[tid] = (int)__hip_atomic_fetch_add(c.cnt + tid, (unsigned)HIST[tid], RLX_AGENT);
        __syncthreads();
        if (tid < 128) { const int row = bx * 128 + tid;
#pragma unroll
            for (int k = 0; k < 2; ++k) { const int e = RE[tid * 2 + k], pos = GB[e] + LP[tid * 2 + k];
                c.perm[e * 32768 + pos] = row; c.gwt[row * 2 + k] = RW[tid * 2 + k]; c.tokslot[row * 2 + k] = ((unsigned)e << 16) | (unsigned)pos; } }
    }
    __syncthreads();
}

__device__ __forceinline__ void combine_phase(const bf16* O1, const bf16* O2, bf16* O, const float* lamp  , const float* gnorm  , float lam_init, int lane, int wave, int bx) {
    float pa = lamp[lane] * lamp[64 + lane], pb = lamp[128 + lane] * lamp[192 + lane];
    pa = wave_sum(pa, lane); pb = wave_sum(pb, lane);
    const float lam = __expf(pa) - __expf(pb) + lam_init, post = (1.0f - lam_init) * OSC;
    float g[16];
#pragma unroll
    for (int k = 0; k < 16; ++k) g[k] = gnorm[(lane & 7) * 16 + k] * post;
    const int rowb = bx * 128 + wave * 16;
    for (int i = 0; i < 16; ++i) {
        const size_t off = (size_t)(rowb + i) * DM + 16 * lane;
        const u32x4 a0 = *(const u32x4*)(O1 + off), a1 = *(const u32x4*)(O1 + off + 8), b0 = *(const u32x4*)(O2 + off), b1 = *(const u32x4*)(O2 + off + 8);
        float d[16];
        { const f32x4 x0 = unpack4((u32x2){a0.x, a0.y}), x1 = unpack4((u32x2){a0.z, a0.w}), x2 = unpack4((u32x2){a1.x, a1.y}), x3 = unpack4((u32x2){a1.z, a1.w});
          const f32x4 y0 = unpack4((u32x2){b0.x, b0.y}), y1 = unpack4((u32x2){b0.z, b0.w}), y2 = unpack4((u32x2){b1.x, b1.y}), y3 = unpack4((u32x2){b1.z, b1.w});
          const f32x4 r0 = x0 - y0 * lam, r1 = x1 - y1 * lam, r2 = x2 - y2 * lam, r3 = x3 - y3 * lam;
#pragma unroll
          for (int k = 0; k < 4; ++k) { d[k] = r0[k]; d[4 + k] = r1[k]; d[8 + k] = r2[k]; d[12 + k] = r3[k]; } }
        float ss = 0.f;
#pragma unroll
        for (int k = 0; k < 16; ++k) ss += d[k] * d[k];
        ss += xshfl(ss, 1, lane); ss += xshfl(ss, 2, lane); ss += xshfl(ss, 4, lane);
        const float r = 1.0f / sqrtf(ss * (1.0f / 128.0f) + LN_EPS);
        u32x4 w0;
        w0.x = pg8::pk4_fp8(d[0] * r * g[0], d[1] * r * g[1], d[2] * r * g[2], d[3] * r * g[3]); w0.y = pg8::pk4_fp8(d[4] * r * g[4], d[5] * r * g[5], d[6] * r * g[6], d[7] * r * g[7]);
        w0.z = pg8::pk4_fp8(d[8] * r * g[8], d[9] * r * g[9], d[10] * r * g[10], d[11] * r * g[11]); w0.w = pg8::pk4_fp8(d[12] * r * g[12], d[13] * r * g[13], d[14] * r * g[14], d[15] * r * g[15]);
        *(u32x4*)((unsigned char*)O + off) = w0;
    }
}

__device__ __forceinline__ void fill_bias(LAS unsigned char* L, bool fox, const float* lc, const float* bt, float slope, int nkeys, int tid, int lane, int kaoff) {
    LAS u32x4* bias = (LAS u32x4*)(L + kaoff);
    const int s = 8 * tid;
    float pre = 0.f;
    if (fox) { const int blk = tid >> 4; const int l5 = lane & 31; float inc = bt[l5];
        const float own = inc;
#pragma unroll
        for (int o = 1; o < 32; o <<= 1) { const float t = __uint_as_float((unsigned)__builtin_amdgcn_ds_bpermute((lane - o) << 2, (int)__float_as_uint(inc))); inc += (l5 >= o) ? t : 0.f; }
        pre = __uint_as_float((unsigned)__builtin_amdgcn_ds_bpermute(blk << 2, (int)__float_as_uint(inc - own))); }
    if (s < nkeys) {
        f32x4 o0, o1;
        if (fox) { const f32x4 a = *(const f32x4*)(lc + s), b = *(const f32x4*)(lc + s + 4);
            o0 = (a + pre) * (-LOG2E); o1 = (b + pre) * (-LOG2E); }
        else { const float k = slope * LOG2E;
            o0 = (f32x4){k * (float)s, k * (float)(s + 1), k * (float)(s + 2), k * (float)(s + 3)}; o1 = (f32x4){k * (float)(s + 4), k * (float)(s + 5), k * (float)(s + 6), k * (float)(s + 7)}; }
        const attn_body::u32x2v k0 = attn_body::ka_split(o0.x), k1 = attn_body::ka_split(o0.y), k2 = attn_body::ka_split(o0.z), k3 = attn_body::ka_split(o0.w);
        const attn_body::u32x2v k4 = attn_body::ka_split(o1.x), k5 = attn_body::ka_split(o1.y), k6 = attn_body::ka_split(o1.z), k7 = attn_body::ka_split(o1.w);
        bias[4 * tid] = (u32x4){k0[0], k0[1], k1[0], k1[1]}; bias[4 * tid + 1] = (u32x4){k2[0], k2[1], k3[0], k3[1]}; bias[4 * tid + 2] = (u32x4){k4[0], k4[1], k5[0], k5[1]}; bias[4 * tid + 3] = (u32x4){k6[0], k6[1], k7[0], k7[1]};
    }
}

struct Args { const float* in[23]; float* out; unsigned char* ws; int ph_lo, ph_hi, li, pad; };
__global__ void __launch_bounds__(NWAVES * 64, 2) mk_fwd(Args args) {
    extern __shared__ __attribute__((aligned(16))) unsigned char lds[];
    LAS unsigned char* L = (LAS unsigned char*)lds;
    const int tid0 = threadIdx.x; const int wave0 = __builtin_amdgcn_readfirstlane(tid0 >> 6);
    const int bx0 = blockIdx.x;
    for (int u = tid0; u < (LDS_BYTES - LDSCTL_OFF) / 4; u += NWAVES * 64) ((LAS unsigned*)(L + LDSCTL_OFF))[u] = 0u;
    __syncthreads();
    volatile LAS unsigned* MISC = (volatile LAS unsigned*)(L + MISC_OFF);
    XcdBarrier bar = xcd_barrier_post((unsigned*)(args.ws + WS_CTL) + CW_BAR + args.li * XCD_BAR_WORDS, MISC + 8);
    const int lo = args.ph_lo, hi = args.ph_hi;
    int ph = 0;
    constexpr size_t AE = ACT_BYTES / 2;
#define PH_ON (ph >= lo && ph < hi)
#define FRESH_TID() int lane; asm volatile("v_mbcnt_lo_u32_b32 %0, -1, 0\n\tv_mbcnt_hi_u32_b32 %0, -1, %0" : "=v"(lane)); const int wave = wave0; const int tid = wave * 64 + lane; (void)tid; \
    int bx = bx0; asm volatile("" : "+s"(bx)); const int G = 256; const int vcu = (bx % 8) * (G / 8) + bx / 8; (void)vcu; const int bb = bx >> 5; (void)bb; \
    kaptr ka = (kaptr)__builtin_amdgcn_kernarg_segment_ptr(); asm volatile("" : "+s"(ka)); \
    unsigned char* ws = *(unsigned char* const __attribute__((address_space(4)))*)(ka + 8 * 24); float* out = *(float* const __attribute__((address_space(4)))*)(ka + 8 * 23); (void)out; \
    unsigned* ctl = (unsigned*)(ws + WS_CTL); (void)ctl; bf16* ACT = (bf16*)(ws + WS_ACT); \
    bf16 *B0 = ACT, *B1 = ACT + AE, *B2 = ACT + 2 * AE, *B3 = ACT + 3 * AE, *B4 = ACT + 4 * AE, *B5 = ACT + 5 * AE; (void)B0; (void)B1; (void)B2; (void)B3; (void)B4; (void)B5; \
    float* MOD = (float*)(ws + WS_MOD); float* KVMOD = (float*)(ws + WS_KVMOD); float* BT = (float*)(ws + WS_BT); float* LC = (float*)(ws + WS_LC); (void)MOD; (void)KVMOD; (void)BT; (void)LC; \
    unsigned* TOK = (unsigned*)(ws + WS_TOK); int* PERM = (int*)(ws + WS_PERM); float* GWT = (float*)(ws + WS_GWT); (void)TOK; (void)PERM; (void)GWT
#define PH_END do { if (PH_ON && ph + 1 < hi) { XcdBarrier b_ = bar; asm volatile("" : "+s"(b_.bar), "+s"(b_.x)); for (int rb_ = 0; rb_ < REP_BAR; ++rb_) xcd_barrier(b_); } ++ph; } while (0)


    if (PH_ON) { FRESH_TID(); for (int rep_ = 0; rep_ < REP_P0; ++rep_) p0_prologue(L, ka, ws, tid, lane, wave, bx, G, vcu); }
    PH_END;
    if (PH_ON) { FRESH_TID();
        RowsCfg c{}; c.xin_f32 = INP(0); c.sh = MOD + (size_t)bb * 6144; c.sc = MOD + (size_t)bb * 6144 + DM; c.hout = B5; c.hout_fp8 = 1;
        c.w16 = INP(8) + 3072; c.w16_ld = 3088; c.dotmode = 2; c.rb = INP(9); c.lc = LC; c.bt = BT;
        for (int rep_ = 0; rep_ < REP_P0B; ++rep_) rows_phase<0, true>(L, c, tid, lane, wave, bx);
    }
    PH_END;

    for (int l = 0; l < 4; ++l) {
        const bool fox = l < 2;
        if (PH_ON) { FRESH_TID();
            for (int rep_ = 0; rep_ < REP_P1; ++rep_)
            for (int pass = (l == 2 ? 0 : 1); pass < 2; ++pass) {
                pg8::Gemm g; pg8::EpiBf16 E; int N;
                if (fox) { g = pg8::Gemm{B5, (const bf16*)((const unsigned char*)(ws + WS_FOXIN) + (size_t)l * 3072 * DM), DM / 2}; N = 3072; E = pg8::EpiBf16{B2, DM, DM, AE, {QSCALE / WQK, 1.0f / WQK, 1.0f / WV}, ctl + CW_NORM + 1024 * l, 32, DRY_REP && rep_ > 0}; }
                else if (pass == 0) { g = pg8::Gemm{B2, (const bf16*)(ws + WS_KVW), DM / 2}; N = 2048; E = pg8::EpiBf16{B3, DM, DM, AE, {1.0f / WQK, 1.0f / WV, 0.f}, ctl + CW_KVN, 16, DRY_REP && rep_ > 0}; }
                else { g = pg8::Gemm{B5, (const bf16*)((const unsigned char*)(ws + WS_DQ) + (size_t)(l - 2) * DM * DM), DM / 2}; N = 1024; E = pg8::EpiBf16{B0, DM, DM, AE, {QSCALE / WQK, 0.f, 0.f}, ctl + CW_NORM + 1024 * l, 16, DRY_REP && rep_ > 0}; }
                pg8::DenseSched S; S.init(NT, N, DM / 2, G, bx);
                pg8::gemm_phase<pg8::EpiBf16, pg8::DenseSched, true, true>(L, g, S, E, tid, L + PARK_OFF);
            }
        }
        PH_END;
        if (PH_ON) { FRESH_TID();
            LAS int* QW = (LAS int*)(L + QW_OFF);
            unsigned* qctr = ctl + CW_QUEUE + 64 * l;
            const int total = fox ? 2048 : 1024;
            if (!fox && tid < 64) { const float* lamp = INP(15) + (size_t)(l - 2) * 256; const float lam_init = (l == 2) ? 0.47071302f : 0.55605820f;
                float pa = lamp[tid] * lamp[64 + tid], pb = lamp[128 + tid] * lamp[192 + tid];
                pa = wave_sum(pa, tid); pb = wave_sum(pb, tid);
                if (tid == 0) ((LAS float*)QW)[16] = __expf(pa) - __expf(pb) + lam_init; }
            int jph = 0;
            if (!fox && tid < 128) { const int hh = tid >> 4, qq = tid & 15;
                auto est = [](int h_, int q_) { const int w = 5 + (int)(0.823f * (float)(2 << h_)); const int c = 4 * q_ + 4; return c < w ? c : w; };
                const int e = est(hh, qq); int rank = 0;
                for (int c2 = 0; c2 < 128; ++c2) { const int e2 = est(c2 >> 4, c2 & 15); rank += (e2 > e || (e2 == e && c2 < tid)) ? 1 : 0; }
                ((LAS unsigned char*)QW)[128 + rank] = (unsigned char)tid; }
            const int kaoff = fox ? attn_body::LDS_BIAS : attn_body::LDS128_BIAS;
            { LAS float* NL = (LAS float*)(L + NORML_OFF);
              for (int i = tid; i < 512; i += NWAVES * 64) { const int b = i >> 6, s = i & 63; unsigned v = 0u;
                  if (fox) { if ((s & 31) < 16) v = __hip_atomic_load(ctl + CW_NORM + 1024 * l + b * 32 + (s < 32 ? s : 16 + (s - 32)), RLX_AGENT); }
                  else { if (s < 16) v = __hip_atomic_load(ctl + CW_NORM + 1024 * l + b * 16 + s, RLX_AGENT); else if (s >= 32 && s < 48) v = __hip_atomic_load(ctl + CW_KVN + b * 16 + (s - 32), RLX_AGENT); }
                  NL[i] = __uint_as_float(v); } }
            for (int rep_ = 0; rep_ < (fox ? REP_ATTN_FOX : REP_ATTN); ++rep_) {
            unsigned* qc = qctr + 16 * rep_;
            int pvh = -1, pnk = 0;
            if (tid == 0) QW[0] = (int)__hip_atomic_fetch_add(qc, 1u, RLX_AGENT);
            __syncthreads();
            int ck = 0;
            for (;;) {
                const int u = __builtin_amdgcn_readfirstlane(QW[0]);
                __syncthreads();
                const bool have = u < total;
                if (!have && ck >= CONV_PER_WAVE) break;
                bool grab = false; int nxt = 0;
                if (have) {
                grab = fox || jph == 1;
                if (grab && tid == 0) nxt = (int)__hip_atomic_fetch_add(qc, 1u, RLX_AGENT);
                int vh, qb;
                if (fox) { vh = u & 127; qb = 15 - (u >> 7); }
                else { const int cls = ((const LAS unsigned char*)QW)[128 + (u >> 3)]; vh = (u & 7) * 8 + (cls >> 4); qb = cls & 15; }
                const bf16 *Qb, *Kb, *Vb; bf16* Ob; const float *lc = nullptr, *bt = nullptr; float slope = 0.f; int nqi;
                if (fox) { const int b = vh >> 4, h = vh & 15; const size_t o = (size_t)b * SEQ * DM + h * 64;
                    Qb = B2 + o; Kb = B3 + o; Vb = B4 + o; Ob = (bf16*)((unsigned char*)B0 + o);   lc = LC + (size_t)vh * SEQ; bt = BT + vh * 32;
                    nqi = b * 64 + h; }
                else { const int b = vh >> 3, h = vh & 7, j = jph; const size_t o = (size_t)b * SEQ * DM + h * 128;
                    Qb = B0 + o + j * 64; Kb = B3 + o + j * 64; Vb = B4 + o; Ob = B1 + o; slope = exp2f(-(float)(h + 1));
                    nqi = b * 64 + 2 * h + j; }
                const LAS float* NL = (const LAS float*)(L + NORML_OFF);
                const float q2 = NL[nqi], k2 = NL[nqi + 32];
                const float bh = 1.01f * sqrtf(q2 * k2), bound = 2.0f * bh + 32.0f;
                int tu = tid; int t0;
                asm volatile("" : "+v"(tu));
                if (!(vh == pvh && (qb + 1) * 256 <= pnk)) {
                    fill_bias(L, fox, lc, bt, slope, (qb + 1) * 256, tu, tu & 63, kaoff);
                    asm volatile("s_waitcnt lgkmcnt(0)\n\ts_barrier" ::: "memory");
                    pvh = vh; pnk = (qb + 1) * 256; }
                { const LAS attn_body::u32x2v* bias = (const LAS attn_body::u32x2v*)(L + kaoff); const int jl = tu & 63;
                  const bool c = (jl < 4 * qb) && (attn_body::ka_value(bias[64 * jl + 63]) - attn_body::ka_value(bias[256 * qb]) + bound < 0.0f);
                  t0 = (int)__builtin_popcountll(__ballot(c)) & ~1; }
                if (fox) attn_body::attn_unit<8>(qb, t0, (const attn_body::bf16*)Qb, (const attn_body::bf16*)Kb, (const attn_body::bf16*)Vb, (attn_body::bf16*)Ob, (char*)lds, tu, bh, OSC);
                else attn_body::attn_unit128(qb, t0, (const attn_body::bf16*)Qb, (const attn_body::bf16*)Kb, (const attn_body::bf16*)Vb, (attn_body::bf16*)Ob, (char*)lds, tu, bh, jph, (unsigned char*)B2 + (Ob - B1), (const float*)((char*)lds + QW_OFF + 64), INP(16) + (size_t)(l - 2) * 128, (1.0f - ((l == 2) ? 0.47071302f : 0.55605820f)) * OSC, LN_EPS);
                if (!fox) jph ^= 1;
                }
                if (ck < CONV_PER_WAVE) { int tc = tid; asm volatile("" : "+v"(tc)); moe_convert_item((LAS float*)(L + (tc >> 6) * 8448), ka, ws, l, tc & 63, tc >> 6, G, vcu, ck); ++ck; }
                if (grab && tid == 0) QW[0] = nxt;
                __syncthreads();
            }
            }
        }
        PH_END;
        ++ph;
        if (PH_ON) { FRESH_TID();
            pg8::Gemm g{fox ? B0 : B2, (const bf16*)((const unsigned char*)(ws + (fox ? WS_FOXO : WS_DO)) + (size_t)(fox ? l : l - 2) * DM * DM), DM / 2};
            pg8::DenseSched S; S.init(NT, DM, DM / 2, G, bx);
            for (int rep_ = 0; rep_ < REP_P3; ++rep_) { pg8::EpiFp8 E{(unsigned char*)B1, DM, YSC / (WV * OSC), DRY_REP && rep_ > 0};
            if (rep_ == 0) pg8::gemm_phase<pg8::EpiFp8, pg8::DenseSched, true, true>(L, g, S, E, tid, L + PARK_OFF); else pg8::gemm_phase<pg8::EpiFp8, pg8::DenseSched, true, true, ABLP>(L, g, S, E, tid, L + PARK_OFF); }
        }
        PH_END;
        if (PH_ON) { FRESH_TID();
            const float* modl = MOD + ((size_t)l * NB + bb) * 6144; bf16* XB = (bf16*)out + (size_t)NT * DM;     RowsCfg c{}; c.xin_f32 = INP(0); c.xin_bf = XB; c.xout_bf = (l == 3) ? B5 : XB; c.src = (const unsigned char*)B1; c.src_inv = 1.0f / YSC; c.gate = modl + 2 * DM; c.gamma = INP(4) + l * DM; c.beta = INP(5) + l * DM;
            c.sh = modl + 3 * DM; c.sc = modl + 4 * DM; c.hout = B0; c.hout_fp8 = 1; c.w16 = INP(18); c.w16_ld = 16; c.dotmode = 1; c.rb = INP(19);
            c.cnt = ctl + CW_CNT + 64 * l; c.perm = PERM; c.gwt = GWT; c.tokslot = TOK;
            for (int rep_ = 0; rep_ < REP_LN1; ++rep_) { RowsCfg c2 = c; if (rep_ + 1 < REP_LN1) { c2.xout_bf = (l == 3) ? B5 : B5; c2.cnt = nullptr; if (PROBE_NODOT) c2.dotmode = 0; }
            if (l == 0) rows_phase<1, true>(L, c2, tid, lane, wave, bx); else rows_phase<1, false>(L, c2, tid, lane, wave, bx); }
            if (CONV_PER_WAVE == 0) for (int rep_ = 0; rep_ < REP_CONV; ++rep_) moe_weight_copies(L, ka, ws, l, lane, wave, G, vcu);
        }
        PH_END;
        if (PH_ON) { FRESH_TID();
            LAS int* TAB = (LAS int*)(L + MOETAB_OFF);
            if (tid < 16) TAB[32 + tid] = (int)__hip_atomic_load(ctl + CW_CNT + 64 * l + tid, RLX_AGENT);
            __syncthreads();
            if (tid == 0) { int tp = 0, so = 0;
#pragma unroll
                for (int e = 0; e < 16; ++e) { const int cn = TAB[32 + e]; TAB[e] = tp; TAB[64 + e] = so; tp += (cn + 255) >> 8; so += cn; } TAB[16] = tp; }
            __syncthreads();
            pg8::Gemm g{B0, (const bf16*)(ws + WS_MOE1), DM / 2};
            pg8::MoeSched<true> S{TAB, G, vcu, DM / 2, PERM, (unsigned)(DM * DM), (const LAS int*)(L + PARK_OFF)};
            S.fill_tokens((LAS int*)(L + PARK_OFF), tid); __syncthreads();
            pg8::EpiMoe1 E{(unsigned char*)B2, 1.0f / W1SCALE, ASCALE};
            for (int rep_ = 0; rep_ < REP_P5; ++rep_)
            pg8::gemm_phase<pg8::EpiMoe1, pg8::MoeSched<true>, true, true>(L, g, S, E, tid, L + PARK_OFF);
        }
        PH_END;
        if (PH_ON) { FRESH_TID();
            LAS int* TAB = (LAS int*)(L + MOETAB_OFF);
            if (tid < 16) TAB[32 + tid] = (int)__hip_atomic_load(ctl + CW_CNT + 64 * l + tid, RLX_AGENT);
            __syncthreads();
            if (tid == 0) { int tp = 0, so = 0;
#pragma unroll
                for (int e = 0; e < 16; ++e) { const int cn = TAB[32 + e]; TAB[e] = tp; TAB[64 + e] = so; tp += (cn + 255) >> 8; so += cn; } TAB[16] = tp; }
            __syncthreads();
            pg8::Gemm g{B2, (const bf16*)(ws + WS_MOE2), 256};
            pg8::MoeSched<false> S{TAB, G, vcu, 256, PERM, (unsigned)(DM * 512), nullptr};
            pg8::EpiMoe2 E{(unsigned char*)B0, DNSC / (W2SCALE * ASCALE)};
            for (int rep_ = 0; rep_ < REP_P6; ++rep_)
            pg8::gemm_phase<pg8::EpiMoe2, pg8::MoeSched<false>, true, true>(L, g, S, E, tid, L + PARK_OFF);
        }
        PH_END;
        if (PH_ON) { FRESH_TID();
            const float* modl = MOD + ((size_t)l * NB + bb) * 6144; bf16* XB = (bf16*)out + (size_t)NT * DM; RowsCfg c{}; c.xin_bf = (l == 3) ? B5 : XB; if (l == 3) c.xout_f32 = out; else c.xout_bf = XB; c.src = (const unsigned char*)B0; c.src_inv = 1.0f / DNSC; c.gate = modl + 5 * DM; c.gamma = INP(6) + l * DM; c.beta = INP(7) + l * DM;
            c.cnt = ctl + CW_CNT + 64 * l; c.tokslot = TOK; c.gwt = GWT;
            if (l < 3) { const float* modn = MOD + ((size_t)(l + 1) * NB + bb) * 6144; c.sh = modn; c.sc = modn + DM; c.hout = B5; c.hout_fp8 = 1; }
            if (l == 0) { c.w16 = INP(8) + (size_t)DM * 3088 + 3072; c.w16_ld = 3088; c.dotmode = 2; c.rb = INP(9) + 16; c.lc = LC; c.bt = BT; }
            if (l == 1) { c.sh2 = KVMOD + (size_t)bb * 2048; c.sc2 = KVMOD + (size_t)bb * 2048 + DM; c.hout2 = B2; }
            for (int rep_ = 0; rep_ < REP_LN2; ++rep_) { RowsCfg c2 = c; if (rep_ + 1 < REP_LN2) { c2.xout_f32 = nullptr; c2.xout_bf = (l == 1) ? B3 : B2; }
            rows_phase<2, false>(L, c2, tid, lane, wave, bx); }
        }
        PH_END;
    }
#undef PH_ON
#undef PH_END
}

extern "C" void kernel_launch(void* const* d_in, const int* in_sizes, int n_in, void* d_out, int out_size, void* d_ws, size_t ws_size, hipStream_t stream) {
    static int grid = 0;
    if (grid == 0) {
        if (n_in != 23 || in_sizes[0] != NT * DM || out_size != NT * DM || ws_size < WS_END) { fprintf(stderr, "kernel_launch: unexpected problem (n_in %d, in0 %d, out %d, ws %zu < %zu)\n", n_in, n_in > 0 ? in_sizes[0] : -1, out_size, ws_size, (size_t)WS_END); grid = -1; return; }
        if (hipFuncSetAttribute((const void*)mk_fwd, hipFuncAttributeMaxDynamicSharedMemorySize, LDS_BYTES) != hipSuccess) { fprintf(stderr, "kernel_launch: hipFuncSetAttribute failed\n"); grid = -1; return; }
        int per_cu = 0;
        if (hipOccupancyMaxActiveBlocksPerMultiprocessor(&per_cu, (const void*)mk_fwd, NWAVES * 64, LDS_BYTES) != hipSuccess || per_cu < 1) fprintf(stderr, "kernel_launch: occupancy query reports %d\n", per_cu);
        (void)hipGetLastError();
        grid = 256;
    }
    if (grid < 0) return;
    if (hipMemsetAsync((char*)d_ws + WS_CTL, 0, CTL_ZERO_BYTES, stream) != hipSuccess) { fprintf(stderr, "kernel_launch: memset failed\n"); return; }
    Args a{};
    for (int i = 0; i < 23; ++i) a.in[i] = (const float*)d_in[i];
    a.out = (float*)d_out; a.ws = (unsigned char*)d_ws;
#if MK_PER_PHASE
    for (int p = 0; p < NPH; ++p) { a.ph_lo = p; a.ph_hi = p + 1; a.li = p; hipLaunchKernelGGL(mk_fwd, dim3(grid), dim3(NWAVES * 64), LDS_BYTES, stream, a); }
#else
    a.ph_lo = 0; a.ph_hi = NPH; a.li = 0;
    hipLaunchKernelGGL(mk_fwd, dim3(grid), dim3(NWAVES * 64), LDS_BYTES, stream, a);
#endif
    const hipError_t le = hipPeekAtLastError();
    if (le != hipSuccess) fprintf(stderr, "kernel_launch: launch failed: %s\n", hipGetErrorName(le));
}
```

```cpp
#include <hip/hip_runtime.h>
#include <hip/hip_bf16.h>
#include <cstdio>
#include <cstdint>
#include <cmath>
#define LAS __attribute__((address_space(3)))
namespace pg8 {
#define PG8_LAS __attribute__((address_space(3)))
typedef unsigned short bf16_t;
typedef short bf16x8 __attribute__((ext_vector_type(8)));
typedef float f32x4 __attribute__((ext_vector_type(4)));
typedef unsigned u32x4 __attribute__((ext_vector_type(4)));
constexpr int BM = 256, BK = 64, HALF = 128, HTB = HALF * BK * 2  , STAGE_BYTES = 8 * HTB, NXCD = 8, WGM = 8;

__host__ __device__ __forceinline__ int lds_byte(int r, int c) { const int st = (r >> 4) * 2 + (c >> 5), rr = r & 15, cc = c & 31, ob = rr * 64 + cc * 2; return st * 1024 + (ob ^ (((ob >> 9) & 1) << 5)); }
__host__ __device__ __forceinline__ void stage_rc(int b, int& R, int& C) { const int st = b / 1024, sb = b % 1024, swz = sb ^ (((sb >> 9) & 1) << 5); R = (st >> 1) * 16 + swz / 64; C = (st & 1) * 32 + (swz % 64) / 2; }
__host__ __device__ __forceinline__ int perm32(int rho) { const int n = rho >> 4, i = rho & 15; return 8 * (i >> 2) + 4 * n + (i & 3); }
struct Unit0 { int pm, pn; };
struct StaticOrder {
    int nM, nN, nwg, G, c;
    __host__ __device__ void init(int M, int N, int G_, int c_) { nM = M / BM; nN = N / BM; nwg = nM * nN; G = G_; c = c_; }
    __host__ __device__ bool next(int i, Unit0& u) const {
        const long L = (long)i * G + c; if (L >= nwg) return false;
        int wgid = (int)L; { const int q = nwg / NXCD, r = nwg % NXCD, xcd = wgid % NXCD, off = wgid / NXCD; wgid = (xcd < r ? xcd * (q + 1) : r * (q + 1) + (xcd - r) * q) + off; }
        const int nig = WGM * nN, gid = wgid / nig, fm = gid * WGM, gsz = (nM - fm) < WGM ? (nM - fm) : WGM;
        u.pm = fm + ((wgid % nig) % gsz); u.pn = (wgid % nig) / gsz; return true;
    }
    __device__ __forceinline__ void a_ready(const Unit0&) const {}
    __device__ __forceinline__ void done(const Unit0&) const {}
};

struct Unit { int pm, pn, e, nrows, row0, ord; unsigned boff; };
struct Gemm { const bf16_t* A; const bf16_t* Bt; int K; };

struct DenseSched {
    StaticOrder so; int K;
    __device__ __forceinline__ void init(int M, int N, int K_, int G, int c) { so.init(M, N, G, c); K = K_; }
    __device__ __forceinline__ bool next(int i, Unit& u) const { Unit0 t; if (!so.next(i, t)) return false; u.pm = t.pm; u.pn = t.pn; u.e = 0; u.ord = i; u.nrows = BM; u.row0 = t.pm * BM; u.boff = (unsigned)t.pn * (unsigned)(BM * 2) * (unsigned)K; return true; }
    static constexpr bool GATHER = false;
    __device__ __forceinline__ void aoff(const Unit& u, int tid, unsigned (&off)[2][2]) const {
#pragma unroll
        for (int i = 0; i < 2; ++i) { int R, C; stage_rc(tid * 16 + i * 8192, R, C);
#pragma unroll
            for (int h = 0; h < 2; ++h) off[h][i] = (unsigned)((u.row0 + h * HALF + R) * K + C) * 2u; } }
};
template <bool GATHER_> struct MoeSched {
    static constexpr bool GATHER = GATHER_;
    const PG8_LAS int* tab; int G, c, K; const int* perm; unsigned wstride; const PG8_LAS int* toks;
    __device__ __forceinline__ bool next(int i, Unit& u) const {
        const int L = i * G + c; const int tot = tab[16] * 4; if (L >= tot) return false;
        const int g = L >> 2; int e = 0;
#pragma unroll
        for (int k = 1; k < 16; ++k) e += (tab[k] <= g) ? 1 : 0;
        const int mt = g - tab[e], cnt = tab[32 + e];
        u.pm = mt; u.pn = L & 3; u.e = e; u.ord = i; u.nrows = (cnt - BM * mt) < BM ? (cnt - BM * mt) : BM; u.row0 = tab[64 + e] + BM * mt;
        u.boff = (unsigned)e * wstride + (unsigned)(L & 3) * (unsigned)(BM * 2) * (unsigned)K; return true; }
    __device__ __forceinline__ void fill_tokens(PG8_LAS int* dst, int tid) const {
        Unit u;
        for (int i = 0; i < 8 && next(i, u); ++i) for (int r = tid; r < BM; r += 512) dst[i * BM + r] = r < u.nrows ? perm[u.e * 32768 + u.pm * BM + r] : 0; }
    __device__ __forceinline__ void aoff(const Unit& u, int tid, unsigned (&off)[2][2]) const {
#pragma unroll
        for (int i = 0; i < 2; ++i) { int R, C; stage_rc(tid * 16 + i * 8192, R, C);
#pragma unroll
            for (int h = 0; h < 2; ++h) {
                int row;
                if (GATHER) row = toks[u.ord * BM + h * HALF + R];
                else row = u.row0 + h * HALF + R;
                off[h][i] = (unsigned)(row * K + C) * 2u; } } }
};

typedef float f32x2 __attribute__((ext_vector_type(2))); typedef __bf16 bf16x2_t __attribute__((ext_vector_type(2)));
__device__ __forceinline__ unsigned cvt_pk_bf16(float lo, float hi) { f32x2 v = {lo, hi}; bf16x2_t b = __builtin_convertvector(v, bf16x2_t); return __builtin_bit_cast(unsigned, b); }

struct EpiBf16 {
    static constexpr bool PERM = true, AFTER_DRAIN = false;
    bf16_t* O; int ldc; int split_cols; size_t split_stride; float scv[3]; unsigned* norm; int nslots; int dry;
    __device__ __forceinline__ void operator()(const f32x4 (&acc)[2][2][4][2], const Unit& u, int wr, int wc, int fr, int fq) const {
        const int row0 = u.row0 + wr * 64 + fr; int colt = u.pn * BM; bf16_t* base = O;
        float sc = scv[0]; int tt = 0; if (split_cols) { const int t = colt / split_cols; tt = t; base += (size_t)t * split_stride; colt -= t * split_cols; sc = t == 0 ? scv[0] : (t == 1 ? scv[1] : scv[2]); }
        const int col0 = colt + wc * 64 + 8 * fq;
#pragma unroll
        for (int ai = 0; ai < 2; ++ai)
#pragma unroll
            for (int m = 0; m < 4; ++m) { bf16_t* rowp = base + (size_t)(row0 + ai * HALF + m * 16) * ldc + col0;
#pragma unroll
                for (int bj = 0; bj < 2; ++bj) { const f32x4 v0 = acc[ai][bj][m][0] * sc, v1 = acc[ai][bj][m][1] * sc;
                    u32x4 w; w.x = cvt_pk_bf16(v0[0], v0[1]); w.y = cvt_pk_bf16(v0[2], v0[3]); w.z = cvt_pk_bf16(v1[0], v1[1]); w.w = cvt_pk_bf16(v1[2], v1[3]);
                    if (!dry) *(u32x4*)(rowp + bj * 32) = w; else asm volatile("" :: "v"(w)); } }
        if (norm && !dry && tt < nslots / 16) { const int lane = fq * 16 + fr; float mx = 0.f;
#pragma unroll
            for (int ai = 0; ai < 2; ++ai)
#pragma unroll
                for (int m = 0; m < 4; ++m) { float ss = 0.f;
#pragma unroll
                    for (int bj = 0; bj < 2; ++bj) { const f32x4 v0 = acc[ai][bj][m][0] * sc, v1 = acc[ai][bj][m][1] * sc;
                        ss += (v0[0] * v0[0] + v0[1] * v0[1]) + (v0[2] * v0[2] + v0[3] * v0[3]) + (v1[0] * v1[0] + v1[1] * v1[1]) + (v1[2] * v1[2] + v1[3] * v1[3]); }
                    ss += __uint_as_float((unsigned)__builtin_amdgcn_ds_bpermute((lane ^ 16) << 2, (int)__float_as_uint(ss)));
                    ss += __uint_as_float((unsigned)__builtin_amdgcn_ds_bpermute((lane ^ 32) << 2, (int)__float_as_uint(ss)));
                    mx = fmaxf(mx, ss); }
#pragma unroll
            for (int o = 1; o < 16; o <<= 1) mx = fmaxf(mx, __uint_as_float((unsigned)__builtin_amdgcn_ds_bpermute((lane ^ o) << 2, (int)__float_as_uint(mx))));
            if (lane == 0) __hip_atomic_fetch_max(norm + (u.row0 >> 12) * nslots + u.pn * 4 + wc, __float_as_uint(mx), __ATOMIC_RELAXED, __HIP_MEMORY_SCOPE_AGENT);
        }
    }
};
__device__ __forceinline__ unsigned pk4_fp8(float a, float b, float c, float d) { unsigned w = __builtin_amdgcn_cvt_pk_fp8_f32(a, b, 0u, false); return __builtin_amdgcn_cvt_pk_fp8_f32(c, d, w, true); }
typedef unsigned u32x2e_t __attribute__((ext_vector_type(2)));
__device__ __forceinline__ u32x4 widen16(u32x2e_t w0, u32x2e_t w1) {
    const auto a = __builtin_amdgcn_permlane16_swap(w0[0], w1[0], false, false), b = __builtin_amdgcn_permlane16_swap(w0[1], w1[1], false, false);
    return (u32x4){a[0], b[0], a[1], b[1]}; }
struct EpiFp8 {
    static constexpr bool PERM = true, AFTER_DRAIN = false;
    unsigned char* O; int ldc; float sc; int dry;
    __device__ __forceinline__ void operator()(const f32x4 (&acc)[2][2][4][2], const Unit& u, int wr, int wc, int fr, int fq) const {
        const int row0 = u.row0 + wr * 64 + fr + 16 * (fq & 1), col0 = u.pn * BM + wc * 32 + 8 * (fq & ~1);
#pragma unroll
        for (int ai = 0; ai < 2; ++ai)
#pragma unroll
            for (int mp = 0; mp < 4; mp += 2) { unsigned char* rowp = O + (size_t)(row0 + ai * HALF + mp * 16) * ldc + col0;
#pragma unroll
                for (int bj = 0; bj < 2; ++bj) { const f32x4 a0 = acc[ai][bj][mp][0] * sc, a1 = acc[ai][bj][mp][1] * sc, b0 = acc[ai][bj][mp + 1][0] * sc, b1 = acc[ai][bj][mp + 1][1] * sc;
                    const u32x4 w = widen16((u32x2e_t){pk4_fp8(a0[0], a0[1], a0[2], a0[3]), pk4_fp8(a1[0], a1[1], a1[2], a1[3])}, (u32x2e_t){pk4_fp8(b0[0], b0[1], b0[2], b0[3]), pk4_fp8(b1[0], b1[1], b1[2], b1[3])});
                    if (!dry) *(u32x4*)(rowp + bj * HALF) = w; else asm volatile("" :: "v"(w)); } }
    }
};
__device__ __forceinline__ float silu_mul(float g, float u) { return g * u * __builtin_amdgcn_rcpf(1.0f + __builtin_amdgcn_exp2f(-1.4426950408889634f * g)); }
struct EpiMoe1 {
    static constexpr bool PERM = true, AFTER_DRAIN = false;
    unsigned char* O; float inv_wscale, ascale;
    __device__ __forceinline__ void operator()(const f32x4 (&acc)[2][2][4][2], const Unit& u, int wr, int wc, int fr, int fq) const {
        const int col0 = u.pn * 128 + wc * 32 + 8 * (fq & ~1); const float us = inv_wscale * ascale;
#pragma unroll
        for (int ai = 0; ai < 2; ++ai)
#pragma unroll
            for (int mp = 0; mp < 4; mp += 2) { const int r = ai * HALF + wr * 64 + (mp + (fq & 1)) * 16 + fr; u32x2e_t wv[2];
#pragma unroll
                for (int k = 0; k < 2; ++k) { const f32x4 g0 = acc[ai][0][mp + k][0] * inv_wscale, g1 = acc[ai][0][mp + k][1] * inv_wscale, u0 = acc[ai][1][mp + k][0] * us, u1 = acc[ai][1][mp + k][1] * us;
                    wv[k] = (u32x2e_t){pk4_fp8(silu_mul(g0[0], u0[0]), silu_mul(g0[1], u0[1]), silu_mul(g0[2], u0[2]), silu_mul(g0[3], u0[3])), pk4_fp8(silu_mul(g1[0], u1[0]), silu_mul(g1[1], u1[1]), silu_mul(g1[2], u1[2]), silu_mul(g1[3], u1[3]))}; }
                const u32x4 w = widen16(wv[0], wv[1]);
                if (r < u.nrows) *(u32x4*)(O + (size_t)(u.row0 + r) * 512 + col0) = w; }
    }
};
struct EpiMoe2 {
    static constexpr bool PERM = true, AFTER_DRAIN = false;
    unsigned char* O; float oscale;
    __device__ __forceinline__ void operator()(const f32x4 (&acc)[2][2][4][2], const Unit& u, int wr, int wc, int fr, int fq) const {
        const int col0 = u.pn * BM + wc * 32 + 8 * (fq & ~1); const float s = oscale;
#pragma unroll
        for (int ai = 0; ai < 2; ++ai)
#pragma unroll
            for (int mp = 0; mp < 4; mp += 2) { const int r = ai * HALF + wr * 64 + (mp + (fq & 1)) * 16 + fr; unsigned char* rowp = O + (size_t)(u.row0 + r) * 1024 + col0;
#pragma unroll
                for (int bj = 0; bj < 2; ++bj) { const f32x4 a0 = acc[ai][bj][mp][0] * s, a1 = acc[ai][bj][mp][1] * s, b0 = acc[ai][bj][mp + 1][0] * s, b1 = acc[ai][bj][mp + 1][1] * s;
                    const u32x4 w = widen16((u32x2e_t){pk4_fp8(a0[0], a0[1], a0[2], a0[3]), pk4_fp8(a1[0], a1[1], a1[2], a1[3])}, (u32x2e_t){pk4_fp8(b0[0], b0[1], b0[2], b0[3]), pk4_fp8(b1[0], b1[1], b1[2], b1[3])});
                    if (r < u.nrows) *(u32x4*)(rowp + bj * HALF) = w; } }
    }
};

typedef int v8i32 __attribute__((ext_vector_type(8))); typedef int v4i32 __attribute__((ext_vector_type(4)));
__device__ __forceinline__ v8i32 cat8(bf16x8 a, bf16x8 b) { const v4i32 x = __builtin_bit_cast(v4i32, a), y = __builtin_bit_cast(v4i32, b); return (v8i32){x[0], x[1], x[2], x[3], y[0], y[1], y[2], y[3]}; }
__device__ __forceinline__ void glds_s(const void* sbase, unsigned voff, unsigned lds_dst) { unsigned keep;
    asm volatile("s_mov_b32 %0, m0\n\ts_mov_b32 m0, %3\n\ts_nop 2\n\tglobal_load_lds_dwordx4 %1, %2\n\ts_mov_b32 m0, %0" : "=&s"(keep) : "v"(voff), "s"(sbase), "s"(lds_dst) : "memory"); }
__device__ __forceinline__ const char* uni_ptr(const char* p) { const unsigned long long v = (unsigned long long)p; const unsigned lo = __builtin_amdgcn_readfirstlane((unsigned)v), hi = __builtin_amdgcn_readfirstlane((unsigned)(v >> 32)); return (const char*)(((unsigned long long)hi << 32) | lo); }
template <class Epi, class Sched, bool ALIGN_EPI, bool FP8 = false, int ABL = 0>
__device__ __forceinline__ void gemm_phase(PG8_LAS unsigned char* lds, const Gemm g, const Sched& S, const Epi& E, const int tid, PG8_LAS unsigned char* park) {
    const int wid = __builtin_amdgcn_readfirstlane(tid >> 6), lane = tid & 63, wr = wid >> 2, wc = wid & 3, fr = lane & 15, fq = lane >> 4;
    const int K = g.K, nt = K / BK;
    unsigned voffB[2];
#pragma unroll
    for (int i = 0; i < 2; ++i) { int R, C; stage_rc(tid * 16 + i * 8192, R, C); const int Rb = Epi::PERM ? ((R & ~31) + perm32(R & 31)) : R; voffB[i] = (unsigned)(Rb * K + C) * 2u; }
    const unsigned kstep = (unsigned)(BK * 2);
    const unsigned hstep = (unsigned)HALF * (unsigned)K * 2u;
    const unsigned ldsw = (unsigned)wid * 1024u;
    const int aoff = lds_byte(wr * 64 + fr, fq * 8), boff = lds_byte(wc * 32 + fr, fq * 8);
    const char* gA = (const char*)g.A;
    const unsigned ldsbase = (unsigned)(size_t)lds;
#define PG8_SA(b, h) (((b) * 2 + (h)) * HTB)
#define PG8_SB(b, h) ((4 + (b) * 2 + (h)) * HTB)
#define PG8_STAGE(bufoff, gbase, voff) do { if constexpr (!(((ABL & 4) && (bufoff) < 4 * HTB) || ((ABL & 8) && (bufoff) >= 4 * HTB))) _Pragma("unroll") for (int _i = 0; _i < 2; ++_i) \
        glds_s(uni_ptr(gbase), (voff)[_i], (unsigned)__builtin_amdgcn_readfirstlane((int)(ldsbase + (unsigned)(bufoff) + ldsw + (unsigned)(_i * 8192)))); } while (0)
#define PG8_LDA(dst, b, h) do { if constexpr (!(ABL & 16)) _Pragma("unroll") for (int m = 0; m < 4; ++m) _Pragma("unroll") for (int k = 0; k < 2; ++k) dst[m][k] = *(const PG8_LAS bf16x8*)(lds + PG8_SA(b, h) + aoff + m * 2048 + k * 1024); } while (0)
#define PG8_LDB(dst, b, h) do { if constexpr (!(ABL & 16)) _Pragma("unroll") for (int n = 0; n < 2; ++n) _Pragma("unroll") for (int k = 0; k < 2; ++k) dst[n][k] = *(const PG8_LAS bf16x8*)(lds + PG8_SB(b, h) + boff + n * 2048 + k * 1024); } while (0)
#define PG8_MMA(ai, bj, At, Bt) do { __builtin_amdgcn_s_setprio(1); if constexpr (!(ABL & 1)) _Pragma("unroll") for (int m = 0; m < 4; ++m) _Pragma("unroll") for (int n = 0; n < 2; ++n) { \
        if constexpr (FP8) acc[ai][bj][m][n] = __builtin_amdgcn_mfma_scale_f32_16x16x128_f8f6f4(cat8(Bt[n][0], Bt[n][1]), cat8(At[m][0], At[m][1]), acc[ai][bj][m][n], 0, 0, 0, 0x7F7F7F7F, 0, 0x7F7F7F7F); \
        else { _Pragma("unroll") for (int k = 0; k < 2; ++k) acc[ai][bj][m][n] = __builtin_amdgcn_mfma_f32_16x16x32_bf16(Bt[n][k], At[m][k], acc[ai][bj][m][n], 0, 0, 0); } } __builtin_amdgcn_s_setprio(0); } while (0)
#define PG8_WAIT_V(n) asm volatile("s_waitcnt vmcnt(" #n ")" ::: "memory")
#define PG8_WAIT_L(n) asm volatile("s_waitcnt lgkmcnt(" #n ")" ::: "memory")
#define PG8_BAR __builtin_amdgcn_s_barrier()
#define PG8_SCHED __builtin_amdgcn_sched_barrier(0)
    Unit cur, nxt; int ui = 0;
    if (!S.next(0, cur)) return;
    f32x4 acc[2][2][4][2];
#pragma unroll
    for (int a = 0; a < 2; ++a)
#pragma unroll
        for (int b = 0; b < 2; ++b)
#pragma unroll
            for (int m = 0; m < 4; ++m)
#pragma unroll
                for (int n = 0; n < 2; ++n) acc[a][b][m][n] = (f32x4){0.f, 0.f, 0.f, 0.f};
    bf16x8 At[4][2], B0[2][2], B1[2][2];
    if constexpr (ABL & 16) { _Pragma("unroll") for (int m = 0; m < 4; ++m) _Pragma("unroll") for (int k = 0; k < 2; ++k) { At[m][k] = (bf16x8){0,0,0,0,0,0,0,0}; asm volatile("" : "+v"(At[m][k])); }
        _Pragma("unroll") for (int n = 0; n < 2; ++n) _Pragma("unroll") for (int k = 0; k < 2; ++k) { B0[n][k] = (bf16x8){0,0,0,0,0,0,0,0}; B1[n][k] = B0[n][k]; asm volatile("" : "+v"(B0[n][k]), "+v"(B1[n][k])); } }
    unsigned offC[2][2];
    S.aoff(cur, tid, offC);
    const char* cB = (const char*)g.Bt + cur.boff;
    PG8_STAGE(PG8_SB(0, 0), cB, voffB); PG8_STAGE(PG8_SB(0, 1), cB + hstep, voffB); PG8_STAGE(PG8_SA(0, 0), gA, offC[0]); PG8_STAGE(PG8_SA(0, 1), gA, offC[1]);
    if (wr == 1) PG8_BAR;
    PG8_WAIT_V(2); PG8_BAR;
    PG8_STAGE(PG8_SB(1, 0), cB + kstep, voffB); PG8_STAGE(PG8_SA(1, 0), gA + kstep, offC[0]); PG8_STAGE(PG8_SB(1, 1), cB + hstep + kstep, voffB);
    PG8_WAIT_V(6); PG8_BAR;
    for (;;) {
        const bool has_next = S.next(ui + 1, nxt);
        const char* nB = has_next ? (const char*)g.Bt + nxt.boff : cB;
#pragma unroll 1
        for (int t = 0; t < nt; t += 2) {
            const bool last = (t == nt - 2);
            const char* a1 = gA + (size_t)(t + 1) * kstep;
            const char* a2 = last ? gA : gA + (size_t)(t + 2) * kstep; const char* b2 = last ? nB : cB + (size_t)(t + 2) * kstep;
            const char* a3 = a2 + kstep; const char* b3 = b2 + kstep;
            PG8_LDB(B0, 0, 0); PG8_LDB(B1, 0, 1); PG8_SCHED; PG8_LDA(At, 0, 0); PG8_STAGE(PG8_SA(1, 1), a1, offC[1]);
            if (last && has_next) {
                { int t2 = tid; asm volatile("" : "+v"(t2)); S.aoff(nxt, t2, offC); } }
            PG8_WAIT_V(8); PG8_WAIT_L(0); PG8_BAR; PG8_MMA(0, 0, At, B0); PG8_MMA(0, 1, At, B1); PG8_BAR; PG8_SCHED;
            PG8_LDA(At, 0, 1); PG8_STAGE(PG8_SB(0, 0), b2, voffB); PG8_STAGE(PG8_SB(0, 1), b2 + hstep, voffB); PG8_STAGE(PG8_SA(0, 0), a2, offC[0]);
            PG8_WAIT_V(8); PG8_WAIT_L(0); PG8_BAR; PG8_MMA(1, 0, At, B0); PG8_MMA(1, 1, At, B1); PG8_BAR; PG8_SCHED;
            PG8_LDB(B0, 1, 0); PG8_LDB(B1, 1, 1); PG8_SCHED; PG8_LDA(At, 1, 0); PG8_STAGE(PG8_SA(0, 1), a2, offC[1]);
            PG8_WAIT_V(8); PG8_WAIT_L(0); PG8_BAR; PG8_MMA(0, 0, At, B0); PG8_MMA(0, 1, At, B1); PG8_BAR; PG8_SCHED;
            PG8_LDA(At, 1, 1); PG8_STAGE(PG8_SB(1, 0), b3, voffB); PG8_STAGE(PG8_SB(1, 1), b3 + hstep, voffB); PG8_STAGE(PG8_SA(1, 0), a3, offC[0]);
            PG8_WAIT_V(8); PG8_WAIT_L(0); PG8_BAR; PG8_MMA(1, 0, At, B0); PG8_MMA(1, 1, At, B1); PG8_BAR; PG8_SCHED;
        }
        if constexpr (ALIGN_EPI) { if (wr == 0) PG8_BAR; }
        if constexpr (!(ABL & 2)) E(acc, cur, wr, wc, fr, fq); else { _Pragma("unroll") for (int a = 0; a < 2; ++a) _Pragma("unroll") for (int b = 0; b < 2; ++b) _Pragma("unroll") for (int m = 0; m < 4; ++m) _Pragma("unroll") for (int n = 0; n < 2; ++n) asm volatile("" :: "v"(acc[a][b][m][n])); }
        if (!has_next) break;
#pragma unroll
        for (int a = 0; a < 2; ++a)
#pragma unroll
            for (int b = 0; b < 2; ++b)
#pragma unroll
                for (int m = 0; m < 4; ++m)
#pragma unroll
                    for (int n = 0; n < 2; ++n) acc[a][b][m][n] = (f32x4){0.f, 0.f, 0.f, 0.f};
        cur = nxt; cB = nB; ++ui;
        if constexpr (ALIGN_EPI) { if (wr == 1) PG8_BAR; }
    }
    PG8_WAIT_V(0);
    if constexpr (!ALIGN_EPI) { if (wr == 0) PG8_BAR; }
    PG8_BAR;
#undef PG8_SA
#undef PG8_SB
#undef PG8_STAGE
#undef PG8_LDA
#undef PG8_LDB
#undef PG8_MMA
#undef PG8_WAIT_V
#undef PG8_WAIT_L
#undef PG8_BAR
#undef PG8_SCHED
}
}

namespace attn_body {
using bf16=__hip_bfloat16;
using bf16x8=__attribute__((ext_vector_type(8)))short;
using s16x4=__attribute__((ext_vector_type(4)))short;
using f32x16=__attribute__((ext_vector_type(16)))float;
using u32x4=__attribute__((ext_vector_type(4)))unsigned;
#ifndef EMU8
#define EMU8 0
#endif
__device__ __forceinline__ float q8(float x,float s){ if(!EMU8) return x; const unsigned w=__builtin_amdgcn_cvt_pk_fp8_f32(x*s,0.f,0u,false); return __builtin_amdgcn_cvt_f32_fp8((int)w,0)*(1.0f/s); }
constexpr int SEQ=4096,D=64,DM=1024;
constexpr int NW=8,QBLK=32,QB=QBLK*NW,KVBLK=64,NQB=SEQ/QB;
constexpr int ATTN_PITCH=DM, ATTN_UNIT_ROWS=QB;
__device__ __forceinline__ int crow(int r,int hi){return (r&3)+8*(r>>2)+4*hi;}
#define SBAR() __builtin_amdgcn_sched_barrier(0)
__device__ __forceinline__ void cmask(f32x16&p0,f32x16&p1,int jb,int qrel,int hi){
  const float NEG=-INFINITY; int kb=64*jb+4*hi;
  #pragma unroll
  for(int r=0;r<16;++r){int kv=kb+(r&3)+8*(r>>2); if(kv>qrel)p0[r]=NEG; if(kv+32>qrel)p1[r]=NEG;}
}

constexpr int NSLOT=3, SLOTB=8192;
constexpr int LDS_K=0, LDS_V=NSLOT*SLOTB, LDS_WS=2*NSLOT*SLOTB, LDS_OST=LDS_WS+NW*64*4, LDS_BIAS=LDS_OST+NW*4096, LDS_BYTES=LDS_BIAS+SEQ*8;
constexpr float C2=0.125f*1.4426950408889634f;
__device__ __forceinline__ void glds16(const void*sbase,unsigned voff,unsigned lds_dst){unsigned keep;
  asm volatile("s_mov_b32 %0, m0\n\ts_mov_b32 m0, %3\n\ts_nop 2\n\tglobal_load_lds_dwordx4 %1, %2\n\ts_mov_b32 m0, %0":"=&s"(keep):"v"(voff),"s"(sbase),"s"(lds_dst):"memory");}
__device__ __forceinline__ float max3f(float a,float b,float c){float r;asm("v_max3_f32 %0, %1, %2, %3":"=v"(r):"v"(a),"v"(b),"v"(c));return r;}
__device__ __forceinline__ float max2f(float a,float b){float r;asm("v_max_f32_e32 %0, %1, %2":"=v"(r):"v"(a),"v"(b));return r;}
__device__ __forceinline__ float fadd_s(float a,float b){float r;asm("v_add_f32_e32 %0, %1, %2":"=v"(r):"v"(a),"v"(b));return r;}
__device__ __forceinline__ float fsub_s(float a,float b){float r;asm("v_sub_f32_e32 %0, %1, %2":"=v"(r):"v"(a),"v"(b));return r;}
typedef float f32x2_t __attribute__((ext_vector_type(2))); typedef __bf16 bf16x2_t __attribute__((ext_vector_type(2)));
__device__ __forceinline__ unsigned cvtpk_s(float lo,float hi){f32x2_t v={lo,hi};bf16x2_t b=__builtin_convertvector(v,bf16x2_t);return __builtin_bit_cast(unsigned,b);}
#define WAIT_BAR(N) asm volatile("s_waitcnt vmcnt(" #N ") lgkmcnt(0)\n\ts_barrier":::"memory")

__device__ __forceinline__ void qkt(f32x16&p0,f32x16&p1,const char*Kslot,const bf16x8*qr,int r32,int hi){
  const char*kb=Kslot+hi*1024+r32*16;
  #pragma unroll
  for(int d0=0;d0<4;++d0){
    const bf16x8 b0=*reinterpret_cast<const bf16x8*>(kb+d0*2048);
    const bf16x8 b1=*reinterpret_cast<const bf16x8*>(kb+d0*2048+512);
    {p0=__builtin_amdgcn_mfma_f32_32x32x16_bf16(b0,qr[d0],p0,0,0,0);p1=__builtin_amdgcn_mfma_f32_32x32x16_bf16(b1,qr[d0],p1,0,0,0);}}
}
typedef __attribute__((address_space(3))) const char* lds_cptr;
typedef short v4i16_t __attribute__((ext_vector_type(4)));
__device__ __forceinline__ void kload8(bf16x8*kf,lds_cptr kp){
  kf[0]=*(const __attribute__((address_space(3))) bf16x8*)(kp);      kf[1]=*(const __attribute__((address_space(3))) bf16x8*)(kp+512);
  kf[2]=*(const __attribute__((address_space(3))) bf16x8*)(kp+2048); kf[3]=*(const __attribute__((address_space(3))) bf16x8*)(kp+2560);
  kf[4]=*(const __attribute__((address_space(3))) bf16x8*)(kp+4096); kf[5]=*(const __attribute__((address_space(3))) bf16x8*)(kp+4608);
  kf[6]=*(const __attribute__((address_space(3))) bf16x8*)(kp+6144); kf[7]=*(const __attribute__((address_space(3))) bf16x8*)(kp+6656);
}
__device__ __forceinline__ void kload2(bf16x8*kf,lds_cptr kp,int j){ kf[2*j]=*(const __attribute__((address_space(3))) bf16x8*)(kp+j*2048); kf[2*j+1]=*(const __attribute__((address_space(3))) bf16x8*)(kp+j*2048+512); }
__device__ __forceinline__ s16x4 vtr(lds_cptr p){ return __builtin_bit_cast(s16x4,__builtin_amdgcn_ds_read_tr16_b64_v4i16((__attribute__((address_space(3))) v4i16_t*)p)); }
__device__ __forceinline__ float rowmax(const f32x16&p0,const f32x16&p1){
  float a=max3f(p0[0],p0[1],p1[0]),b=max3f(p0[2],p0[3],p1[1]);a=max3f(a,p1[2],p1[3]);
  #pragma unroll
  for(int r=4;r<16;r+=4){a=max3f(a,p0[r],p0[r+1]);b=max3f(b,p0[r+2],p0[r+3]);a=max3f(a,p1[r],p1[r+1]);b=max3f(b,p1[r+2],p1[r+3]);}
  const float m=max2f(a,b);
  auto rr=__builtin_amdgcn_permlane32_swap(__float_as_uint(m),__float_as_uint(m),false,false);
  return max2f(__uint_as_float(rr[0]),__uint_as_float(rr[1]));
}
__device__ __forceinline__ void pv(f32x16*o,int vb,bf16x8 pa0,bf16x8 pa1,bf16x8 pa2,bf16x8 pa3){
  #pragma unroll
  for(int d0=0;d0<2;++d0){s16x4 lo[4],hi[4];
    #pragma unroll
    for(int ks=0;ks<4;++ks){
      asm volatile("ds_read_b64_tr_b16 %0,%1 offset:%c2":"=&v"(lo[ks]):"v"(vb),"i"(d0*4096+ks*1024):"memory");
      asm volatile("ds_read_b64_tr_b16 %0,%1 offset:%c2":"=&v"(hi[ks]):"v"(vb),"i"(d0*4096+ks*1024+512):"memory");}
    asm volatile("s_waitcnt lgkmcnt(0)":::"memory");SBAR();
    #define PK(k) (bf16x8){lo[k][0],lo[k][1],lo[k][2],lo[k][3],hi[k][0],hi[k][1],hi[k][2],hi[k][3]}
    o[d0]=__builtin_amdgcn_mfma_f32_32x32x16_bf16(pa0,PK(0),o[d0],0,0,0);
    o[d0]=__builtin_amdgcn_mfma_f32_32x32x16_bf16(pa1,PK(1),o[d0],0,0,0);
    o[d0]=__builtin_amdgcn_mfma_f32_32x32x16_bf16(pa2,PK(2),o[d0],0,0,0);
    o[d0]=__builtin_amdgcn_mfma_f32_32x32x16_bf16(pa3,PK(3),o[d0],0,0,0);
    #undef PK
  }
}

#ifndef ATTN_STORE16
#define ATTN_STORE16(p,v) (*(u32x4*)(p)=(v))
#endif
typedef float f32x4v __attribute__((ext_vector_type(4)));
typedef unsigned u32x2v __attribute__((ext_vector_type(2)));
#define KAF(ka) __builtin_bit_cast(bf16x8,(u32x4){(ka)[0],(ka)[1],0x3F803F80u,0x00003F80u})
#define KAR(tt) do{ ka0=*(const __attribute__((address_space(3))) u32x2v*)(kap+(tt)*512); ka1=*(const __attribute__((address_space(3))) u32x2v*)(kap+(tt)*512+256); }while(0)
__device__ __forceinline__ float ka_value(u32x2v w){ return (__uint_as_float(w[0]<<16)+__uint_as_float(w[0]&0xffff0000u))+__uint_as_float(w[1]<<16); }
__device__ __forceinline__ u32x2v ka_split(float b){ const unsigned h=cvtpk_s(b,0.f)&0xffffu; const float r1=b-__uint_as_float(h<<16); const unsigned m=cvtpk_s(r1,0.f)&0xffffu; const float r2=r1-__uint_as_float(m<<16); const unsigned l=cvtpk_s(r2,0.f)&0xffffu; return (u32x2v){h|(m<<16),l}; }
template<int THRL,class CF> __device__ __forceinline__ void attn_unit(int qb,int t0,const bf16*Qb,const bf16*__restrict__ Kb,const bf16*__restrict__ Vb,bf16*Ob,char*shm,const int tid,const float bh,const float osc,const CF&cf){
  const int lane=tid&63,r32=lane&31,hi=lane>>5; const int wid=__builtin_amdgcn_readfirstlane(tid>>6);
  const int q0=qb*QB;
  const bf16*Qw=Qb+(long)(q0+wid*QBLK)*DM;
  const bf16*Kh=Kb+(long)t0*KVBLK*DM,*Vh=Vb+(long)t0*KVBLK*DM;
  const unsigned lds0=(unsigned)(uintptr_t)shm;
  float*wsf=(float*)(shm+LDS_WS)+wid*64;
  const unsigned ksrc=(unsigned)(lane*DM+wid*8)*2u;
  const unsigned vsrc=(unsigned)((16*(wid&3)+(lane>>2))*DM+(wid>>2)*32+(lane&3)*8)*2u;
  const unsigned kdst=lds0+LDS_K+wid*1024, vdst=lds0+LDS_V+wid*1024;
  #define DMA_K(t,slot) glds16(Kh+(long)(t)*KVBLK*DM,ksrc,(unsigned)__builtin_amdgcn_readfirstlane(kdst+(slot)))
  #define DMA_V(t,slot) glds16(Vh+(long)(t)*KVBLK*DM,vsrc,(unsigned)__builtin_amdgcn_readfirstlane(vdst+(slot)))
  const int vb0=(int)(lds0+LDS_V)+((lane>>4)&1)*32+(lane&3)*8+(4*hi+((lane&15)>>2))*64;
  const char*Kbase=shm+LDS_K; bf16x8 kf[8];
  const lds_cptr shm3=(lds_cptr)shm; const lds_cptr kap=shm3+LDS_BIAS+t0*512+r32*8; const lds_cptr kp0=shm3+LDS_K+hi*1024+r32*16; const lds_cptr vp0=shm3+LDS_V+((lane>>4)&1)*32+(lane&3)*8+(4*hi+((lane&15)>>2))*64;
  const int NT=(q0+QB)/KVBLK-t0;
  DMA_K(0,0);DMA_V(0,0);DMA_K(1,SLOTB);
  bf16x8 qr[4];
  #pragma unroll
  for(int d0=0;d0<4;++d0)qr[d0]=*reinterpret_cast<const bf16x8*>(&Qw[(long)r32*DM+d0*16+hi*8]);
  float z_=0.f;asm volatile("":"+v"(z_));float l_reg=z_;f32x16 o[2];
  const float mhat=ka_value(*(const __attribute__((address_space(3))) u32x2v*)((lds_cptr)shm+LDS_BIAS+(q0+wid*QBLK+r32)*8))+bh;
  bf16x8 qa; { const u32x2v nm=ka_split(-mhat); const u32x4 w=hi==0?(u32x4){0x3F803F80u,0x00003F80u,nm[0],nm[1]}:(u32x4){0u,0u,0u,0u}; qa=__builtin_bit_cast(bf16x8,w); }
  u32x2v ka0,ka1;
  #pragma unroll
  for(int r=0;r<16;++r){o[0][r]=z_;o[1][r]=z_;}
  const int qrel=wid*QBLK+r32;
  #define CMASK(P0,P1,t) do{int jb_=(t)-(NT-4); if(jb_>=0)cmask(P0,P1,jb_,qrel,hi);}while(0)
  #define START(P0,P1) do{ _Pragma("unroll") for(int r=0;r<16;++r)P0[r]=__builtin_amdgcn_exp2f(P0[r]); }while(0)
  #define RESC() do{}while(0)
  f32x16 pA0,pA1,pB0,pB1;
  int sl_prev=0,sl_cur=0,sl_next=SLOTB;
  #define ROT() do{sl_prev=sl_cur;sl_cur=sl_next;sl_next=(sl_next==(NSLOT-1)*SLOTB)?0:sl_next+SLOTB;}while(0)
  DMA_K(2,2*SLOTB);
  WAIT_BAR(3);
  KAR(0); pA0=__builtin_amdgcn_mfma_f32_32x32x16_bf16(KAF(ka0),qa,f32x16{},0,0,0); pA1=__builtin_amdgcn_mfma_f32_32x32x16_bf16(KAF(ka1),qa,f32x16{},0,0,0);
  qkt(pA0,pA1,Kbase,qr,r32,hi);asm volatile("s_nop 15\n\ts_nop 7":"+v"(pA0),"+v"(pA1));CMASK(pA0,pA1,0);
  START(pA0,pA1);
  _Pragma("unroll") for(int r=0;r<16;++r)pA1[r]=__builtin_amdgcn_exp2f(pA1[r]);
  WAIT_BAR(0);
  DMA_K(3,0);DMA_V(1,SLOTB);
  ROT();
  kload8(kf,kp0+sl_cur); KAR(1);
  WAIT_BAR(2);
  s16x4 vlo[8],vhi[8]; u32x4 pw0,pw1,pw2,pw3;
  #define PKW(P,B) cvtpk_s(P[B],P[B+1])
  #define PAF(k) __builtin_bit_cast(bf16x8,pw##k)
  #define VFR(i) (bf16x8){vlo[i][0],vlo[i][1],vlo[i][2],vlo[i][3],vhi[i][0],vhi[i][1],vhi[i][2],vhi[i][3]}
  #define PIN(x) asm volatile("":"+v"(x))
  #define MX3(a,b,c) __builtin_fmaxf(__builtin_fmaxf((a),(b)),(c))
  #define GAPA(MF,A0,A1,A2,A3,W0,W1,PW) do{ MF; sacc+=A0; sacc+=A1; sacc+=A2; sacc+=A3; PIN(sacc); W0; W1; PIN(PW); SBAR(); }while(0)
  #define EX(v) __builtin_amdgcn_exp2f(v)
  #define GAPB(MF,X,B) do{ MF; X[B]=EX(X[B]); X[B+1]=EX(X[B+1]); X[B+2]=EX(X[B+2]); X[B+3]=EX(X[B+3]); PIN(X); SBAR(); }while(0)
  #define VRD(i) do{ vlo[i]=vtr(vp_+(((i)>>2)*4096+((i)&3)*1024)); vhi[i]=vtr(vp_+(((i)>>2)*4096+((i)&3)*1024+512)); }while(0)
  #define KRD(G,j) do{ if(G){ kload2(kf,kp0+sl_next,j); SBAR(); } }while(0)
  #define STEP(C0,C1,P0,P1,t,GK,GV,GL) do{ SBAR(); \
    const lds_cptr vp_=vp0+sl_prev; \
    C0=__builtin_amdgcn_mfma_f32_32x32x16_bf16(KAF(ka0),qa,f32x16{},0,0,0); C1=__builtin_amdgcn_mfma_f32_32x32x16_bf16(KAF(ka1),qa,f32x16{},0,0,0); SBAR(); \
    VRD(0); SBAR(); float sacc=(P0[0]+P0[1]); \
    GAPA(C0=__builtin_amdgcn_mfma_f32_32x32x16_bf16(kf[0],qr[0],C0,0,0,0), P0[2],P0[3],P0[4],P0[5],     pw0[0]=PKW(P0,0), pw0[1]=PKW(P0,2), pw0); \
    VRD(4); SBAR(); GAPA(C1=__builtin_amdgcn_mfma_f32_32x32x16_bf16(kf[1],qr[0],C1,0,0,0), P0[6],P0[7],P0[8],P0[9],     pw0[2]=PKW(P0,4), pw0[3]=PKW(P0,6), pw0); \
    VRD(1); SBAR(); GAPA(C0=__builtin_amdgcn_mfma_f32_32x32x16_bf16(kf[2],qr[1],C0,0,0,0),   P0[10],P0[11],P0[12],P0[13], pw1[0]=PKW(P0,8), pw1[1]=PKW(P0,10), pw1); \
    VRD(5); SBAR(); GAPA(C1=__builtin_amdgcn_mfma_f32_32x32x16_bf16(kf[3],qr[1],C1,0,0,0),   P0[14],P0[15],P1[0],P1[1],   pw1[2]=PKW(P0,12),pw1[3]=PKW(P0,14), pw1); \
    VRD(2); SBAR(); GAPA(C0=__builtin_amdgcn_mfma_f32_32x32x16_bf16(kf[4],qr[2],C0,0,0,0),   P1[2],P1[3],P1[4],P1[5],     pw2[0]=PKW(P1,0), pw2[1]=PKW(P1,2), pw2); \
    VRD(6); SBAR(); GAPA(C1=__builtin_amdgcn_mfma_f32_32x32x16_bf16(kf[5],qr[2],C1,0,0,0),   P1[6],P1[7],P1[8],P1[9],     pw2[2]=PKW(P1,4), pw2[3]=PKW(P1,6), pw2); \
    VRD(3); SBAR(); GAPA(C0=__builtin_amdgcn_mfma_f32_32x32x16_bf16(kf[6],qr[3],C0,0,0,0),   P1[10],P1[11],P1[12],P1[13], pw3[0]=PKW(P1,8), pw3[1]=PKW(P1,10), pw3); \
    VRD(7); SBAR(); GAPA(C1=__builtin_amdgcn_mfma_f32_32x32x16_bf16(kf[7],qr[3],C1,0,0,0),   P1[14],P1[15],0.f,0.f,       pw3[2]=PKW(P1,12),pw3[3]=PKW(P1,14), pw3); \
    l_reg+=sacc; \
    if(GK){DMA_K((t)+3,sl_cur);} if(GV){DMA_V((t)+1,sl_next);} \
    CMASK(C0,C1,t); \
    SBAR(); \
    GAPB(o[0]=__builtin_amdgcn_mfma_f32_32x32x16_bf16(PAF(0),VFR(0),o[0],0,0,0), C0,0); \
    GAPB(o[1]=__builtin_amdgcn_mfma_f32_32x32x16_bf16(PAF(0),VFR(4),o[1],0,0,0), C0,4); \
    if(GL){KAR((t)+1);} KRD(GL,0); GAPB(o[0]=__builtin_amdgcn_mfma_f32_32x32x16_bf16(PAF(1),VFR(1),o[0],0,0,0), C0,8); \
    KRD(GL,1); GAPB(o[1]=__builtin_amdgcn_mfma_f32_32x32x16_bf16(PAF(1),VFR(5),o[1],0,0,0), C0,12); \
    KRD(GL,2); GAPB(o[0]=__builtin_amdgcn_mfma_f32_32x32x16_bf16(PAF(2),VFR(2),o[0],0,0,0), C1,0); \
    KRD(GL,3); GAPB(o[1]=__builtin_amdgcn_mfma_f32_32x32x16_bf16(PAF(2),VFR(6),o[1],0,0,0), C1,4); \
    GAPB(o[0]=__builtin_amdgcn_mfma_f32_32x32x16_bf16(PAF(3),VFR(3),o[0],0,0,0), C1,8); \
    GAPB(o[1]=__builtin_amdgcn_mfma_f32_32x32x16_bf16(PAF(3),VFR(7),o[1],0,0,0), C1,12); \
    }while(0)
  int t=1;
  #undef CMASK
  #define CMASK(P0,P1,t) do{}while(0)
  for(;t+5<NT;t+=2){
    STEP(pB0,pB1,pA0,pA1,t,true,true,true);     WAIT_BAR(2); RESC(); ROT();
    STEP(pA0,pA1,pB0,pB1,t+1,true,true,true);   WAIT_BAR(2); RESC(); ROT();
  }
  #undef CMASK
  #define CMASK(P0,P1,t) do{int jb_=(t)-(NT-4); if(jb_>=0)cmask(P0,P1,jb_,qrel,hi);}while(0)
  #define ENDW(tt) do{ if((tt)+3<NT){WAIT_BAR(2);} else if((tt)+2<NT){WAIT_BAR(1);} else {WAIT_BAR(0);} }while(0)
  for(;t+1<NT;t+=2){
    STEP(pB0,pB1,pA0,pA1,t,(t+3<NT),(t+1<NT),(t+1<NT));       ENDW(t);   RESC(); ROT();
    STEP(pA0,pA1,pB0,pB1,t+1,(t+4<NT),(t+2<NT),(t+2<NT));     ENDW(t+1); RESC(); ROT();
  }
  STEP(pB0,pB1,pA0,pA1,NT-1,false,false,false); RESC();
  float cv[32]; cf.issue(cv,lane,wid);
  { float sacc=pB0[0]+pB0[1]; _Pragma("unroll") for(int r=2;r<16;++r)sacc+=pB0[r]; _Pragma("unroll") for(int r=0;r<16;++r)sacc+=pB1[r]; l_reg+=sacc;
    pw0=(u32x4){PKW(pB0,0),PKW(pB0,2),PKW(pB0,4),PKW(pB0,6)};pw1=(u32x4){PKW(pB0,8),PKW(pB0,10),PKW(pB0,12),PKW(pB0,14)};pw2=(u32x4){PKW(pB1,0),PKW(pB1,2),PKW(pB1,4),PKW(pB1,6)};pw3=(u32x4){PKW(pB1,8),PKW(pB1,10),PKW(pB1,12),PKW(pB1,14)};
    SBAR(); pv(o,vb0+sl_cur,PAF(0),PAF(1),PAF(2),PAF(3)); }
  #undef PKW
  #undef PAF
  #undef VFR
  #undef PIN
  #undef MX3
  #undef GAPA
  #undef GAPB
  #undef EX
  #undef VRD
  #undef KRD
  #undef STEP
  #undef ENDW
  {auto rr=__builtin_amdgcn_permlane32_swap(__float_as_uint(l_reg),__float_as_uint(l_reg),false,false);l_reg=__uint_as_float(rr[0])+__uint_as_float(rr[1]);}
  if(hi==0)wsf[32+r32]=l_reg;asm volatile("s_waitcnt lgkmcnt(0)":::"memory");
  float rli[16];
  #pragma unroll
  for(int r=0;r<16;++r)rli[r]=__builtin_amdgcn_rcpf(wsf[32+crow(r,hi)]);
  { unsigned char*stg=(unsigned char*)(shm+LDS_OST)+wid*4096;
    unsigned char*Ow8=(unsigned char*)Ob+(long)(q0+wid*QBLK)*DM;
    #pragma unroll
    for(int r=0;r<16;++r){const int orow=crow(r,hi); const float s_=rli[r]*osc;
      #pragma unroll
      for(int d0=0;d0<2;++d0)stg[orow*64+d0*32+r32]=(unsigned char)(__builtin_amdgcn_cvt_pk_fp8_f32(o[d0][r]*s_,0.f,0u,false)&0xffu);}
    asm volatile("s_waitcnt lgkmcnt(0)":::"memory");
    #pragma unroll
    for(int i=0;i<2;++i){const int row=i*16+(lane>>2),ch=lane&3; const u32x4 v=*(const u32x4*)(stg+row*64+ch*16); ATTN_STORE16(Ow8+(long)row*DM+ch*16,v);} }
  asm volatile("s_waitcnt lgkmcnt(0)\n\ts_barrier":::"memory");
  cf.finish(cv,lane,wid);
  #undef DMA_K
  #undef DMA_V
  #undef CMASK
  #undef START
  #undef RESC
  #undef ROT
}

constexpr int V128_SLOTB=16384, LDS128_K=0, LDS128_V=NSLOT*SLOTB, LDS128_WS=LDS128_V+NSLOT*V128_SLOTB, LDS128_OST=LDS128_WS+NW*64*4, LDS128_BIAS=LDS128_OST+NW*4096, LDS128_BYTES=LDS128_BIAS+SEQ*8;
__device__ __forceinline__ void pv4(f32x16*o,int vb,bf16x8 pa0,bf16x8 pa1,bf16x8 pa2,bf16x8 pa3){
  #pragma unroll
  for(int d0=0;d0<4;++d0){s16x4 lo[4],hi[4];
    #pragma unroll
    for(int ks=0;ks<4;++ks){
      asm volatile("ds_read_b64_tr_b16 %0,%1 offset:%c2":"=&v"(lo[ks]):"v"(vb),"i"(d0*4096+ks*1024):"memory");
      asm volatile("ds_read_b64_tr_b16 %0,%1 offset:%c2":"=&v"(hi[ks]):"v"(vb),"i"(d0*4096+ks*1024+512):"memory");}
    asm volatile("s_waitcnt lgkmcnt(0)":::"memory");SBAR();
    #define PK(k) (bf16x8){lo[k][0],lo[k][1],lo[k][2],lo[k][3],hi[k][0],hi[k][1],hi[k][2],hi[k][3]}
    o[d0]=__builtin_amdgcn_mfma_f32_32x32x16_bf16(pa0,PK(0),o[d0],0,0,0);
    o[d0]=__builtin_amdgcn_mfma_f32_32x32x16_bf16(pa1,PK(1),o[d0],0,0,0);
    o[d0]=__builtin_amdgcn_mfma_f32_32x32x16_bf16(pa2,PK(2),o[d0],0,0,0);
    o[d0]=__builtin_amdgcn_mfma_f32_32x32x16_bf16(pa3,PK(3),o[d0],0,0,0);
    #undef PK
  }
}
template<class CF> __device__ __forceinline__ void attn_unit128(int qb,int t0,const bf16*Qb,const bf16*__restrict__ Kb,const bf16*__restrict__ Vb,bf16*Ob,char*shm,const int tid,const float bh,const int comb,unsigned char*Oc,const float*lamp,const float*gnorm,const float post,const float eps,const CF&cf){
  const int lane=tid&63,r32=lane&31,hi=lane>>5; const int wid=__builtin_amdgcn_readfirstlane(tid>>6);
  const int q0=qb*QB;
  const bf16*Qw=Qb+(long)(q0+wid*QBLK)*DM;
  const bf16*Kh=Kb+(long)t0*KVBLK*DM,*Vh=Vb+(long)t0*KVBLK*DM;
  const unsigned lds0=(unsigned)(uintptr_t)shm;
  float*wsf=(float*)(shm+LDS128_WS)+wid*64;
  const unsigned ksrc=(unsigned)(lane*DM+wid*8)*2u;
  const unsigned vsrc=(unsigned)((16*(wid&3)+(lane>>2))*DM+(wid>>2)*32+(lane&3)*8)*2u;
  const unsigned kdst=lds0+LDS128_K+wid*1024, vdst=lds0+LDS128_V+wid*1024;
  #define DMA_K(t,slot) glds16(Kh+(long)(t)*KVBLK*DM,ksrc,(unsigned)__builtin_amdgcn_readfirstlane(kdst+(slot)))
  #define DMA_V(t,slot) do{ glds16(Vh+(long)(t)*KVBLK*DM,vsrc,(unsigned)__builtin_amdgcn_readfirstlane(vdst+2*(slot))); glds16(Vh+(long)(t)*KVBLK*DM+64,vsrc,(unsigned)__builtin_amdgcn_readfirstlane(vdst+2*(slot)+8192)); }while(0)
  const int vb0=(int)(lds0+LDS128_V)+((lane>>4)&1)*32+(lane&3)*8+(4*hi+((lane&15)>>2))*64;
  const char*Kbase=shm+LDS128_K; bf16x8 kf[8];
  const lds_cptr shm3=(lds_cptr)shm; const lds_cptr kap=shm3+LDS128_BIAS+t0*512+r32*8; const lds_cptr kp0=shm3+LDS128_K+hi*1024+r32*16; const lds_cptr vp0=shm3+LDS128_V+((lane>>4)&1)*32+(lane&3)*8+(4*hi+((lane&15)>>2))*64;
  const int NT=(q0+QB)/KVBLK-t0;
  DMA_K(0,0);DMA_V(0,0);DMA_K(1,SLOTB);
  bf16x8 qr[4];
  #pragma unroll
  for(int d0=0;d0<4;++d0)qr[d0]=*reinterpret_cast<const bf16x8*>(&Qw[(long)r32*DM+d0*16+hi*8]);
  float z_=0.f;asm volatile("":"+v"(z_));float l_reg=z_;f32x16 o[4];
  const float mhat=ka_value(*(const __attribute__((address_space(3))) u32x2v*)((lds_cptr)shm+LDS128_BIAS+(q0+wid*QBLK+r32)*8))+bh;
  bf16x8 qa; { const u32x2v nm=ka_split(-mhat); const u32x4 w=hi==0?(u32x4){0x3F803F80u,0x00003F80u,nm[0],nm[1]}:(u32x4){0u,0u,0u,0u}; qa=__builtin_bit_cast(bf16x8,w); }
  u32x2v ka0,ka1;
  #pragma unroll
  for(int r=0;r<16;++r){o[0][r]=z_;o[1][r]=z_;o[2][r]=z_;o[3][r]=z_;}
  const int qrel=wid*QBLK+r32;
  #define CMASK(P0,P1,t) do{int jb_=(t)-(NT-4); if(jb_>=0)cmask(P0,P1,jb_,qrel,hi);}while(0)
  f32x16 C0,C1;
  int sl_prev=0,sl_cur=0,sl_next=SLOTB;
  #define ROT() do{sl_prev=sl_cur;sl_cur=sl_next;sl_next=(sl_next==(NSLOT-1)*SLOTB)?0:sl_next+SLOTB;}while(0)
  DMA_K(2,2*SLOTB);
  WAIT_BAR(4);
  s16x4 vlo[8],vhi[8]; u32x4 pwA0,pwA1,pwA2,pwA3,pwB0,pwB1,pwB2,pwB3;
  #define PKW(P,B) cvtpk_s(P[B],P[B+1])
  #define PAF(S,k) __builtin_bit_cast(bf16x8,pw##S##k)
  #define VFR(i) (bf16x8){vlo[i][0],vlo[i][1],vlo[i][2],vlo[i][3],vhi[i][0],vhi[i][1],vhi[i][2],vhi[i][3]}
  #define PIN(x) asm volatile("":"+v"(x))
  #define EX(v) __builtin_amdgcn_exp2f(v)
  KAR(0); C0=__builtin_amdgcn_mfma_f32_32x32x16_bf16(KAF(ka0),qa,f32x16{},0,0,0); C1=__builtin_amdgcn_mfma_f32_32x32x16_bf16(KAF(ka1),qa,f32x16{},0,0,0);
  qkt(C0,C1,Kbase,qr,r32,hi);asm volatile("s_nop 15\n\ts_nop 7":"+v"(C0),"+v"(C1));CMASK(C0,C1,0);
  { float sacc=z_;
    _Pragma("unroll") for(int r=0;r<16;++r){C0[r]=EX(C0[r]);C1[r]=EX(C1[r]);}
    _Pragma("unroll") for(int r=0;r<16;++r){sacc+=C0[r];sacc+=C1[r];}
    l_reg+=sacc;
    pwA0=(u32x4){PKW(C0,0),PKW(C0,2),PKW(C0,4),PKW(C0,6)};pwA1=(u32x4){PKW(C0,8),PKW(C0,10),PKW(C0,12),PKW(C0,14)};pwA2=(u32x4){PKW(C1,0),PKW(C1,2),PKW(C1,4),PKW(C1,6)};pwA3=(u32x4){PKW(C1,8),PKW(C1,10),PKW(C1,12),PKW(C1,14)}; }
  WAIT_BAR(0);
  DMA_K(3,0);DMA_V(1,SLOTB);
  ROT();
  kload8(kf,kp0+sl_cur); KAR(1);
  WAIT_BAR(3);
  #define VRD(i) do{ vlo[i]=vtr(vp_+(((i)>>2)*4096+((i)&3)*1024)); vhi[i]=vtr(vp_+(((i)>>2)*4096+((i)&3)*1024+512)); }while(0)
  #define VRD2(i) do{ vlo[i]=vtr(vp_+((2+((i)>>2))*4096+((i)&3)*1024)); vhi[i]=vtr(vp_+((2+((i)>>2))*4096+((i)&3)*1024+512)); }while(0)
  #define KRD(G,j) do{ if(G){ kload2(kf,kp0+sl_next,j); SBAR(); } }while(0)
  #define QKG(V,MF) do{ VRD(V); SBAR(); MF; SBAR(); }while(0)
  #define GB(MF,X,B,W,AFTER) do{ MF; { const float e0_=EX(X[B]), e1_=EX(X[B+1]); sacc+=e0_; sacc+=e1_; W=cvtpk_s(e0_,e1_); } PIN(sacc); PIN(W); AFTER; SBAR(); }while(0)
  #define STEP128(P,N,t,GK,GV,GL) do{ SBAR(); \
    const lds_cptr vp_=vp0+2*sl_prev; \
    C0=__builtin_amdgcn_mfma_f32_32x32x16_bf16(KAF(ka0),qa,f32x16{},0,0,0); C1=__builtin_amdgcn_mfma_f32_32x32x16_bf16(KAF(ka1),qa,f32x16{},0,0,0); SBAR(); \
    QKG(0,C0=__builtin_amdgcn_mfma_f32_32x32x16_bf16(kf[0],qr[0],C0,0,0,0)); \
    QKG(4,C1=__builtin_amdgcn_mfma_f32_32x32x16_bf16(kf[1],qr[0],C1,0,0,0)); \
    QKG(1,C0=__builtin_amdgcn_mfma_f32_32x32x16_bf16(kf[2],qr[1],C0,0,0,0)); \
    QKG(5,C1=__builtin_amdgcn_mfma_f32_32x32x16_bf16(kf[3],qr[1],C1,0,0,0)); \
    QKG(2,C0=__builtin_amdgcn_mfma_f32_32x32x16_bf16(kf[4],qr[2],C0,0,0,0)); \
    QKG(6,C1=__builtin_amdgcn_mfma_f32_32x32x16_bf16(kf[5],qr[2],C1,0,0,0)); \
    QKG(3,C0=__builtin_amdgcn_mfma_f32_32x32x16_bf16(kf[6],qr[3],C0,0,0,0)); \
    QKG(7,C1=__builtin_amdgcn_mfma_f32_32x32x16_bf16(kf[7],qr[3],C1,0,0,0)); \
    if(GK){DMA_K((t)+3,sl_cur);} if(GV){DMA_V((t)+1,sl_next);} \
    CMASK(C0,C1,t); \
    SBAR(); \
    float sacc=z_; \
    GB(o[0]=__builtin_amdgcn_mfma_f32_32x32x16_bf16(PAF(P,0),VFR(0),o[0],0,0,0), C0,0, pw##N##0[0], VRD2(0)); \
    GB(o[1]=__builtin_amdgcn_mfma_f32_32x32x16_bf16(PAF(P,0),VFR(4),o[1],0,0,0), C0,2, pw##N##0[1], VRD2(4)); \
    GB(o[0]=__builtin_amdgcn_mfma_f32_32x32x16_bf16(PAF(P,1),VFR(1),o[0],0,0,0), C0,4, pw##N##0[2], VRD2(1)); \
    GB(o[1]=__builtin_amdgcn_mfma_f32_32x32x16_bf16(PAF(P,1),VFR(5),o[1],0,0,0), C0,6, pw##N##0[3], VRD2(5)); \
    GB(o[0]=__builtin_amdgcn_mfma_f32_32x32x16_bf16(PAF(P,2),VFR(2),o[0],0,0,0), C0,8, pw##N##1[0], VRD2(2)); \
    GB(o[1]=__builtin_amdgcn_mfma_f32_32x32x16_bf16(PAF(P,2),VFR(6),o[1],0,0,0), C0,10,pw##N##1[1], VRD2(6)); \
    GB(o[0]=__builtin_amdgcn_mfma_f32_32x32x16_bf16(PAF(P,3),VFR(3),o[0],0,0,0), C0,12,pw##N##1[2], VRD2(3)); \
    GB(o[1]=__builtin_amdgcn_mfma_f32_32x32x16_bf16(PAF(P,3),VFR(7),o[1],0,0,0), C0,14,pw##N##1[3], VRD2(7)); \
    GB(o[2]=__builtin_amdgcn_mfma_f32_32x32x16_bf16(PAF(P,0),VFR(0),o[2],0,0,0), C1,0, pw##N##2[0], if(GL){KAR((t)+1);}); \
    GB(o[3]=__builtin_amdgcn_mfma_f32_32x32x16_bf16(PAF(P,0),VFR(4),o[3],0,0,0), C1,2, pw##N##2[1], KRD(GL,0)); \
    GB(o[2]=__builtin_amdgcn_mfma_f32_32x32x16_bf16(PAF(P,1),VFR(1),o[2],0,0,0), C1,4, pw##N##2[2], KRD(GL,1)); \
    GB(o[3]=__builtin_amdgcn_mfma_f32_32x32x16_bf16(PAF(P,1),VFR(5),o[3],0,0,0), C1,6, pw##N##2[3], KRD(GL,2)); \
    GB(o[2]=__builtin_amdgcn_mfma_f32_32x32x16_bf16(PAF(P,2),VFR(2),o[2],0,0,0), C1,8, pw##N##3[0], KRD(GL,3)); \
    GB(o[3]=__builtin_amdgcn_mfma_f32_32x32x16_bf16(PAF(P,2),VFR(6),o[3],0,0,0), C1,10,pw##N##3[1], (void)0); \
    GB(o[2]=__builtin_amdgcn_mfma_f32_32x32x16_bf16(PAF(P,3),VFR(3),o[2],0,0,0), C1,12,pw##N##3[2], (void)0); \
    GB(o[3]=__builtin_amdgcn_mfma_f32_32x32x16_bf16(PAF(P,3),VFR(7),o[3],0,0,0), C1,14,pw##N##3[3], (void)0); \
    l_reg+=sacc; \
    }while(0)
  int t=1;
  #undef CMASK
  #define CMASK(P0,P1,t) do{}while(0)
  for(;t+5<NT;t+=2){
    STEP128(A,B,t,true,true,true);     WAIT_BAR(3); ROT();
    STEP128(B,A,t+1,true,true,true);   WAIT_BAR(3); ROT();
  }
  #undef CMASK
  #define CMASK(P0,P1,t) do{int jb_=(t)-(NT-4); if(jb_>=0)cmask(P0,P1,jb_,qrel,hi);}while(0)
  #define ENDW(tt) do{ if((tt)+3<NT){WAIT_BAR(3);} else if((tt)+2<NT){WAIT_BAR(2);} else {WAIT_BAR(0);} }while(0)
  for(;t+1<NT;t+=2){
    STEP128(A,B,t,(t+3<NT),(t+1<NT),(t+1<NT));       ENDW(t);   ROT();
    STEP128(B,A,t+1,(t+4<NT),(t+2<NT),(t+2<NT));     ENDW(t+1); ROT();
  }
  STEP128(A,B,NT-1,false,false,false);
  float cv[32]; cf.issue(cv,lane,wid);
  bf16*Ow=Ob+(long)(q0+wid*QBLK)*DM;
  u32x4 v1r[2][4]; f32x4v gr[2][2];
  if(comb){
    #pragma unroll
    for(int hf=0;hf<2;++hf){
      #pragma unroll
      for(int i=0;i<4;++i)v1r[hf][i]=*(const u32x4*)(Ow+(long)(i*8+(lane>>3))*DM+hf*64+(lane&7)*8);
      gr[hf][0]=*(const f32x4v*)(gnorm+hf*64+(lane&7)*8); gr[hf][1]=*(const f32x4v*)(gnorm+hf*64+(lane&7)*8+4); } }
  SBAR(); pv4(o,vb0+2*sl_cur,PAF(B,0),PAF(B,1),PAF(B,2),PAF(B,3));
  #undef PKW
  #undef PAF
  #undef VFR
  #undef PIN
  #undef EX
  #undef VRD
  #undef VRD2
  #undef KRD
  #undef QKG
  #undef GB
  #undef STEP128
  #undef ENDW
  {auto rr=__builtin_amdgcn_permlane32_swap(__float_as_uint(l_reg),__float_as_uint(l_reg),false,false);l_reg=__uint_as_float(rr[0])+__uint_as_float(rr[1]);}
  if(hi==0)wsf[32+r32]=l_reg;asm volatile("s_waitcnt lgkmcnt(0)":::"memory");
  float rli[16];
  #pragma unroll
  for(int r=0;r<16;++r)rli[r]=__builtin_amdgcn_rcpf(wsf[32+crow(r,hi)]);
  if(!comb){
  #pragma unroll
  for(int hf=0;hf<2;++hf){ bf16*stg=(bf16*)(shm+LDS128_OST)+wid*2048;
    #pragma unroll
    for(int r=0;r<16;++r){const int orow=crow(r,hi);
      #pragma unroll
      for(int d0=0;d0<2;++d0)stg[orow*64+d0*32+r32]=__float2bfloat16(o[2*hf+d0][r]*rli[r]);}
    asm volatile("s_waitcnt lgkmcnt(0)":::"memory");
    #pragma unroll
    for(int i=0;i<4;++i){const int row=i*8+(lane>>3),ch=lane&7; const u32x4 v=*(const u32x4*)(stg+row*64+ch*8); ATTN_STORE16(Ow+(long)row*DM+hf*64+ch*8,v);}
    asm volatile("s_waitcnt lgkmcnt(0)":::"memory"); }
  } else {
    unsigned char*Ocw=Oc+(long)(q0+wid*QBLK)*DM;
    float dd[2][4][8]; float ss[4]={0.f,0.f,0.f,0.f}; const float lam=*lamp;
    #pragma unroll
    for(int hf=0;hf<2;++hf){ bf16*stg=(bf16*)(shm+LDS128_OST)+wid*2048;
      #pragma unroll
      for(int r=0;r<16;++r){const int orow=crow(r,hi);
        #pragma unroll
        for(int d0=0;d0<2;++d0)stg[orow*64+d0*32+r32]=__float2bfloat16(o[2*hf+d0][r]*rli[r]);}
      asm volatile("s_waitcnt lgkmcnt(0)":::"memory");
      #pragma unroll
      for(int i=0;i<4;++i){const int row=i*8+(lane>>3),ch=lane&7; const u32x4 v2=*(const u32x4*)(stg+row*64+ch*8); const u32x4 v1=v1r[hf][i];
        #pragma unroll
        for(int k=0;k<4;++k){ const float a0=__uint_as_float(v1[k]<<16),a1=__uint_as_float(v1[k]&0xffff0000u),b0=__uint_as_float(v2[k]<<16),b1=__uint_as_float(v2[k]&0xffff0000u);
          const float d0_=a0-b0*lam,d1_=a1-b1*lam; dd[hf][i][2*k]=d0_; dd[hf][i][2*k+1]=d1_; ss[i]+=d0_*d0_; ss[i]+=d1_*d1_; } }
      asm volatile("s_waitcnt lgkmcnt(0)":::"memory"); }
    float gg[2][8];
    #pragma unroll
    for(int hf=0;hf<2;++hf){ const f32x4v g0=gr[hf][0], g1=gr[hf][1];
      #pragma unroll
      for(int k=0;k<4;++k){gg[hf][k]=g0[k]*post;gg[hf][4+k]=g1[k]*post;} }
    #pragma unroll
    for(int i=0;i<4;++i){ float s_=ss[i];
      s_+=__uint_as_float((unsigned)__builtin_amdgcn_ds_bpermute((lane^1)<<2,(int)__float_as_uint(s_)));
      s_+=__uint_as_float((unsigned)__builtin_amdgcn_ds_bpermute((lane^2)<<2,(int)__float_as_uint(s_)));
      s_+=__uint_as_float((unsigned)__builtin_amdgcn_ds_bpermute((lane^4)<<2,(int)__float_as_uint(s_)));
      const float rn=1.0f/sqrtf(s_*(1.0f/128.0f)+eps);
      const int row=i*8+(lane>>3),ch=lane&7;
      #pragma unroll
      for(int hf=0;hf<2;++hf){ float e[8];
        #pragma unroll
        for(int k=0;k<8;++k)e[k]=dd[hf][i][k]*rn*gg[hf][k];
        unsigned w0=__builtin_amdgcn_cvt_pk_fp8_f32(e[0],e[1],0u,false); w0=__builtin_amdgcn_cvt_pk_fp8_f32(e[2],e[3],w0,true);
        unsigned w1=__builtin_amdgcn_cvt_pk_fp8_f32(e[4],e[5],0u,false); w1=__builtin_amdgcn_cvt_pk_fp8_f32(e[6],e[7],w1,true);
        *(u32x2v*)(Ocw+(long)row*DM+hf*64+ch*8)=(u32x2v){w0,w1}; } }
  }
  asm volatile("s_waitcnt lgkmcnt(0)\n\ts_barrier":::"memory");
  cf.finish(cv,lane,wid);
  #undef DMA_K
  #undef DMA_V
  #undef CMASK
  #undef ROT
}
constexpr int ATTN_LDS_BYTES=LDS_BYTES;
#undef SBAR
#undef WAIT_BAR
}


#ifndef CONV_PER_WAVE
#define CONV_PER_WAVE 6
#endif
#ifndef ABLP
#define ABLP 0
#endif
#ifndef REP_ATTN
#define REP_ATTN 1
#endif
#ifndef REP_P1
#define REP_P1 1
#endif
#ifndef REP_P3
#define REP_P3 1
#endif
#ifndef REP_P5
#define REP_P5 1
#endif
#ifndef REP_P6
#define REP_P6 1
#endif
#ifndef REP_LN1
#define REP_LN1 1
#endif
#ifndef REP_LN2
#define REP_LN2 1
#endif
#ifndef REP_COMB
#define REP_COMB 1
#endif
#ifndef REP_BAR
#define REP_BAR 1
#endif
#ifndef REP_FILL
#define REP_FILL 1
#endif
#ifndef DRY_REP
#define DRY_REP 0
#endif
#ifndef REP_ATTN_FOX
#define REP_ATTN_FOX REP_ATTN
#endif
#ifndef PROBE_NODOT
#define PROBE_NODOT 0
#endif
#ifndef REP_CONV
#define REP_CONV 1
#endif
#ifndef REP_P0B
#define REP_P0B 1
#endif
#ifndef REP_P0
#define REP_P0 1
#endif
#ifndef MK_PER_PHASE
#define MK_PER_PHASE 0
#endif
constexpr int NWAVES = 8;
constexpr int NB = 8, SEQ = 4096, DM = 1024, NT = NB * SEQ;
constexpr int NPH = 2 + 8 * 4;
constexpr float ALPHA = 1.6817928305074292f;
constexpr float LN_EPS = 1e-5f;
constexpr float LOG2E = 1.4426950408889634f;
constexpr float QSCALE = 0.125f * LOG2E;
constexpr float W1SCALE = 32.0f, W2SCALE = 64.0f, ASCALE = 4.0f, WQK = 32.0f, WV = 64.0f, OSC = 4.0f, YSC = 8.0f, DNSC = 16.0f;

typedef unsigned short bf16;
typedef float f32x4 __attribute__((ext_vector_type(4)));
typedef float f32x2 __attribute__((ext_vector_type(2)));
typedef unsigned u32x4 __attribute__((ext_vector_type(4)));
typedef unsigned u32x2 __attribute__((ext_vector_type(2)));

typedef const __attribute__((address_space(4))) unsigned char* kaptr;
#define INP(k) (*(const float* const __attribute__((address_space(4)))*)(ka + 8 * (k)))
constexpr size_t MiB = 1u << 20;
constexpr size_t WS_CTL = 0, CTL_ZERO_BYTES = 1 * MiB;
constexpr size_t WS_MOD = 1 * MiB;
constexpr size_t WS_KVMOD = WS_MOD + 768 * 1024;
constexpr size_t WS_BT = WS_MOD + 896 * 1024;
constexpr size_t WS_LC = 2 * MiB;
constexpr size_t WS_TOK = 4 * MiB;
constexpr size_t WS_PERM = 5 * MiB;
constexpr size_t WS_GWT = 7 * MiB;
constexpr size_t WS_FOXIN = 10 * MiB, WS_FOXO = 22 * MiB, WS_KVW = 26 * MiB, WS_DQ = 30 * MiB, WS_DO = 34 * MiB, WS_MOE1 = 38 * MiB, WS_MOE2 = 70 * MiB;
constexpr size_t WS_ACT = 86 * MiB, ACT_BYTES = 64 * MiB;
constexpr size_t WS_END = WS_ACT + 6 * ACT_BYTES;
constexpr int CW_TMO = 0;
constexpr int CW_BAR = 4096;
constexpr int CW_QUEUE = 190000;
constexpr int CW_NORM = 210000, CW_KVN = CW_NORM + 4096;
constexpr int CW_CNT = 200000;
constexpr int RING_BYTES = 131072, LDSCTL_OFF = 141312  , MISC_OFF = LDSCTL_OFF + 320, MOETAB_OFF = LDSCTL_OFF + 1024, PARK_OFF = LDSCTL_OFF + 2048  , NORML_OFF = LDSCTL_OFF + 10240  , QW_OFF = LDSCTL_OFF + 512, LDS_BYTES = LDSCTL_OFF + 16384;

#define RLX_AGENT __ATOMIC_RELAXED, __HIP_MEMORY_SCOPE_AGENT
__device__ __forceinline__ unsigned pk2(float lo, float hi) { return pg8::cvt_pk_bf16(lo, hi); }
__device__ __forceinline__ f32x4 unpack4(u32x2 w) { f32x4 r; r.x = __uint_as_float(w.x << 16); r.y = __uint_as_float(w.x & 0xffff0000u); r.z = __uint_as_float(w.y << 16); r.w = __uint_as_float(w.y & 0xffff0000u); return r; }
__device__ __forceinline__ f32x4 unpack4_fp8(unsigned w) { const f32x2 lo = __builtin_amdgcn_cvt_pk_f32_fp8((int)w, false), hi = __builtin_amdgcn_cvt_pk_f32_fp8((int)w, true); return (f32x4){lo.x, lo.y, hi.x, hi.y}; }
__device__ __forceinline__ float xshfl(float v, int m, int lane) { return __uint_as_float((unsigned)__builtin_amdgcn_ds_bpermute((lane ^ m) << 2, (int)__float_as_uint(v))); }
__device__ __forceinline__ float wave_sum(float v, int lane) {
#pragma unroll
    for (int o = 1; o < 64; o <<= 1) v += xshfl(v, o, lane);
    return v;
}

#define XB_TMO      128
#define XB_XCNT(j)  (256  + 64 * (j))
#define XB_XSUB(j)  (1280 + 64 * (j))
#define XB_XGEN(j)  (2304 + 64 * (j))
#define XB_TOP      3328
#define XB_TOPGEN   3392
#define XCD_BAR_WORDS 3456
#define XB_SPIN_CAP (1u << 18)

__device__ __forceinline__ unsigned xb_ld(unsigned* p)              { return __hip_atomic_load(p, __ATOMIC_RELAXED, __HIP_MEMORY_SCOPE_AGENT); }
__device__ __forceinline__ unsigned xb_add(unsigned* p, unsigned v) { return __hip_atomic_fetch_add(p, v, __ATOMIC_RELAXED, __HIP_MEMORY_SCOPE_AGENT); }
__device__ __forceinline__ unsigned xb_xcc_id() { return (unsigned)__builtin_amdgcn_s_getreg((3 << 11) | 20) & 0xFu; }
#define XB_SPIN(cond, bar) do { unsigned _sp = 0; while (cond) { __builtin_amdgcn_s_sleep(1); \
    if ((++_sp & 255u) == 0u) { if (xb_ld(&(bar)[XB_TMO])) break; if (_sp > XB_SPIN_CAP) { atomicAdd(&(bar)[XB_TMO], 1u); break; } } } } while (0)

struct XcdBarrier {
    unsigned* bar; unsigned x;
    volatile LAS unsigned* st;
};

__device__ __forceinline__ XcdBarrier xcd_barrier_post(unsigned* bar, volatile LAS unsigned* st) {
    XcdBarrier b; b.bar = bar; b.x = xb_xcc_id(); b.st = st;
    if (threadIdx.x == 0) (void)xb_add(&bar[XB_XCNT(b.x)], 1u);
    return b;
}
__device__ __forceinline__ void xcd_barrier_complete(unsigned* bar, unsigned x, unsigned& nloc, unsigned& nx) {
    const unsigned G = gridDim.x * gridDim.y * gridDim.z;
    unsigned sum, cnt, mine, sp = 0u;
    for (;;) {
        sum = 0u; cnt = 0u; mine = 0u;
#pragma unroll
        for (unsigned j = 0; j < 16; ++j) { const unsigned c = xb_ld(&bar[XB_XCNT(j)]); sum += c; cnt += (c > 0u) ? 1u : 0u; mine = (j == x) ? c : mine; }
        if (sum == G) break;
        __builtin_amdgcn_s_sleep(1);
        if ((++sp & 255u) == 0u) { if (xb_ld(&bar[XB_TMO])) break; if (sp > XB_SPIN_CAP) { atomicAdd(&bar[XB_TMO], 1u); break; } }
    }
    nloc = mine > 0u ? mine : 1u; nx = cnt > 0u ? cnt : 1u;
}

__device__ __forceinline__ void xcd_barrier(const XcdBarrier& b) {
    asm volatile("s_waitcnt vmcnt(0)" ::: "memory");
    __syncthreads();
    if (threadIdx.x == 0) {
        unsigned* bar = b.bar;
        __builtin_amdgcn_s_waitcnt(0);
        unsigned nloc = b.st[0], nx = b.st[1];
        if (nloc == 0u) { xcd_barrier_complete(bar, b.x, nloc, nx); b.st[0] = nloc; b.st[1] = nx; }
        const unsigned old = xb_add(&bar[XB_XSUB(b.x)], 1u);
        const unsigned gen = old / nloc;
        if (old + 1u == (gen + 1u) * nloc) {
            __builtin_amdgcn_fence(__ATOMIC_RELEASE, "agent");
            asm volatile("s_waitcnt vmcnt(0)" ::: "memory");
            const unsigned og = xb_add(&bar[XB_TOP], 1u);
            const unsigned tg = og / nx;
            if (og + 1u == (tg + 1u) * nx) xb_add(&bar[XB_TOPGEN], 1u);
            else XB_SPIN(xb_ld(&bar[XB_TOPGEN]) == tg, bar);
            __builtin_amdgcn_fence(__ATOMIC_ACQUIRE, "agent");
            xb_add(&bar[XB_XGEN(b.x)], 1u);
            asm volatile("s_waitcnt vmcnt(0)" ::: "memory");
        } else {
            XB_SPIN(xb_ld(&bar[XB_XGEN(b.x)]) == gen, bar);
            __builtin_amdgcn_fence(__ATOMIC_ACQUIRE, "agent");
            asm volatile("s_waitcnt vmcnt(0)" ::: "memory");
        }
    }
    __syncthreads();
}

__device__ __forceinline__ void transpose_item(const float* W, int ld, int K, bf16* WT, int drow0, int k0, int n0, LAS float* scr, int lane, float qs) {
#pragma unroll 8
    for (int i = 0; i < 32; ++i) { const int kk = 2 * i + (lane >> 5); scr[kk * 33 + (lane & 31)] = W[(size_t)(k0 + kk) * ld + n0 + (lane & 31)]; (void)qs; }
    asm volatile("s_waitcnt lgkmcnt(0)" ::: "memory");
    const int c = lane & 7;
#pragma unroll
    for (int j = 0; j < 4; ++j) { const int n = (lane >> 3) + 8 * j; const LAS float* s = scr + (8 * c) * 33 + n;
        u32x4 o; o.x = pk2(s[0 * 33], s[1 * 33]); o.y = pk2(s[2 * 33], s[3 * 33]); o.z = pk2(s[4 * 33], s[5 * 33]); o.w = pk2(s[6 * 33], s[7 * 33]);
        *(u32x4*)(WT + (size_t)(drow0 + n) * K + k0 + 8 * c) = o; }
    asm volatile("s_waitcnt lgkmcnt(0)" ::: "memory");
}

__device__ __forceinline__ void transpose_item_fp8(const float* W, int ld, int K, unsigned char* WT, int drow0, int k0, int n0, LAS float* scr, int lane, float scale) {
#pragma unroll 8
    for (int i = 0; i < 32; ++i) { const int kk = 2 * i + (lane >> 5); scr[kk * 33 + (lane & 31)] = __builtin_nontemporal_load(W + (size_t)(k0 + kk) * ld + n0 + (lane & 31)) * scale; }
    asm volatile("s_waitcnt lgkmcnt(0)" ::: "memory");
    const int c = lane & 7;
#pragma unroll
    for (int j = 0; j < 4; ++j) { const int n = (lane >> 3) + 8 * j; const LAS float* s = scr + (8 * c) * 33 + n;
        u32x2 o; o.x = pg8::pk4_fp8(s[0 * 33], s[1 * 33], s[2 * 33], s[3 * 33]); o.y = pg8::pk4_fp8(s[4 * 33], s[5 * 33], s[6 * 33], s[7 * 33]);
        *(u32x2*)(WT + (size_t)(drow0 + n) * K + k0 + 8 * c) = o; }
    asm volatile("s_waitcnt lgkmcnt(0)" ::: "memory");
}

__device__ __forceinline__ void p0_prologue(LAS unsigned char* L, kaptr ka, unsigned char* ws, int tid, int lane, int wave, int bx, int G, int vcu) {
    LAS float* sc = (LAS float*)L;
    LAS float* part = (LAS float*)(L + 32768);
    const float* cin = INP(1);
    for (int i = tid; i < NB * DM; i += NWAVES * 64) { const float v = cin[i]; sc[i] = v / (1.0f + __expf(-v)); }
    __syncthreads();
    for (int task = bx; task < 208; task += G) {
        const float* W; const float* bias; float* out; int ld, n0;
        if (task < 192) { const int l = task / 48, ch = task % 48; W = INP(2) + (size_t)l * DM * 6144; ld = 6144; n0 = ch * 128; bias = INP(3) + l * 6144; out = (float*)(ws + WS_MOD) + (size_t)l * NB * 6144; }
        else { const int ch = task - 192; W = INP(11); ld = 2048; n0 = ch * 128; bias = INP(12); out = (float*)(ws + WS_KVMOD); }
        float acc[8][2];
#pragma unroll
        for (int b = 0; b < 8; ++b) { acc[b][0] = 0.f; acc[b][1] = 0.f; }
        const float* wp = W + (size_t)(wave * 128) * ld + n0 + 2 * lane;
        for (int k4 = 0; k4 < 32; ++k4) {
            f32x2 wv[4];
#pragma unroll
            for (int kk = 0; kk < 4; ++kk) wv[kk] = __builtin_nontemporal_load((const f32x2*)(wp + (size_t)(4 * k4 + kk) * ld));
#pragma unroll
            for (int b = 0; b < 8; ++b) { const f32x4 s = *(const LAS f32x4*)(sc + b * DM + wave * 128 + 4 * k4);
#pragma unroll
                for (int kk = 0; kk < 4; ++kk) { acc[b][0] += s[kk] * wv[kk].x; acc[b][1] += s[kk] * wv[kk].y; } }
        }
#pragma unroll
        for (int b = 0; b < 8; ++b) *(LAS f32x2*)(part + (wave * 8 + b) * 128 + 2 * lane) = (f32x2){acc[b][0], acc[b][1]};
        __syncthreads();
        for (int o = tid; o < 8 * 128; o += NWAVES * 64) { const int b = o >> 7, col = o & 127; float s = bias[n0 + col];
#pragma unroll
            for (int w = 0; w < 8; ++w) s += part[(w * 8 + b) * 128 + col];
            out[(size_t)b * ld + n0 + col] = s; }
        __syncthreads();
    }
    __syncthreads();
    LAS float* scr = (LAS float*)(L + wave * 16384);
    const int gw = vcu * NWAVES + wave, NGW = G * NWAVES;
    constexpr int I_IN = 16 * 96, I_SQ = 16 * 32, I_KV = 16 * 64;
#define HEADPERM(n0) (((n0) & ~255) + 128 * ((((n0) & 255) & 63) >> 5) + 32 * (((n0) & 255) >> 6))
    constexpr int NITEMS = 2 * I_IN + 2 * I_SQ + I_KV + 2 * I_SQ + 2 * I_SQ;
    for (int it = gw; it < NITEMS; it += NGW) {
        int r = it;
        if (r < 2 * I_IN) { const int l = r / I_IN; r %= I_IN; transpose_item_fp8(INP(8) + (size_t)l * DM * 3088, 3088, DM, (unsigned char*)(ws + WS_FOXIN) + (size_t)l * 3072 * DM, HEADPERM(32 * (r % 96)), 64 * (r / 96), 32 * (r % 96), scr, lane, (r % 96) < 64 ? WQK : WV); continue; } r -= 2 * I_IN;
        if (r < 2 * I_SQ) { const int l = r / I_SQ; r %= I_SQ; transpose_item_fp8(INP(10) + (size_t)l * DM * DM, DM, DM, (unsigned char*)(ws + WS_FOXO) + (size_t)l * DM * DM, 32 * (r % 32), 64 * (r / 32), 32 * (r % 32), scr, lane, WV); continue; } r -= 2 * I_SQ;
        if (r < I_KV) { transpose_item_fp8(INP(13), 2048, DM, (unsigned char*)(ws + WS_KVW), HEADPERM(32 * (r % 64)), 64 * (r / 64), 32 * (r % 64), scr, lane, (r % 64) < 32 ? WQK : WV); continue; } r -= I_KV;
        if (r < 2 * I_SQ) { const int l = r / I_SQ; r %= I_SQ; transpose_item_fp8(INP(14) + (size_t)l * DM * DM, DM, DM, (unsigned char*)(ws + WS_DQ) + (size_t)l * DM * DM, HEADPERM(32 * (r % 32)), 64 * (r / 32), 32 * (r % 32), scr, lane, WQK); continue; } r -= 2 * I_SQ;
        { const int l = r / I_SQ; r %= I_SQ; transpose_item_fp8(INP(17) + (size_t)l * DM * DM, DM, DM, (unsigned char*)(ws + WS_DO) + (size_t)l * DM * DM, 32 * (r % 32), 64 * (r / 32), 32 * (r % 32), scr, lane, WV); }
    }
}
struct ConvItem { const float* W; unsigned char* WT; int ld, K, drow0, k0, n0; float scale; };
__device__ __forceinline__ ConvItem conv_item(kaptr ka, unsigned char* ws, int l, int it) {
    const int which = it >> 12, e = (it >> 8) & 15, r = it & 255; ConvItem c;
    if (which < 2) { const int kb = r >> 4, nb = r & 15, n0 = 32 * nb;
        c.W = (which == 0 ? INP(20) : INP(21)) + (size_t)(l * 16 + e) * DM * 512; c.ld = 512; c.K = DM; c.WT = (unsigned char*)(ws + WS_MOE1) + (size_t)e * DM * DM; c.drow0 = (n0 >> 7) * 256 + (n0 & 127) + which * 128; c.k0 = 64 * kb; c.n0 = n0; c.scale = W1SCALE; }
    else { const int kb = r >> 5, nb = r & 31;
        c.W = INP(22) + (size_t)(l * 16 + e) * 512 * DM; c.ld = DM; c.K = 512; c.WT = (unsigned char*)(ws + WS_MOE2) + (size_t)e * DM * 512; c.drow0 = 32 * nb; c.k0 = 64 * kb; c.n0 = 32 * nb; c.scale = W2SCALE; }
    return c; }
__device__ __forceinline__ void conv_finish(const ConvItem& c, const float (&v)[32], LAS float* scr, int lane);
__device__ __forceinline__ const float* conv_src(const ConvItem& c, int lane);
struct ConvF { kaptr ka; unsigned char* ws; LAS unsigned char* L; int l, vcu, G, ck, on;
    __device__ __forceinline__ void issue(float (&v)[32], int lane, int wave) const { if (on) { const ConvItem c = conv_item(ka, ws, l, vcu * NWAVES + wave + ck * (G * NWAVES)); const float* s = conv_src(c, lane);
#pragma unroll
        for (int i = 0; i < 32; ++i) v[i] = __builtin_nontemporal_load(s + (size_t)(2 * i) * c.ld); } }
    __device__ __forceinline__ void finish(const float (&v)[32], int lane, int wave) const { if (on) { const ConvItem c = conv_item(ka, ws, l, vcu * NWAVES + wave + ck * (G * NWAVES)); conv_finish(c, v, (LAS float*)(L + wave * 8448), lane); } }
};
__device__ __forceinline__ const float* conv_src(const ConvItem& c, int lane) { return c.W + (size_t)(c.k0 + (lane >> 5)) * c.ld + c.n0 + (lane & 31); }
__device__ __forceinline__ void conv_finish(const ConvItem& c, const float (&v)[32], LAS float* scr, int lane) {
#pragma unroll
    for (int i = 0; i < 32; ++i) scr[(2 * i + (lane >> 5)) * 33 + (lane & 31)] = v[i] * c.scale;
    asm volatile("s_waitcnt lgkmcnt(0)" ::: "memory");
    const int cc = lane & 7;
#pragma unroll
    for (int j = 0; j < 4; ++j) { const int n = (lane >> 3) + 8 * j; const LAS float* s = scr + (8 * cc) * 33 + n;
        u32x2 o; o.x = pg8::pk4_fp8(s[0 * 33], s[1 * 33], s[2 * 33], s[3 * 33]); o.y = pg8::pk4_fp8(s[4 * 33], s[5 * 33], s[6 * 33], s[7 * 33]);
        *(u32x2*)(c.WT + (size_t)(c.drow0 + n) * c.K + c.k0 + 8 * cc) = o; }
    asm volatile("s_waitcnt lgkmcnt(0)" ::: "memory");
}
__device__ __forceinline__ void moe_weight_copies(LAS unsigned char* L, kaptr ka, unsigned char* ws, int l, int lane, int wave, int G, int vcu) {
    LAS float* scr = (LAS float*)(L + wave * 16384);
    const int gw = vcu * NWAVES + wave, NGW = G * NWAVES;
    for (int it = gw; it < 12288; it += NGW) {
        const int which = it >> 12, e = (it >> 8) & 15, r = it & 255;
        if (which < 2) { const int kb = r >> 4, nb = r & 15, n0 = 32 * nb;
            transpose_item_fp8((which == 0 ? INP(20) : INP(21)) + (size_t)(l * 16 + e) * DM * 512, 512, DM, (unsigned char*)(ws + WS_MOE1) + (size_t)e * DM * DM, (n0 >> 7) * 256 + (n0 & 127) + which * 128, 64 * kb, n0, scr, lane, W1SCALE); }
        else { const int kb = r >> 5, nb = r & 31;
            transpose_item_fp8(INP(22) + (size_t)(l * 16 + e) * 512 * DM, DM, 512, (unsigned char*)(ws + WS_MOE2) + (size_t)e * DM * 512, 32 * nb, 64 * kb, 32 * nb, scr, lane, W2SCALE); }
    }
}

__device__ __forceinline__ void route16(const float (&lg)[16], const LAS float* rb, int& e0, int& e1, float& w0, float& w1) {
    float mx = lg[0];
#pragma unroll
    for (int e = 1; e < 16; ++e) mx = fmaxf(mx, lg[e]);
    float p[16], sum = 0.f;
#pragma unroll
    for (int e = 0; e < 16; ++e) { p[e] = __expf(lg[e] - mx); sum += p[e]; }
    const float inv = 1.0f / sum;
    int be0 = 0, be1 = 1; float bp0 = 0.f, bp1 = 0.f, gbest = -INFINITY;
#pragma unroll
    for (int g = 0; g < 4; ++g) {
        float a[4], q[4];
#pragma unroll
        for (int i = 0; i < 4; ++i) { q[i] = p[4 * g + i] * inv; a[i] = q[i] + rb[4 * g + i]; }
        int i0 = 0; float v0 = a[0], q0 = q[0];
#pragma unroll
        for (int i = 1; i < 4; ++i) if (a[i] > v0) { v0 = a[i]; i0 = i; q0 = q[i]; }
        int i1 = 0; float v1 = -INFINITY, q1 = 0.f;
#pragma unroll
        for (int i = 0; i < 4; ++i) if (i != i0 && a[i] > v1) { v1 = a[i]; i1 = i; q1 = q[i]; }
        const float gs = v0 + v1;
        if (gs > gbest) { gbest = gs; be0 = 4 * g + i0; be1 = 4 * g + i1; bp0 = q0; bp1 = q1; }
    }
    e0 = be0; e1 = be1; const float ws_ = 1.0f / (bp0 + bp1); w0 = bp0 * ws_; w1 = bp1 * ws_;
}

struct RowsCfg {
    const float* xin_f32; const bf16* xin_bf;
    bf16* xout_bf; float* xout_f32;
    const unsigned char* src; float src_inv;
    const float* gate; const float* gamma; const float* beta;
    const float* sc; const float* sh; bf16* hout; int hout_fp8;
    const float* sc2; const float* sh2; bf16* hout2;
    const float* w16; int w16_ld; int dotmode;
    const float* rb;
    unsigned* cnt; int* perm; float* gwt; unsigned* tokslot;
    float* lc; float* bt;
};
template <int MODE, bool XF32>
__device__ __forceinline__ void rows_load(f32x4 (&xf)[4], u32x4 (&xb)[2], u32x2 (&s0)[2], u32x2 (&s1)[2], const RowsCfg& c, int row, int slot0, int slot1, int lane) {
    if (XF32) { const f32x4* xr = (const f32x4*)(c.xin_f32 + (size_t)row * DM) + 2 * lane;
#pragma unroll
        for (int q = 0; q < 4; ++q) xf[q] = xr[128 * (q >> 1) + (q & 1)]; }
    else { const u32x4* xr = (const u32x4*)(c.xin_bf + (size_t)row * DM) + lane;
#pragma unroll
        for (int j = 0; j < 2; ++j) xb[j] = xr[64 * j]; }
    if (MODE == 1) { const u32x2* yr = (const u32x2*)(c.src + (size_t)row * DM) + lane;
#pragma unroll
        for (int j = 0; j < 2; ++j) s0[j] = yr[64 * j]; }
    if (MODE == 2) { const u32x2* r0 = (const u32x2*)(c.src + (size_t)slot0 * DM) + lane; const u32x2* r1 = (const u32x2*)(c.src + (size_t)slot1 * DM) + lane;
#pragma unroll
        for (int j = 0; j < 2; ++j) { s0[j] = r0[64 * j]; s1[j] = r1[64 * j]; } }
}
template <int MODE, bool XF32>
__device__ __forceinline__ void rows_phase(LAS unsigned char* L, const RowsCfg& c, int tid, int lane, int wave, int bx) {
    LAS u32x4* WB = (LAS u32x4*)L;
    LAS u32x4* ST = (LAS u32x4*)(L + 32768 + wave * 8192);
    LAS f32x4* VEC = (LAS f32x4*)(L + 98304);
    LAS float* LF = (LAS float*)(L + 126976);
    LAS int* RE = (LAS int*)(L + 135168);
    LAS float* RW = (LAS float*)(L + 136192);
    LAS int* LP = (LAS int*)(L + 137216);
    LAS int* HIST = (LAS int*)(L + 138240);
    LAS int* GB = HIST + 16; LAS int* OFF = HIST + 32; LAS float* RB = (LAS float*)(HIST + 48);
    LAS float* LG2 = (LAS float*)(L + 126976);
    if (tid < 256) {
        if (MODE != 0) { VEC[0 * 256 + tid] = (((const f32x4*)c.gate)[tid] + 1.0f) * c.src_inv;     VEC[1 * 256 + tid] = ((const f32x4*)c.gamma)[tid]; VEC[2 * 256 + tid] = ((const f32x4*)c.beta)[tid]; }
        if (c.hout) { VEC[3 * 256 + tid] = ((const f32x4*)c.sc)[tid]; VEC[4 * 256 + tid] = ((const f32x4*)c.sh)[tid]; }
        if (c.hout2) { VEC[5 * 256 + tid] = ((const f32x4*)c.sc2)[tid]; VEC[6 * 256 + tid] = ((const f32x4*)c.sh2)[tid]; }
    }
    if (tid < 16) { HIST[tid] = 0; if (c.dotmode) RB[tid] = c.rb[tid]; }
    if (MODE == 2 && tid < 16) GB[tid] = (int)__hip_atomic_load(c.cnt + tid, RLX_AGENT);
    if (c.dotmode) for (int idx = tid; idx < 2048; idx += NWAVES * 64) { const int s = idx >> 6, ln = idx & 63, e = ln & 15, k0 = 32 * s + 8 * (ln >> 4); float w[8];
#pragma unroll
        for (int j = 0; j < 8; ++j) w[j] = c.w16[(size_t)(k0 + j) * c.w16_ld + e];
        WB[idx] = (u32x4){pk2(w[0], w[1]), pk2(w[2], w[3]), pk2(w[4], w[5]), pk2(w[6], w[7])}; }
    __syncthreads();
    if (MODE == 2) { if (tid == 0) { int so = 0;
#pragma unroll
        for (int e = 0; e < 16; ++e) { OFF[e] = so; so += GB[e]; } }
        __syncthreads(); }
    const int rowb = bx * 128 + wave * 16;
#define VQ(vec, q) VEC[(vec) * 256 + 2 * lane + 128 * ((q) >> 1) + ((q) & 1)]
    int myslot = 0; float myw = 0.f;
    if (MODE == 2) { const unsigned t = c.tokslot[rowb * 2 + (lane & 31)]; myslot = OFF[t >> 16] + (int)(t & 0xffffu); myw = c.gwt[rowb * 2 + (lane & 31)]; }
#define ROWS_SLOT(r, k) (MODE == 2 ? __builtin_amdgcn_readlane(myslot, 2 * (r) + (k)) : 0)
    auto compute = [&](f32x4 (&Bxf)[2][4], u32x4 (&Bxb)[2][2], u32x2 (&Bs0)[2][2], u32x2 (&Bs1)[2][2], const int g, const bool mma) __attribute__((always_inline)) {
        f32x4 hv[2][4];
#pragma unroll
        for (int rr = 0; rr < 2; ++rr) {
            const int row = rowb + 2 * g + rr;
            f32x4 v[4];
#pragma unroll
            for (int q = 0; q < 4; ++q) { if (XF32) v[q] = Bxf[rr][q]; else { const u32x4 w = Bxb[rr][q >> 1]; v[q] = (q & 1) ? unpack4((u32x2){w.z, w.w}) : unpack4((u32x2){w.x, w.y}); } }
            if (MODE != 0) {
                float gw0 = 1.f, gw1 = 1.f; if (MODE == 2) { gw0 = __uint_as_float(__builtin_amdgcn_readlane(__float_as_uint(myw), 2 * (2 * g + rr))); gw1 = __uint_as_float(__builtin_amdgcn_readlane(__float_as_uint(myw), 2 * (2 * g + rr) + 1)); }
                float sm = 0.f;
#pragma unroll
                for (int q = 0; q < 4; ++q) { const unsigned w0 = (q & 1) ? Bs0[rr][q >> 1].y : Bs0[rr][q >> 1].x; f32x4 s = unpack4_fp8(w0);
                    if (MODE == 2) { const unsigned w1 = (q & 1) ? Bs1[rr][q >> 1].y : Bs1[rr][q >> 1].x; s = s * gw0 + unpack4_fp8(w1) * gw1; }
                    const f32x4 gt = VQ(0, q); v[q] = v[q] * ALPHA + gt * s; sm += (v[q].x + v[q].y) + (v[q].z + v[q].w); }
                const float mean = wave_sum(sm, lane) * (1.0f / DM); float s2 = 0.f;
#pragma unroll
                for (int q = 0; q < 4; ++q) { v[q] = v[q] - mean; s2 += (v[q].x * v[q].x + v[q].y * v[q].y) + (v[q].z * v[q].z + v[q].w * v[q].w); }
                const float rstd = 1.0f / sqrtf(wave_sum(s2, lane) * (1.0f / DM) + LN_EPS);
#pragma unroll
                for (int q = 0; q < 4; ++q) v[q] = v[q] * rstd * VQ(1, q) + VQ(2, q);
                if (c.xout_f32) { f32x4* xo = (f32x4*)(c.xout_f32 + (size_t)row * DM) + 2 * lane;
#pragma unroll
                    for (int q = 0; q < 4; ++q) xo[128 * (q >> 1) + (q & 1)] = v[q]; }
                else { u32x4* xo = (u32x4*)(c.xout_bf + (size_t)row * DM) + lane;
#pragma unroll
                    for (int j = 0; j < 2; ++j) xo[64 * j] = (u32x4){pk2(v[2 * j].x, v[2 * j].y), pk2(v[2 * j].z, v[2 * j].w), pk2(v[2 * j + 1].x, v[2 * j + 1].y), pk2(v[2 * j + 1].z, v[2 * j + 1].w)}; }
            }
            if (c.hout) { u32x2* ho = (u32x2*)((unsigned char*)c.hout + (size_t)row * DM) + lane;
#pragma unroll
                for (int q = 0; q < 4; ++q) hv[rr][q] = v[q] * (VQ(3, q) + 1.0f) + VQ(4, q);
#pragma unroll
                for (int j = 0; j < 2; ++j) ho[64 * j] = (u32x2){pg8::pk4_fp8(hv[rr][2 * j].x, hv[rr][2 * j].y, hv[rr][2 * j].z, hv[rr][2 * j].w), pg8::pk4_fp8(hv[rr][2 * j + 1].x, hv[rr][2 * j + 1].y, hv[rr][2 * j + 1].z, hv[rr][2 * j + 1].w)}; }
            if (c.hout2) { u32x2* ho = (u32x2*)((unsigned char*)c.hout2 + (size_t)row * DM) + lane;
#pragma unroll
                for (int j = 0; j < 2; ++j) { const f32x4 ha = v[2 * j] * (VQ(5, 2 * j) + 1.0f) + VQ(6, 2 * j), hb = v[2 * j + 1] * (VQ(5, 2 * j + 1) + 1.0f) + VQ(6, 2 * j + 1);
                    ho[64 * j] = (u32x2){pg8::pk4_fp8(ha.x, ha.y, ha.z, ha.w), pg8::pk4_fp8(hb.x, hb.y, hb.z, hb.w)}; } }
        }
        if (c.dotmode) {
#pragma unroll
            for (int rr = 0; rr < 2; ++rr)
#pragma unroll
                for (int j = 0; j < 2; ++j) ST[(2 * (g & 1) + rr) * 128 + lane + 64 * j] = (u32x4){pk2(hv[rr][2 * j].x, hv[rr][2 * j].y), pk2(hv[rr][2 * j].z, hv[rr][2 * j].w), pk2(hv[rr][2 * j + 1].x, hv[rr][2 * j + 1].y), pk2(hv[rr][2 * j + 1].z, hv[rr][2 * j + 1].w)};
            if (mma) {
                f32x4 acc = {0.f, 0.f, 0.f, 0.f};
                const LAS u32x4* ap = ST + (lane & 3) * 128 + (lane >> 4);
#pragma unroll 8
                for (int s = 0; s < 32; ++s) acc = __builtin_amdgcn_mfma_f32_16x16x32_bf16(__builtin_bit_cast(pg8::bf16x8, ap[4 * s]), __builtin_bit_cast(pg8::bf16x8, WB[64 * s + lane]), acc, 0, 0, 0);
                if (lane < 16) {
#pragma unroll
                    for (int rr = 0; rr < 4; ++rr) { const float tot = acc[rr]; const int rl = wave * 16 + 2 * (g - 1) + rr;
                        if (c.dotmode == 2) { const float z = tot + RB[lane]; LF[rl * 16 + lane] = fminf(z, 0.f) - 0.6931471805599453f * __builtin_amdgcn_logf(1.0f + __builtin_amdgcn_exp2f(-LOG2E * fabsf(z))); }
                        else LG2[rl * 16 + lane] = tot; } }
            }
        }
    };
    f32x4 Axf[2][4], Bxf[2][4]; u32x4 Axb[2][2], Bxb[2][2]; u32x2 As0[2][2], Bs0[2][2], As1[2][2], Bs1[2][2];
#define ROWS_LD(P, rr, r) rows_load<MODE, XF32>(P##xf[rr], P##xb[rr], P##s0[rr], P##s1[rr], c, rowb + (r), ROWS_SLOT((r), 0), ROWS_SLOT((r), 1), lane)
    ROWS_LD(A, 0, 0); ROWS_LD(A, 1, 1);
#pragma unroll 1
    for (int g = 0; g < 8; g += 2) {
        ROWS_LD(B, 0, 2 * g + 2); ROWS_LD(B, 1, 2 * g + 3);
        compute(Axf, Axb, As0, As1, g, false);
        if (g + 2 < 8) { ROWS_LD(A, 0, 2 * g + 4); ROWS_LD(A, 1, 2 * g + 5); }
        compute(Bxf, Bxb, Bs0, Bs1, g + 1, true);
    }
#undef ROWS_LD
#undef ROWS_SLOT
#undef VQ
    if (c.dotmode == 1) {
        asm volatile("s_waitcnt lgkmcnt(0)" ::: "memory");
        if (lane < 16) { float lg[16];
#pragma unroll
            for (int e = 0; e < 16; ++e) lg[e] = LG2[(wave * 16 + lane) * 16 + e];
            int e0, e1; float w0, w1; route16(lg, RB, e0, e1, w0, w1);
            const int rl = wave * 16 + lane;
            RE[rl * 2] = e0; RE[rl * 2 + 1] = e1; RW[rl * 2] = w0; RW[rl * 2 + 1] = w1;
            LP[rl * 2] = __hip_atomic_fetch_add(HIST + e0, 1, __ATOMIC_RELAXED, __HIP_MEMORY_SCOPE_WORKGROUP);
            LP[rl * 2 + 1] = __hip_atomic_fetch_add(HIST + e1, 1, __ATOMIC_RELAXED, __HIP_MEMORY_SCOPE_WORKGROUP); }
    }
    __syncthreads();
    if (c.dotmode == 2) {
        const int b = bx >> 5, blk = bx & 31;
        if (tid < 16) { float run = 0.f;
            for (int i = 0; i < 128; ++i) { run += LF[i * 16 + tid]; LF[i * 16 + tid] = run; }
            c.bt[(b * 16 + tid) * 32 + blk] = run; }
        __syncthreads();
        { const int e = tid >> 5, i0 = 4 * (tid & 31);
          const f32x4 o = {LF[(i0 + 0) * 16 + e], LF[(i0 + 1) * 16 + e], LF[(i0 + 2) * 16 + e], LF[(i0 + 3) * 16 + e]};
          *(f32x4*)(c.lc + (size_t)(b * 16 + e) * SEQ + blk * 128 + i0) = o; }
    }
    if (c.dotmode == 1) {
        if (c.cnt == nullptr) { __syncthreads(); return; }
        if (tid < 16) GB[tid] = (int)__hip_atomic_fetch_add(c.cnt + tid, (unsigned)HIST[tid], RLX_AGENT);
        __syncthreads();
        if (tid < 128) { const int row = bx * 128 + tid;
#pragma unroll
            for (int k = 0; k < 2; ++k) { const int e = RE[tid * 2 + k], pos = GB[e] + LP[tid * 2 + k];
                c.perm[e * 32768 + pos] = row; c.gwt[row * 2 + k] = RW[tid * 2 + k]; c.tokslot[row * 2 + k] = ((unsigned)e << 16) | (unsigned)pos; } }
    }
    __syncthreads();
}

__device__ __forceinline__ void combine_phase(const bf16* O1, const bf16* O2, bf16* O, const float* lamp  , const float* gnorm  , float lam_init, int lane, int wave, int bx) {
    float pa = lamp[lane] * lamp[64 + lane], pb = lamp[128 + lane] * lamp[192 + lane];
    pa = wave_sum(pa, lane); pb = wave_sum(pb, lane);
    const float lam = __expf(pa) - __expf(pb) + lam_init, post = (1.0f - lam_init) * OSC;
    float g[16];
#pragma unroll
    for (int k = 0; k < 16; ++k) g[k] = gnorm[(lane & 7) * 16 + k] * post;
    const int rowb = bx * 128 + wave * 16;
    for (int i = 0; i < 16; ++i) {
        const size_t off = (size_t)(rowb + i) * DM + 16 * lane;
        const u32x4 a0 = *(const u32x4*)(O1 + off), a1 = *(const u32x4*)(O1 + off + 8), b0 = *(const u32x4*)(O2 + off), b1 = *(const u32x4*)(O2 + off + 8);
        float d[16];
        { const f32x4 x0 = unpack4((u32x2){a0.x, a0.y}), x1 = unpack4((u32x2){a0.z, a0.w}), x2 = unpack4((u32x2){a1.x, a1.y}), x3 = unpack4((u32x2){a1.z, a1.w});
          const f32x4 y0 = unpack4((u32x2){b0.x, b0.y}), y1 = unpack4((u32x2){b0.z, b0.w}), y2 = unpack4((u32x2){b1.x, b1.y}), y3 = unpack4((u32x2){b1.z, b1.w});
          const f32x4 r0 = x0 - y0 * lam, r1 = x1 - y1 * lam, r2 = x2 - y2 * lam, r3 = x3 - y3 * lam;
#pragma unroll
          for (int k = 0; k < 4; ++k) { d[k] = r0[k]; d[4 + k] = r1[k]; d[8 + k] = r2[k]; d[12 + k] = r3[k]; } }
        float ss = 0.f;
#pragma unroll
        for (int k = 0; k < 16; ++k) ss += d[k] * d[k];
        ss += xshfl(ss, 1, lane); ss += xshfl(ss, 2, lane); ss += xshfl(ss, 4, lane);
        const float r = 1.0f / sqrtf(ss * (1.0f / 128.0f) + LN_EPS);
        u32x4 w0;
        w0.x = pg8::pk4_fp8(d[0] * r * g[0], d[1] * r * g[1], d[2] * r * g[2], d[3] * r * g[3]); w0.y = pg8::pk4_fp8(d[4] * r * g[4], d[5] * r * g[5], d[6] * r * g[6], d[7] * r * g[7]);
        w0.z = pg8::pk4_fp8(d[8] * r * g[8], d[9] * r * g[9], d[10] * r * g[10], d[11] * r * g[11]); w0.w = pg8::pk4_fp8(d[12] * r * g[12], d[13] * r * g[13], d[14] * r * g[14], d[15] * r * g[15]);
        *(u32x4*)((unsigned char*)O + off) = w0;
    }
}

__device__ __forceinline__ void fill_bias(LAS unsigned char* L, bool fox, const float* lc, const float* bt, float slope, int nkeys, int tid, int lane, int kaoff) {
    LAS u32x4* bias = (LAS u32x4*)(L + kaoff);
    const int s = 8 * tid;
    float pre = 0.f;
    if (fox) { const int blk = tid >> 4; const int l5 = lane & 31; float inc = bt[l5];
        const float own = inc;
#pragma unroll
        for (int o = 1; o < 32; o <<= 1) { const float t = __uint_as_float((unsigned)__builtin_amdgcn_ds_bpermute((lane - o) << 2, (int)__float_as_uint(inc))); inc += (l5 >= o) ? t : 0.f; }
        pre = __uint_as_float((unsigned)__builtin_amdgcn_ds_bpermute(blk << 2, (int)__float_as_uint(inc - own))); }
    if (s < nkeys) {
        f32x4 o0, o1;
        if (fox) { const f32x4 a = *(const f32x4*)(lc + s), b = *(const f32x4*)(lc + s + 4);
            o0 = (a + pre) * (-LOG2E); o1 = (b + pre) * (-LOG2E); }
        else { const float k = slope * LOG2E;
            o0 = (f32x4){k * (float)s, k * (float)(s + 1), k * (float)(s + 2), k * (float)(s + 3)}; o1 = (f32x4){k * (float)(s + 4), k * (float)(s + 5), k * (float)(s + 6), k * (float)(s + 7)}; }
        const attn_body::u32x2v k0 = attn_body::ka_split(o0.x), k1 = attn_body::ka_split(o0.y), k2 = attn_body::ka_split(o0.z), k3 = attn_body::ka_split(o0.w);
        const attn_body::u32x2v k4 = attn_body::ka_split(o1.x), k5 = attn_body::ka_split(o1.y), k6 = attn_body::ka_split(o1.z), k7 = attn_body::ka_split(o1.w);
        bias[4 * tid] = (u32x4){k0[0], k0[1], k1[0], k1[1]}; bias[4 * tid + 1] = (u32x4){k2[0], k2[1], k3[0], k3[1]}; bias[4 * tid + 2] = (u32x4){k4[0], k4[1], k5[0], k5[1]}; bias[4 * tid + 3] = (u32x4){k6[0], k6[1], k7[0], k7[1]};
    }
}

struct Args { const float* in[23]; float* out; unsigned char* ws; int ph_lo, ph_hi, li, pad; };
__global__ void __launch_bounds__(NWAVES * 64, 2) mk_fwd(Args args) {
    extern __shared__ __attribute__((aligned(16))) unsigned char lds[];
    LAS unsigned char* L = (LAS unsigned char*)lds;
    const int tid0 = threadIdx.x; const int wave0 = __builtin_amdgcn_readfirstlane(tid0 >> 6);
    const int bx0 = blockIdx.x;
    for (int u = tid0; u < (LDS_BYTES - LDSCTL_OFF) / 4; u += NWAVES * 64) ((LAS unsigned*)(L + LDSCTL_OFF))[u] = 0u;
    __syncthreads();
    volatile LAS unsigned* MISC = (volatile LAS unsigned*)(L + MISC_OFF);
    XcdBarrier bar = xcd_barrier_post((unsigned*)(args.ws + WS_CTL) + CW_BAR + args.li * XCD_BAR_WORDS, MISC + 8);
    const int lo = args.ph_lo, hi = args.ph_hi;
    int ph = 0;
    constexpr size_t AE = ACT_BYTES / 2;
#define PH_ON (ph >= lo && ph < hi)
#define FRESH_TID() int lane; asm volatile("v_mbcnt_lo_u32_b32 %0, -1, 0\n\tv_mbcnt_hi_u32_b32 %0, -1, %0" : "=v"(lane)); const int wave = wave0; const int tid = wave * 64 + lane; (void)tid; \
    int bx = bx0; asm volatile("" : "+s"(bx)); const int G = 256; const int vcu = (bx % 8) * (G / 8) + bx / 8; (void)vcu; const int bb = bx >> 5; (void)bb; \
    kaptr ka = (kaptr)__builtin_amdgcn_kernarg_segment_ptr(); asm volatile("" : "+s"(ka)); \
    unsigned char* ws = *(unsigned char* const __attribute__((address_space(4)))*)(ka + 8 * 24); float* out = *(float* const __attribute__((address_space(4)))*)(ka + 8 * 23); (void)out; \
    unsigned* ctl = (unsigned*)(ws + WS_CTL); (void)ctl; bf16* ACT = (bf16*)(ws + WS_ACT); \
    bf16 *B0 = ACT, *B1 = ACT + AE, *B2 = ACT + 2 * AE, *B3 = ACT + 3 * AE, *B4 = ACT + 4 * AE, *B5 = ACT + 5 * AE; (void)B0; (void)B1; (void)B2; (void)B3; (void)B4; (void)B5; \
    float* MOD = (float*)(ws + WS_MOD); float* KVMOD = (float*)(ws + WS_KVMOD); float* BT = (float*)(ws + WS_BT); float* LC = (float*)(ws + WS_LC); (void)MOD; (void)KVMOD; (void)BT; (void)LC; \
    unsigned* TOK = (unsigned*)(ws + WS_TOK); int* PERM = (int*)(ws + WS_PERM); float* GWT = (float*)(ws + WS_GWT); (void)TOK; (void)PERM; (void)GWT
#define PH_END do { if (PH_ON && ph + 1 < hi) { XcdBarrier b_ = bar; asm volatile("" : "+s"(b_.bar), "+s"(b_.x)); for (int rb_ = 0; rb_ < REP_BAR; ++rb_) xcd_barrier(b_); } ++ph; } while (0)


    if (PH_ON) { FRESH_TID(); for (int rep_ = 0; rep_ < REP_P0; ++rep_) p0_prologue(L, ka, ws, tid, lane, wave, bx, G, vcu); }
    PH_END;
    if (PH_ON) { FRESH_TID();
        RowsCfg c{}; c.xin_f32 = INP(0); c.sh = MOD + (size_t)bb * 6144; c.sc = MOD + (size_t)bb * 6144 + DM; c.hout = B5; c.hout_fp8 = 1;
        c.w16 = INP(8) + 3072; c.w16_ld = 3088; c.dotmode = 2; c.rb = INP(9); c.lc = LC; c.bt = BT;
        for (int rep_ = 0; rep_ < REP_P0B; ++rep_) rows_phase<0, true>(L, c, tid, lane, wave, bx);
    }
    PH_END;

    for (int l = 0; l < 4; ++l) {
        const bool fox = l < 2;
        if (PH_ON) { FRESH_TID();
            for (int rep_ = 0; rep_ < REP_P1; ++rep_)
            for (int pass = (l == 2 ? 0 : 1); pass < 2; ++pass) {
                pg8::Gemm g; pg8::EpiBf16 E; int N;
                if (fox) { g = pg8::Gemm{B5, (const bf16*)((const unsigned char*)(ws + WS_FOXIN) + (size_t)l * 3072 * DM), DM / 2}; N = 3072; E = pg8::EpiBf16{B2, DM, DM, AE, {QSCALE / WQK, 1.0f / WQK, 1.0f / WV}, ctl + CW_NORM + 1024 * l, 32, DRY_REP && rep_ > 0}; }
                else if (pass == 0) { g = pg8::Gemm{B2, (const bf16*)(ws + WS_KVW), DM / 2}; N = 2048; E = pg8::EpiBf16{B3, DM, DM, AE, {1.0f / WQK, 1.0f / WV, 0.f}, ctl + CW_KVN, 16, DRY_REP && rep_ > 0}; }
                else { g = pg8::Gemm{B5, (const bf16*)((const unsigned char*)(ws + WS_DQ) + (size_t)(l - 2) * DM * DM), DM / 2}; N = 1024; E = pg8::EpiBf16{B0, DM, DM, AE, {QSCALE / WQK, 0.f, 0.f}, ctl + CW_NORM + 1024 * l, 16, DRY_REP && rep_ > 0}; }
                pg8::DenseSched S; S.init(NT, N, DM / 2, G, bx);
                pg8::gemm_phase<pg8::EpiBf16, pg8::DenseSched, true, true>(L, g, S, E, tid, L + PARK_OFF);
            }
        }
        PH_END;
        if (PH_ON) { FRESH_TID();
            LAS int* QW = (LAS int*)(L + QW_OFF);
            unsigned* qctr = ctl + CW_QUEUE + 64 * l;
            const int total = fox ? 2048 : 1024;
            if (!fox && tid < 64) { const float* lamp = INP(15) + (size_t)(l - 2) * 256; const float lam_init = (l == 2) ? 0.47071302f : 0.55605820f;
                float pa = lamp[tid] * lamp[64 + tid], pb = lamp[128 + tid] * lamp[192 + tid];
                pa = wave_sum(pa, tid); pb = wave_sum(pb, tid);
                if (tid == 0) ((LAS float*)QW)[16] = __expf(pa) - __expf(pb) + lam_init; }
            int jph = 0;
            if (!fox && tid < 128) { const int hh = tid >> 4, qq = tid & 15;
                auto est = [](int h_, int q_) { const int w = 5 + (int)(0.823f * (float)(2 << h_)); const int c = 4 * q_ + 4; return c < w ? c : w; };
                const int e = est(hh, qq); int rank = 0;
                for (int c2 = 0; c2 < 128; ++c2) { const int e2 = est(c2 >> 4, c2 & 15); rank += (e2 > e || (e2 == e && c2 < tid)) ? 1 : 0; }
                ((LAS unsigned char*)QW)[128 + rank] = (unsigned char)tid; }
            const int kaoff = fox ? attn_body::LDS_BIAS : attn_body::LDS128_BIAS;
            { LAS float* NL = (LAS float*)(L + NORML_OFF);
              for (int i = tid; i < 512; i += NWAVES * 64) { const int b = i >> 6, s = i & 63; unsigned v = 0u;
                  if (fox) { if ((s & 31) < 16) v = __hip_atomic_load(ctl + CW_NORM + 1024 * l + b * 32 + (s < 32 ? s : 16 + (s - 32)), RLX_AGENT); }
                  else { if (s < 16) v = __hip_atomic_load(ctl + CW_NORM + 1024 * l + b * 16 + s, RLX_AGENT); else if (s >= 32 && s < 48) v = __hip_atomic_load(ctl + CW_KVN + b * 16 + (s - 32), RLX_AGENT); }
                  NL[i] = __uint_as_float(v); } }
            for (int rep_ = 0; rep_ < (fox ? REP_ATTN_FOX : REP_ATTN); ++rep_) {
            unsigned* qc = qctr + 16 * rep_;
            int pvh = -1, pnk = 0;
            if (tid == 0) QW[0] = (int)__hip_atomic_fetch_add(qc, 1u, RLX_AGENT);
            __syncthreads();
            int ck = 0;
            for (;;) {
                const int u = __builtin_amdgcn_readfirstlane(QW[0]);
                __syncthreads();
                const bool have = u < total;
                if (!have && ck >= CONV_PER_WAVE) break;
                bool grab = false; int nxt = 0;
                const bool cdo = ck < CONV_PER_WAVE; const ConvF cf{ka, ws, L, l, vcu, G, ck, cdo ? 1 : 0};
                if (have) {
                grab = fox || jph == 1;
                if (grab && tid == 0) nxt = (int)__hip_atomic_fetch_add(qc, 1u, RLX_AGENT);
                int vh, qb;
                if (fox) { vh = u & 127; qb = 15 - (u >> 7); }
                else { const int cls = ((const LAS unsigned char*)QW)[128 + (u >> 3)]; vh = (u & 7) * 8 + (cls >> 4); qb = cls & 15; }
                const bf16 *Qb, *Kb, *Vb; bf16* Ob; const float *lc = nullptr, *bt = nullptr; float slope = 0.f; int nqi;
                if (fox) { const int b = vh >> 4, h = vh & 15; const size_t o = (size_t)b * SEQ * DM + h * 64;
                    Qb = B2 + o; Kb = B3 + o; Vb = B4 + o; Ob = (bf16*)((unsigned char*)B0 + o);   lc = LC + (size_t)vh * SEQ; bt = BT + vh * 32;
                    nqi = b * 64 + h; }
                else { const int b = vh >> 3, h = vh & 7, j = jph; const size_t o = (size_t)b * SEQ * DM + h * 128;
                    Qb = B0 + o + j * 64; Kb = B3 + o + j * 64; Vb = B4 + o; Ob = B1 + o; slope = exp2f(-(float)(h + 1));
                    nqi = b * 64 + 2 * h + j; }
                const LAS float* NL = (const LAS float*)(L + NORML_OFF);
                const float q2 = NL[nqi], k2 = NL[nqi + 32];
                const float bh = 1.01f * sqrtf(q2 * k2), bound = 2.0f * bh + 32.0f;
                int tu = tid; int t0;
                asm volatile("" : "+v"(tu));
                if (!(vh == pvh && (qb + 1) * 256 <= pnk)) {
                    fill_bias(L, fox, lc, bt, slope, (qb + 1) * 256, tu, tu & 63, kaoff);
                    asm volatile("s_waitcnt lgkmcnt(0)\n\ts_barrier" ::: "memory");
                    pvh = vh; pnk = (qb + 1) * 256; }
                { const LAS attn_body::u32x2v* bias = (const LAS attn_body::u32x2v*)(L + kaoff); const int jl = tu & 63;
                  const bool c = (jl < 4 * qb) && (attn_body::ka_value(bias[64 * jl + 63]) - attn_body::ka_value(bias[256 * qb]) + bound < 0.0f);
                  t0 = (int)__builtin_popcountll(__ballot(c)) & ~1; }
                if (fox) attn_body::attn_unit<8>(qb, t0, (const attn_body::bf16*)Qb, (const attn_body::bf16*)Kb, (const attn_body::bf16*)Vb, (attn_body::bf16*)Ob, (char*)lds, tu, bh, OSC, cf);
                else attn_body::attn_unit128(qb, t0, (const attn_body::bf16*)Qb, (const attn_body::bf16*)Kb, (const attn_body::bf16*)Vb, (attn_body::bf16*)Ob, (char*)lds, tu, bh, jph, (unsigned char*)B2 + (Ob - B1), (const float*)((char*)lds + QW_OFF + 64), INP(16) + (size_t)(l - 2) * 128, (1.0f - ((l == 2) ? 0.47071302f : 0.55605820f)) * OSC, LN_EPS, cf);
                if (!fox) jph ^= 1;
                }
                if (cdo) { if (!have) { int tc = tid; asm volatile("" : "+v"(tc)); float cv[32]; cf.issue(cv, tc & 63, tc >> 6); cf.finish(cv, tc & 63, tc >> 6); } ++ck; }
                if (grab && tid == 0) QW[0] = nxt;
                __syncthreads();
            }
            }
        }
        PH_END;
        ++ph;
        if (PH_ON) { FRESH_TID();
            pg8::Gemm g{fox ? B0 : B2, (const bf16*)((const unsigned char*)(ws + (fox ? WS_FOXO : WS_DO)) + (size_t)(fox ? l : l - 2) * DM * DM), DM / 2};
            pg8::DenseSched S; S.init(NT, DM, DM / 2, G, bx);
            for (int rep_ = 0; rep_ < REP_P3; ++rep_) { pg8::EpiFp8 E{(unsigned char*)B1, DM, YSC / (WV * OSC), DRY_REP && rep_ > 0};
            if (rep_ == 0) pg8::gemm_phase<pg8::EpiFp8, pg8::DenseSched, true, true>(L, g, S, E, tid, L + PARK_OFF); else pg8::gemm_phase<pg8::EpiFp8, pg8::DenseSched, true, true, ABLP>(L, g, S, E, tid, L + PARK_OFF); }
        }
        PH_END;
        if (PH_ON) { FRESH_TID();
            const float* modl = MOD + ((size_t)l * NB + bb) * 6144; bf16* XB = (bf16*)out + (size_t)NT * DM;     RowsCfg c{}; c.xin_f32 = INP(0); c.xin_bf = XB; c.xout_bf = (l == 3) ? B5 : XB; c.src = (const unsigned char*)B1; c.src_inv = 1.0f / YSC; c.gate = modl + 2 * DM; c.gamma = INP(4) + l * DM; c.beta = INP(5) + l * DM;
            c.sh = modl + 3 * DM; c.sc = modl + 4 * DM; c.hout = B0; c.hout_fp8 = 1; c.w16 = INP(18); c.w16_ld = 16; c.dotmode = 1; c.rb = INP(19);
            c.cnt = ctl + CW_CNT + 64 * l; c.perm = PERM; c.gwt = GWT; c.tokslot = TOK;
            for (int rep_ = 0; rep_ < REP_LN1; ++rep_) { RowsCfg c2 = c; if (rep_ + 1 < REP_LN1) { c2.xout_bf = (l == 3) ? B5 : B5; c2.cnt = nullptr; if (PROBE_NODOT) c2.dotmode = 0; }
            if (l == 0) rows_phase<1, true>(L, c2, tid, lane, wave, bx); else rows_phase<1, false>(L, c2, tid, lane, wave, bx); }
            if (CONV_PER_WAVE == 0) for (int rep_ = 0; rep_ < REP_CONV; ++rep_) moe_weight_copies(L, ka, ws, l, lane, wave, G, vcu);
        }
        PH_END;
        if (PH_ON) { FRESH_TID();
            LAS int* TAB = (LAS int*)(L + MOETAB_OFF);
            if (tid < 16) TAB[32 + tid] = (int)__hip_atomic_load(ctl + CW_CNT + 64 * l + tid, RLX_AGENT);
            __syncthreads();
            if (tid == 0) { int tp = 0, so = 0;
#pragma unroll
                for (int e = 0; e < 16; ++e) { const int cn = TAB[32 + e]; TAB[e] = tp; TAB[64 + e] = so; tp += (cn + 255) >> 8; so += cn; } TAB[16] = tp; }
            __syncthreads();
            pg8::Gemm g{B0, (const bf16*)(ws + WS_MOE1), DM / 2};
            pg8::MoeSched<true> S{TAB, G, vcu, DM / 2, PERM, (unsigned)(DM * DM), (const LAS int*)(L + PARK_OFF)};
            S.fill_tokens((LAS int*)(L + PARK_OFF), tid); __syncthreads();
            pg8::EpiMoe1 E{(unsigned char*)B2, 1.0f / W1SCALE, ASCALE};
            for (int rep_ = 0; rep_ < REP_P5; ++rep_)
            pg8::gemm_phase<pg8::EpiMoe1, pg8::MoeSched<true>, true, true>(L, g, S, E, tid, L + PARK_OFF);
        }
        PH_END;
        if (PH_ON) { FRESH_TID();
            LAS int* TAB = (LAS int*)(L + MOETAB_OFF);
            if (tid < 16) TAB[32 + tid] = (int)__hip_atomic_load(ctl + CW_CNT + 64 * l + tid, RLX_AGENT);
            __syncthreads();
            if (tid == 0) { int tp = 0, so = 0;
#pragma unroll
                for (int e = 0; e < 16; ++e) { const int cn = TAB[32 + e]; TAB[e] = tp; TAB[64 + e] = so; tp += (cn + 255) >> 8; so += cn; } TAB[16] = tp; }
            __syncthreads();
            pg8::Gemm g{B2, (const bf16*)(ws + WS_MOE2), 256};
            pg8::MoeSched<false> S{TAB, G, vcu, 256, PERM, (unsigned)(DM * 512), nullptr};
            pg8::EpiMoe2 E{(unsigned char*)B0, DNSC / (W2SCALE * ASCALE)};
            for (int rep_ = 0; rep_ < REP_P6; ++rep_)
            pg8::gemm_phase<pg8::EpiMoe2, pg8::MoeSched<false>, true, true>(L, g, S, E, tid, L + PARK_OFF);
        }
        PH_END;
        if (PH_ON) { FRESH_TID();
            const float* modl = MOD + ((size_t)l * NB + bb) * 6144; bf16* XB = (bf16*)out + (size_t)NT * DM; RowsCfg c{}; c.xin_bf = (l == 3) ? B5 : XB; if (l == 3) c.xout_f32 = out; else c.xout_bf = XB; c.src = (const unsigned char*)B0; c.src_inv = 1.0f / DNSC; c.gate = modl + 5 * DM; c.gamma = INP(6) + l * DM; c.beta = INP(7) + l * DM;
            c.cnt = ctl + CW_CNT + 64 * l; c.tokslot = TOK; c.gwt = GWT;
            if (l < 3) { const float* modn = MOD + ((size_t)(l + 1) * NB + bb) * 6144; c.sh = modn; c.sc = modn + DM; c.hout = B5; c.hout_fp8 = 1; }
            if (l == 0) { c.w16 = INP(8) + (size_t)DM * 3088 + 3072; c.w16_ld = 3088; c.dotmode = 2; c.rb = INP(9) + 16; c.lc = LC; c.bt = BT; }
            if (l == 1) { c.sh2 = KVMOD + (size_t)bb * 2048; c.sc2 = KVMOD + (size_t)bb * 2048 + DM; c.hout2 = B2; }
            for (int rep_ = 0; rep_ < REP_LN2; ++rep_) { RowsCfg c2 = c; if (rep_ + 1 < REP_LN2) { c2.xout_f32 = nullptr; c2.xout_bf = (l == 1) ? B3 : B2; }
            rows_phase<2, false>(L, c2, tid, lane, wave, bx); }
        }
        PH_END;
    }
#undef PH_ON
#undef PH_END
}

extern "C" void kernel_launch(void* const* d_in, const int* in_sizes, int n_in, void* d_out, int out_size, void* d_ws, size_t ws_size, hipStream_t stream) {
    static int grid = 0;
    if (grid == 0) {
        if (n_in != 23 || in_sizes[0] != NT * DM || out_size != NT * DM || ws_size < WS_END) { fprintf(stderr, "kernel_launch: unexpected problem (n_in %d, in0 %d, out %d, ws %zu < %zu)\n", n_in, n_in > 0 ? in_sizes[0] : -1, out_size, ws_size, (size_t)WS_END); grid = -1; return; }
        if (hipFuncSetAttribute((const void*)mk_fwd, hipFuncAttributeMaxDynamicSharedMemorySize, LDS_BYTES) != hipSuccess) { fprintf(stderr, "kernel_launch: hipFuncSetAttribute failed\n"); grid = -1; return; }
        int per_cu = 0;
        if (hipOccupancyMaxActiveBlocksPerMultiprocessor(&per_cu, (const void*)mk_fwd, NWAVES * 64, LDS_BYTES) != hipSuccess || per_cu < 1) fprintf(stderr, "kernel_launch: occupancy query reports %d\n", per_cu);
        (void)hipGetLastError();
        grid = 256;
    }
    if (grid < 0) return;
    if (hipMemsetAsync((char*)d_ws + WS_CTL, 0, CTL_ZERO_BYTES, stream) != hipSuccess) { fprintf(stderr, "kernel_launch: memset failed\n"); return; }
    Args a{};
    for (int i = 0; i < 23; ++i) a.in[i] = (const float*)d_in[i];
    a.out = (float*)d_out; a.ws = (unsigned char*)d_ws;
#if MK_PER_PHASE
    for (int p = 0; p < NPH; ++p) { a.ph_lo = p; a.ph_hi = p + 1; a.li = p; hipLaunchKernelGGL(mk_fwd, dim3(grid), dim3(NWAVES * 64), LDS_BYTES, stream, a); }
#else
    a.ph_lo = 0; a.ph_hi = NPH; a.li = 0;
    hipLaunchKernelGGL(mk_fwd, dim3(grid), dim3(NWAVES * 64), LDS_BYTES, stream, a);
#endif
    const hipError_t le = hipPeekAtLastError();
    if (le != hipSuccess) fprintf(stderr, "kernel_launch: launch failed: %s\n", hipGetErrorName(le));
}
```
